# Optimizing an MI355X kernel written in HIP

```python
import math
import jax, jax.numpy as jnp
from jax import lax
import numpy as np

D_MODEL = 1024
BATCH = 4
SEQ = 4096
DEPTH = 1

N_HEADS = 8
HEAD_DIM = D_MODEL // (2 * N_HEADS)
ATTN_WIDTH = N_HEADS * 2 * HEAD_DIM
ROT_DIM = HEAD_DIM // 4
ROPE_THETA = 500000.0
Q_BLOCK = 128
POOL_WINDOWS = (2, 4, 8, 16)
N_POOL_GROUPS = len(POOL_WINDOWS)
POOL_WIDTH = D_MODEL
POOL_GROUP_DIM = POOL_WIDTH // N_POOL_GROUPS
IN_COLS = POOL_WIDTH + 3 * ATTN_WIDTH + 2 * D_MODEL
N_EXPERTS = 16
EC_CAPACITY_FACTOR = 2
D_FF = ((8 * D_MODEL // 3 + 255) // 256) * 256
RMS_EPS = 1e-6
POS_OFFSET_MAX = 1024

kernel_name = "hybrid_pool_diffattn_ec_moe_encoder"


def rms_norm(x, g):
    xf = x.astype(jnp.float32)
    y = xf * lax.rsqrt(jnp.mean(xf * xf, axis=-1, keepdims=True) + RMS_EPS)
    return y.astype(x.dtype) * g


def pool_mixer(u, w_mix, scale):
    B, S, _ = u.shape
    ug = u.reshape(B, S, N_POOL_GROUPS, POOL_GROUP_DIM)
    cs = jnp.cumsum(ug.astype(jnp.float32), axis=1)
    cs = jnp.pad(cs, ((0, 0), (1, 0), (0, 0), (0, 0)))
    t = jnp.arange(S)
    outs = []
    for g, w in enumerate(POOL_WINDOWS):
        lo = jnp.clip(t - w // 2, 0, S)
        hi = jnp.clip(t + w // 2, 0, S)
        csg = cs[:, :, g]
        win = jnp.take(csg, hi, axis=1) - jnp.take(csg, lo, axis=1)
        cnt = (hi - lo).astype(jnp.float32)[None, :, None]
        pooled = (win / cnt).astype(u.dtype) - ug[:, :, g]
        outs.append(jnp.einsum('bsc,cd->bsd', pooled, w_mix[g]))
    return jnp.concatenate(outs, axis=-1) * scale


def rotary(x, pos):
    half = ROT_DIM // 2
    inv = ROPE_THETA ** (-jnp.arange(half, dtype=jnp.float32) * 2.0 / ROT_DIM)
    ang = pos.astype(jnp.float32)[..., None] * inv
    cos = jnp.cos(ang)[:, :, None, None, :]
    sin = jnp.sin(ang)[:, :, None, None, :]
    x1 = x[..., :half].astype(jnp.float32)
    x2 = x[..., half:ROT_DIM].astype(jnp.float32)
    r = jnp.concatenate([x1 * cos - x2 * sin, x2 * cos + x1 * sin], axis=-1).astype(x.dtype)
    return jnp.concatenate([r, x[..., ROT_DIM:]], axis=-1)


def diff_attention(q, k, v, lam):
    B, S = q.shape[:2]
    nb = S // Q_BLOCK
    qb = q.reshape(B, nb, Q_BLOCK, N_HEADS, 2, HEAD_DIM).transpose(1, 0, 2, 3, 4, 5)
    scale = HEAD_DIM ** -0.5

    def one_block(qblk):
        s = jnp.einsum('bqhmd,bkhmd->bhmqk', qblk, k, preferred_element_type=jnp.float32) * scale
        p = jax.nn.softmax(s, axis=-1)
        a = p[:, :, 0] - lam * p[:, :, 1]
        return jnp.einsum('bhqk,bkhe->bqhe', a.astype(v.dtype), v)

    o = lax.map(one_block, qb)
    return o.transpose(1, 0, 2, 3, 4).reshape(B, S, N_HEADS, 2 * HEAD_DIM)


def expert_choice_ffn(h, w_router, w_gate, w_up, w_down):
    B, S, D = h.shape
    cap = EC_CAPACITY_FACTOR * S // N_EXPERTS
    logits = jnp.einsum('bsd,de->bse', h, w_router, preferred_element_type=jnp.float32)
    aff = jax.nn.softmax(logits, axis=-1)
    vals, idx = lax.top_k(aff.transpose(0, 2, 1), cap)
    xs = jax.vmap(lambda hb, ib: hb[ib])(h, idx.reshape(B, -1)).reshape(B, N_EXPERTS, cap, D)
    g = jnp.einsum('becd,edf->becf', xs, w_gate)
    u = jnp.einsum('becd,edf->becf', xs, w_up)
    y = jnp.einsum('becf,efd->becd', jax.nn.silu(g) * u, w_down) * vals[..., None].astype(h.dtype)
    flat = (jnp.arange(B)[:, None, None] * S + idx).reshape(-1)
    out = jax.ops.segment_sum(y.reshape(-1, D), flat, num_segments=B * S)
    return out.reshape(B, S, D)


def setup_inputs(seed: int = 0) -> dict:
    key = jax.random.key(seed)
    ks = jax.random.split(key, 24)
    f32 = jnp.float32
    nrm = lambda k, shape, fan_in: jax.random.normal(k, shape, f32) * (fan_in ** -0.5)
    x = jax.random.normal(ks[0], (BATCH, SEQ, D_MODEL), f32)
    offsets = jax.random.randint(ks[1], (BATCH, 1), 0, POS_OFFSET_MAX, dtype=jnp.int32)
    positions = offsets + jnp.arange(SEQ, dtype=jnp.int32)[None, :]
    return {
        "x": x,
        "positions": positions,
        "g_mix": 1.0 + 0.02 * jax.random.normal(ks[2], (DEPTH, D_MODEL), f32),
        "w_in": nrm(ks[3], (DEPTH, D_MODEL, IN_COLS), D_MODEL),
        "w_pool_mix": nrm(ks[4], (DEPTH, N_POOL_GROUPS, POOL_GROUP_DIM, POOL_GROUP_DIM), POOL_GROUP_DIM),
        "pool_scale": 1.0 + 0.02 * jax.random.normal(ks[5], (DEPTH, POOL_WIDTH), f32),
        "w_pool_out": nrm(ks[6], (DEPTH, POOL_WIDTH, D_MODEL), POOL_WIDTH),
        "lam_q1": 0.1 * jax.random.normal(ks[7], (DEPTH, HEAD_DIM), f32),
        "lam_k1": 0.1 * jax.random.normal(ks[8], (DEPTH, HEAD_DIM), f32),
        "lam_q2": 0.1 * jax.random.normal(ks[9], (DEPTH, HEAD_DIM), f32),
        "lam_k2": 0.1 * jax.random.normal(ks[10], (DEPTH, HEAD_DIM), f32),
        "g_subln": 1.0 + 0.02 * jax.random.normal(ks[11], (DEPTH, 2 * HEAD_DIM), f32),
        "w_attn_out": nrm(ks[12], (DEPTH, ATTN_WIDTH, D_MODEL), ATTN_WIDTH),
        "w_out": nrm(ks[13], (DEPTH, D_MODEL, D_MODEL), D_MODEL),
        "g_ffn": 1.0 + 0.02 * jax.random.normal(ks[14], (DEPTH, D_MODEL), f32),
        "w_router": nrm(ks[15], (DEPTH, D_MODEL, N_EXPERTS), D_MODEL),
        "w_gate": nrm(ks[16], (DEPTH, N_EXPERTS, D_MODEL, D_FF), D_MODEL),
        "w_up": nrm(ks[17], (DEPTH, N_EXPERTS, D_MODEL, D_FF), D_MODEL),
        "w_down": nrm(ks[18], (DEPTH, N_EXPERTS, D_FF, D_MODEL), D_FF),
        "g_final": 1.0 + 0.02 * jax.random.normal(ks[19], (D_MODEL,), f32),
    }


def reference(x, positions, g_mix, w_in, w_pool_mix, pool_scale, w_pool_out, lam_q1, lam_k1,
              lam_q2, lam_k2, g_subln, w_attn_out, w_out, g_ffn, w_router, w_gate, w_up, w_down,
              g_final):
    B, S, _ = x.shape
    c_q = POOL_WIDTH
    c_k = c_q + ATTN_WIDTH
    c_v = c_k + ATTN_WIDTH
    c_gp = c_v + ATTN_WIDTH
    c_ga = c_gp + D_MODEL
    for l in range(DEPTH):
        lam_init = 0.8 - 0.6 * math.exp(-0.3 * l)
        h = rms_norm(x, g_mix[l])
        z = jnp.einsum('bsd,dc->bsc', h, w_in[l])
        u_pool = z[..., :c_q]
        q = z[..., c_q:c_k].reshape(B, S, N_HEADS, 2, HEAD_DIM)
        k = z[..., c_k:c_v].reshape(B, S, N_HEADS, 2, HEAD_DIM)
        v = z[..., c_v:c_gp].reshape(B, S, N_HEADS, 2 * HEAD_DIM)
        gate_pool = jax.nn.sigmoid(z[..., c_gp:c_ga])
        gate_attn = jax.nn.sigmoid(z[..., c_ga:])
        y_pool = jnp.einsum('bsc,cd->bsd', pool_mixer(u_pool, w_pool_mix[l], pool_scale[l]), w_pool_out[l])
        q = rotary(q, positions)
        k = rotary(k, positions)
        lam = (jnp.exp(jnp.sum(lam_q1[l].astype(jnp.float32) * lam_k1[l].astype(jnp.float32)))
               - jnp.exp(jnp.sum(lam_q2[l].astype(jnp.float32) * lam_k2[l].astype(jnp.float32)))
               + lam_init)
        o = diff_attention(q, k, v, lam)
        o = rms_norm(o, g_subln[l]) * (1.0 - lam_init)
        y_attn = jnp.einsum('bsc,cd->bsd', o.reshape(B, S, ATTN_WIDTH), w_attn_out[l])
        merged = gate_pool * y_pool + gate_attn * y_attn
        x = x + jnp.einsum('bsd,de->bse', merged, w_out[l])
        x = x + expert_choice_ffn(rms_norm(x, g_ffn[l]), w_router[l], w_gate[l], w_up[l], w_down[l])
    return rms_norm(x, g_final)
```

```cpp
#include <hip/hip_runtime.h>
#include <cstdio>
#include <cstdint>

#define GAS __attribute__((address_space(1)))
#define LAS __attribute__((address_space(3)))
typedef unsigned short bf16;
typedef unsigned v4u __attribute__((ext_vector_type(4)));
typedef unsigned v2u __attribute__((ext_vector_type(2)));
typedef float f32x4 __attribute__((ext_vector_type(4)));

constexpr int NB = 4, SEQ = 4096, T = NB * SEQ, D = 1024, NH = 8, INC = 6144, NE = 16, CAP = 512, FF = 2816;
constexpr int NSEL = NB * NE * CAP;
constexpr float EPS = 1e-6f;
constexpr float C2 = 0.18033688011112042f;
constexpr float LAM_INIT = 0.2f, ONE_M_LAM_INIT = 0.8f;

constexpr size_t MiB = 1u << 20;
constexpr size_t WS_CTL = 0, CTL_ZERO_BYTES = 1 * MiB;
constexpr size_t WS_ROPE = 1 * MiB;
constexpr size_t WS_AFF = 2 * MiB;
constexpr size_t WS_SELI = 3 * MiB;
constexpr size_t WS_SELV = 3 * MiB + 512 * 1024;
constexpr size_t WS_SLOT = 4 * MiB;
constexpr size_t WS_WIN = 6 * MiB;
constexpr size_t WS_WCOMB = 18 * MiB, WS_WAO = 20 * MiB, WS_WOUT = 22 * MiB;
constexpr size_t WS_W13 = 24 * MiB;
constexpr size_t WS_WD = 200 * MiB;
constexpr size_t WS_ACT0 = 288 * MiB;
constexpr size_t SLOTB = 32 * MiB;
constexpr size_t WS_Q = WS_ACT0 + 0 * SLOTB, WS_K = WS_ACT0 + 1 * SLOTB, WS_X2 = WS_ACT0;
constexpr size_t WS_XN = WS_ACT0 + 2 * SLOTB, WS_O = WS_XN, WS_H2 = WS_XN;
constexpr size_t WS_U = WS_ACT0 + 3 * SLOTB, WS_MG = WS_U;
constexpr size_t WS_V = WS_ACT0 + 4 * SLOTB, WS_GP = WS_ACT0 + 5 * SLOTB, WS_GA = WS_ACT0 + 6 * SLOTB, WS_PD = WS_ACT0 + 7 * SLOTB;
constexpr size_t WS_OV = WS_ACT0 + 8 * SLOTB;
constexpr size_t WS_XS = WS_ACT0 + 3 * SLOTB, WS_Y = WS_XS;
constexpr size_t WS_ACT = WS_ACT0 + 5 * SLOTB;
constexpr size_t WS_QKF = WS_ACT0 + 7 * SLOTB;
constexpr size_t WS_END = WS_ACT0 + 11 * SLOTB;

struct Params {
    const float* x; const int* pos; const float* g_mix; const float* w_in; const float* w_pmix; const float* pscale; const float* w_pout;
    const float *lq1, *lk1, *lq2, *lk2; const float* g_sub; const float* w_ao; const float* w_out; const float* g_ffn; const float* w_router;
    const float *w_gate, *w_up, *w_down; const float* g_final; float* out; unsigned char* ws;
};

__device__ const float ROPE_INV[8] = {1.0f, 0.1939227432012558f, 0.03760603070259094f, 0.007292664609849453f, 0.0014142135623842478f, 0.00027424818836152554f, 5.3182957344688475e-05f, 1.0313385246263351e-05f};

__device__ __forceinline__ unsigned f2bf(float f) { unsigned u = __builtin_bit_cast(unsigned, f); return (u + 0x7fffu + ((u >> 16) & 1u)) >> 16; }
__device__ __forceinline__ unsigned pk2(float lo, float hi) { return f2bf(lo) | (f2bf(hi) << 16); }
__device__ __forceinline__ float bf_lo(unsigned w) { return __builtin_bit_cast(float, w << 16); }
__device__ __forceinline__ float bf_hi(unsigned w) { return __builtin_bit_cast(float, w & 0xffff0000u); }
__device__ __forceinline__ float bf2f(bf16 h) { return __builtin_bit_cast(float, (unsigned)h << 16); }
__device__ __forceinline__ unsigned pk4_fp8(float a, float b, float c, float d) {
    a = __builtin_amdgcn_fmed3f(a, -448.f, 448.f); b = __builtin_amdgcn_fmed3f(b, -448.f, 448.f); c = __builtin_amdgcn_fmed3f(c, -448.f, 448.f); d = __builtin_amdgcn_fmed3f(d, -448.f, 448.f);
    int r = __builtin_amdgcn_cvt_pk_fp8_f32(a, b, 0, false); r = __builtin_amdgcn_cvt_pk_fp8_f32(c, d, r, true); return (unsigned)r; }
constexpr float W8_SCALE = 64.f, XS8_SCALE = 8.f, ACT8_SCALE = 4.f;
__device__ __forceinline__ float wave_sum(float v) {
#pragma unroll
    for (int o = 1; o < 64; o <<= 1) v += __shfl_xor(v, o);
    return v;
}
__device__ __forceinline__ float wave_max(float v) {
#pragma unroll
    for (int o = 1; o < 64; o <<= 1) v = fmaxf(v, __shfl_xor(v, o));
    return v;
}
__device__ __forceinline__ unsigned lds_add(LAS unsigned* p, unsigned v) { return __hip_atomic_fetch_add(p, v, __ATOMIC_RELAXED, __HIP_MEMORY_SCOPE_WORKGROUP); }
__device__ __forceinline__ float sigmoidf_(float z) { return 1.0f / (1.0f + __expf(-z)); }
__device__ __forceinline__ float lam_value(const Params& P, int lane) {
    const float a = wave_sum(P.lq1[lane] * P.lk1[lane]), b = wave_sum(P.lq2[lane] * P.lk2[lane]);
    return expf(a) - expf(b) + LAM_INIT;
}

__device__ __forceinline__ void rms_row_bf16(const float* xrow, const float* g, bf16* orow, int lane) {
    const f32x4* xr = (const f32x4*)xrow + lane;
    f32x4 v[4]; float s = 0.f;
#pragma unroll
    for (int j = 0; j < 4; ++j) { v[j] = xr[64 * j]; s += (v[j].x * v[j].x + v[j].y * v[j].y) + (v[j].z * v[j].z + v[j].w * v[j].w); }
    const float r = rsqrtf(wave_sum(s) * (1.f / D) + EPS);
    unsigned long long* o8 = (unsigned long long*)orow + lane;
#pragma unroll
    for (int j = 0; j < 4; ++j) { const f32x4 gg = ((const f32x4*)g)[lane + 64 * j];
        o8[64 * j] = (unsigned long long)pk2(v[j].x * r * gg.x, v[j].y * r * gg.y) | ((unsigned long long)pk2(v[j].z * r * gg.z, v[j].w * r * gg.w) << 32); }
}
__device__ __forceinline__ void ph_rms_x(const Params& P, int gw, int ngw, int lane) {
    bf16* XN = (bf16*)(P.ws + WS_XN);
    f32x4 gg[4], v[4], nv[4];
#pragma unroll
    for (int j = 0; j < 4; ++j) gg[j] = ((const f32x4*)P.g_mix)[lane + 64 * j];
    if (gw < T) {
#pragma unroll
        for (int j = 0; j < 4; ++j) v[j] = ((const f32x4*)(P.x + (size_t)gw * D) + lane)[64 * j]; }
    for (int m = gw; m < T; m += ngw) {
        if (m + ngw < T) {
#pragma unroll
            for (int j = 0; j < 4; ++j) nv[j] = ((const f32x4*)(P.x + (size_t)(m + ngw) * D) + lane)[64 * j]; }
        float s = 0.f;
#pragma unroll
        for (int j = 0; j < 4; ++j) s += (v[j].x * v[j].x + v[j].y * v[j].y) + (v[j].z * v[j].z + v[j].w * v[j].w);
        const float r = rsqrtf(wave_sum(s) * (1.f / D) + EPS);
        unsigned long long* o8 = (unsigned long long*)(XN + (size_t)m * D) + lane;
#pragma unroll
        for (int j = 0; j < 4; ++j) o8[64 * j] = (unsigned long long)pk2(v[j].x * r * gg[j].x, v[j].y * r * gg[j].y) | ((unsigned long long)pk2(v[j].z * r * gg[j].z, v[j].w * r * gg[j].w) << 32);
#pragma unroll
        for (int j = 0; j < 4; ++j) v[j] = nv[j];
    }
}
__device__ __forceinline__ void ph_rope(const Params& P, int gtid, int ngt) {
    float* cs = (float*)(P.ws + WS_ROPE);
    for (int i = gtid; i < T * 8; i += ngt) { const int t = i >> 3, k = i & 7;
        const float ang = (float)P.pos[t] * ROPE_INV[k];
        double fr = (double)ang * 0.15915494309189535; fr -= rint(fr);
        cs[t * 16 + k] = __builtin_amdgcn_cosf((float)fr); cs[t * 16 + 8 + k] = __builtin_amdgcn_sinf((float)fr); }
}
__device__ __forceinline__ void ph_wcomb(const Params& P, int gtid, int ngt) {
    bf16* WT = (bf16*)(P.ws + WS_WCOMB);
    for (int it = gtid; it < 512 * 256; it += ngt) { const int c0 = (it & 255) * 4, k0 = (it >> 8) * 2, g = k0 >> 8;
        f32x4 acc0 = {0.f, 0.f, 0.f, 0.f}, acc1 = acc0;
        const float* wm = P.w_pmix + (size_t)k0 * 256; const float* sc = P.pscale + g * 256; const float* wp = P.w_pout + (size_t)(g * 256) * D + c0;
#pragma unroll 4
        for (int j4 = 0; j4 < 64; ++j4) {
            const f32x4 m0 = *(const f32x4*)(wm + 4 * j4), m1 = *(const f32x4*)(wm + 256 + 4 * j4), s4 = *(const f32x4*)(sc + 4 * j4);
#pragma unroll
            for (int jj = 0; jj < 4; ++jj) { const f32x4 w4 = *(const f32x4*)(wp + (size_t)(4 * j4 + jj) * D) * s4[jj]; acc0 += w4 * m0[jj]; acc1 += w4 * m1[jj]; } }
#pragma unroll
        for (int cc = 0; cc < 4; ++cc) *(unsigned*)(WT + (size_t)(c0 + cc) * D + k0) = pk2(acc0[cc], acc1[cc]); }
}
struct WTile { const float* src; unsigned char* dst; int N, Kb, fp8; };
__device__ __forceinline__ WTile wtile_decode(const Params& P, int pair, int half) {
    constexpr int I_GU = 8 * 88, I_DN = 22 * 32, I_E = 2 * I_GU + I_DN, I_IN = 8 * 192, I_SQ = 8 * 32;
    WTile t; int r = pair;
    if (r < NE * I_E) { const int e = r / I_E; r -= e * I_E; t.fp8 = 1;
        if (r < 2 * I_GU) { const int up = r >= I_GU ? 1 : 0; r -= up * I_GU; const int kb = r / 88, nb = r % 88, n0 = 32 * nb, k0 = 128 * kb + 64 * half;
            const float* W = (up ? P.w_up : P.w_gate) + (size_t)e * D * FF; const int orow = (n0 >> 7) * 256 + (n0 & 127) + up * 128;
            t.src = W + (size_t)k0 * FF + n0; t.N = FF; t.Kb = D; t.dst = P.ws + WS_W13 + ((size_t)e * 5632 + orow) * D + k0; return t; }
        r -= 2 * I_GU;
        { const int kb = r / 32, nb = r % 32, n0 = 32 * nb, k0 = 128 * kb + 64 * half; const float* W = P.w_down + (size_t)e * FF * D;
          t.src = W + (size_t)k0 * D + n0; t.N = D; t.Kb = FF; t.dst = P.ws + WS_WD + ((size_t)e * D + n0) * FF + k0; return t; } }
    r -= NE * I_E; t.fp8 = 0;
    if (r < I_IN) { const int kb = r / 192, nb = r % 192, n0 = 32 * nb, k0 = 128 * kb + 64 * half; t.src = P.w_in + (size_t)k0 * INC + n0; t.N = INC; t.Kb = 2 * D; t.dst = P.ws + WS_WIN + ((size_t)n0 * D + k0) * 2; return t; }
    r -= I_IN;
    { const int which = r >= I_SQ ? 1 : 0; r -= which * I_SQ; const int kb = r / 32, nb = r % 32, n0 = 32 * nb, k0 = 128 * kb + 64 * half;
      t.src = (which ? P.w_out : P.w_ao) + (size_t)k0 * D + n0; t.N = D; t.Kb = 2 * D; t.dst = P.ws + (which ? WS_WOUT : WS_WAO) + ((size_t)n0 * D + k0) * 2; return t; }
}
#define WT_LOAD(buf, t) do { const float* sp_ = (t).src + (size_t)(lane >> 5) * (t).N + (lane & 31); _Pragma("unroll") for (int i = 0; i < 32; ++i) buf[i] = __builtin_nontemporal_load(sp_ + (size_t)(2 * i) * (t).N); } while (0)
#define WT_PROC(buf, t) do { _Pragma("unroll") for (int i = 0; i < 32; ++i) scr[(2 * i + (lane >> 5)) * 33 + (lane & 31)] = buf[i]; \
        asm volatile("s_waitcnt lgkmcnt(0)" ::: "memory"); const int c = lane & 7; \
        if ((t).fp8) { _Pragma("unroll") for (int jj = 0; jj < 4; ++jj) { const int n = (lane >> 3) + 8 * jj; const LAS float* s = scr + (8 * c) * 33 + n; \
                v2u o; o.x = pk4_fp8(s[0 * 33] * W8_SCALE, s[1 * 33] * W8_SCALE, s[2 * 33] * W8_SCALE, s[3 * 33] * W8_SCALE); o.y = pk4_fp8(s[4 * 33] * W8_SCALE, s[5 * 33] * W8_SCALE, s[6 * 33] * W8_SCALE, s[7 * 33] * W8_SCALE); \
                *(v2u*)((t).dst + (size_t)n * (t).Kb + 8 * c) = o; } } \
        else { _Pragma("unroll") for (int jj = 0; jj < 4; ++jj) { const int n = (lane >> 3) + 8 * jj; const LAS float* s = scr + (8 * c) * 33 + n; \
                v4u o; o.x = pk2(s[0 * 33], s[1 * 33]); o.y = pk2(s[2 * 33], s[3 * 33]); o.z = pk2(s[4 * 33], s[5 * 33]); o.w = pk2(s[6 * 33], s[7 * 33]); \
                *(v4u*)((t).dst + (size_t)n * (t).Kb + 16 * c) = o; } } \
        asm volatile("s_waitcnt lgkmcnt(0)" ::: "memory"); } while (0)
constexpr int WT_FP8_PAIRS = NE * (2 * 8 * 88 + 22 * 32), WT_ALL_PAIRS = WT_FP8_PAIRS + 8 * 192 + 2 * 8 * 32;
__device__ __forceinline__ void ph_weights(const Params& P, int pair0, int pair1, int gw, int ngw, int lane, LAS float* scr) {
    const int npw = (pair1 - pair0 - gw + ngw - 1) / ngw;
    if (npw <= 0) return;
    float va[32], vb[32];
    WTile ta = wtile_decode(P, pair0 + gw, 0), tb;
    WT_LOAD(va, ta);
    for (int p = 0; p < npw; ++p) {
        tb = wtile_decode(P, pair0 + gw + p * ngw, 1); WT_LOAD(vb, tb);
        WT_PROC(va, ta);
        if (p + 1 < npw) { ta = wtile_decode(P, pair0 + gw + (p + 1) * ngw, 0); WT_LOAD(va, ta); }
        WT_PROC(vb, tb);
    }
}
#undef WT_LOAD
#undef WT_PROC
__device__ __forceinline__ void pool_add(float (&a)[8], const v4u w, float sg) {
    a[0] += sg * bf_lo(w.x); a[1] += sg * bf_hi(w.x); a[2] += sg * bf_lo(w.y); a[3] += sg * bf_hi(w.y); a[4] += sg * bf_lo(w.z); a[5] += sg * bf_hi(w.z); a[6] += sg * bf_lo(w.w); a[7] += sg * bf_hi(w.w); }
template <int HW> __device__ __forceinline__ void pool_rows4(const bf16* U, bf16* PD, int t0, int c0) {
    const int s0 = t0 & (SEQ - 1), b0 = t0 - s0;
    constexpr int NR = 2 * HW + 3;
    v4u w[NR];
#pragma unroll
    for (int i = 0; i < NR; ++i) { const int r = s0 - HW + i, rc = min(max(r, 0), SEQ - 1); w[i] = *(const v4u*)(U + (size_t)(b0 + rc) * D + c0); }
#pragma unroll
    for (int i = 0; i < NR; ++i) { const int r = s0 - HW + i; if (r < 0 || r >= SEQ) w[i] = (v4u){0u, 0u, 0u, 0u}; }
    float acc[8];
#pragma unroll
    for (int j = 0; j < 8; ++j) acc[j] = 0.f;
#pragma unroll
    for (int i = 0; i < 2 * HW; ++i) pool_add(acc, w[i], 1.f);
#pragma unroll
    for (int k = 0; k < 4; ++k) { const int sr = s0 + k; const float inv = 1.0f / (float)(min(sr + HW, SEQ) - max(sr - HW, 0));
        const v4u c = w[k + HW];
        v4u o; o.x = pk2(acc[0] * inv - bf_lo(c.x), acc[1] * inv - bf_hi(c.x)); o.y = pk2(acc[2] * inv - bf_lo(c.y), acc[3] * inv - bf_hi(c.y));
        o.z = pk2(acc[4] * inv - bf_lo(c.z), acc[5] * inv - bf_hi(c.z)); o.w = pk2(acc[6] * inv - bf_lo(c.w), acc[7] * inv - bf_hi(c.w));
        *(v4u*)(PD + (size_t)(t0 + k) * D + c0) = o;
        if (k < 3) { pool_add(acc, w[k + 2 * HW], 1.f); pool_add(acc, w[k], -1.f); } }
}
__device__ __forceinline__ void ph_pool(const Params& P, int gw, int ngw, int lane) {
    const bf16* U = (const bf16*)(P.ws + WS_U); bf16* PD = (bf16*)(P.ws + WS_PD);
    for (int wi = gw; wi < (T / 8) * 4; wi += ngw) {
        const int grp = __builtin_amdgcn_readfirstlane(wi & 3), rb2 = wi >> 2;
        const int t0 = (rb2 * 2 + (lane >> 5)) * 4, c0 = grp * 256 + (lane & 31) * 8;
        if (grp == 0) pool_rows4<1>(U, PD, t0, c0); else if (grp == 1) pool_rows4<2>(U, PD, t0, c0); else if (grp == 2) pool_rows4<4>(U, PD, t0, c0); else pool_rows4<8>(U, PD, t0, c0);
    }
}
__device__ __forceinline__ void ph_combine(const Params& P, int gw, int ngw, int lane) {
    const bf16* O0 = (const bf16*)(P.ws + WS_OV); const bf16* O1 = O0 + (size_t)T * D; bf16* O = (bf16*)(P.ws + WS_O);
    const float lam = lam_value(P, lane);
    float gs[16];
#pragma unroll
    for (int i = 0; i < 16; ++i) gs[i] = P.g_sub[((16 * lane) & 127) + i] * ONE_M_LAM_INIT;
    for (int t = gw; t < T; t += ngw) {
        const v4u a0 = *(const v4u*)(O0 + (size_t)t * D + 16 * lane), a1 = *(const v4u*)(O0 + (size_t)t * D + 16 * lane + 8);
        const v4u b0 = *(const v4u*)(O1 + (size_t)t * D + 16 * lane), b1 = *(const v4u*)(O1 + (size_t)t * D + 16 * lane + 8);
        float d[16];
        d[0] = bf_lo(a0.x) - lam * bf_lo(b0.x); d[1] = bf_hi(a0.x) - lam * bf_hi(b0.x); d[2] = bf_lo(a0.y) - lam * bf_lo(b0.y); d[3] = bf_hi(a0.y) - lam * bf_hi(b0.y);
        d[4] = bf_lo(a0.z) - lam * bf_lo(b0.z); d[5] = bf_hi(a0.z) - lam * bf_hi(b0.z); d[6] = bf_lo(a0.w) - lam * bf_lo(b0.w); d[7] = bf_hi(a0.w) - lam * bf_hi(b0.w);
        d[8] = bf_lo(a1.x) - lam * bf_lo(b1.x); d[9] = bf_hi(a1.x) - lam * bf_hi(b1.x); d[10] = bf_lo(a1.y) - lam * bf_lo(b1.y); d[11] = bf_hi(a1.y) - lam * bf_hi(b1.y);
        d[12] = bf_lo(a1.z) - lam * bf_lo(b1.z); d[13] = bf_hi(a1.z) - lam * bf_hi(b1.z); d[14] = bf_lo(a1.w) - lam * bf_lo(b1.w); d[15] = bf_hi(a1.w) - lam * bf_hi(b1.w);
        float ss = 0.f;
#pragma unroll
        for (int i = 0; i < 16; ++i) ss += d[i] * d[i];
        ss += __shfl_xor(ss, 1); ss += __shfl_xor(ss, 2); ss += __shfl_xor(ss, 4);
        const float r = rsqrtf(ss * (1.f / 128.f) + EPS);
        v4u o0, o1;
        o0.x = pk2(d[0] * r * gs[0], d[1] * r * gs[1]); o0.y = pk2(d[2] * r * gs[2], d[3] * r * gs[3]); o0.z = pk2(d[4] * r * gs[4], d[5] * r * gs[5]); o0.w = pk2(d[6] * r * gs[6], d[7] * r * gs[7]);
        o1.x = pk2(d[8] * r * gs[8], d[9] * r * gs[9]); o1.y = pk2(d[10] * r * gs[10], d[11] * r * gs[11]); o1.z = pk2(d[12] * r * gs[12], d[13] * r * gs[13]); o1.w = pk2(d[14] * r * gs[14], d[15] * r * gs[15]);
        *(v4u*)(O + (size_t)t * D + 16 * lane) = o0; *(v4u*)(O + (size_t)t * D + 16 * lane + 8) = o1;
    }
}
__device__ __forceinline__ void combine_block(const Params& P, int t0, int h, float lam, int wave, int lane) {
    const bf16* O0 = (const bf16*)(P.ws + WS_OV); const bf16* O1 = O0 + (size_t)T * D; bf16* O = (bf16*)(P.ws + WS_O);
    const int cl = (lane & 7) * 16;
    float gs[16];
#pragma unroll
    for (int i = 0; i < 16; ++i) gs[i] = P.g_sub[cl + i] * ONE_M_LAM_INIT;
#pragma unroll
    for (int it = 0; it < 4; ++it) { const int t = t0 + wave * 32 + it * 8 + (lane >> 3); const size_t off = (size_t)t * D + h * 128 + cl;
        const v4u a0 = *(const v4u*)(O0 + off), a1 = *(const v4u*)(O0 + off + 8), b0 = *(const v4u*)(O1 + off), b1 = *(const v4u*)(O1 + off + 8);
        float d[16];
        d[0] = bf_lo(a0.x) - lam * bf_lo(b0.x); d[1] = bf_hi(a0.x) - lam * bf_hi(b0.x); d[2] = bf_lo(a0.y) - lam * bf_lo(b0.y); d[3] = bf_hi(a0.y) - lam * bf_hi(b0.y);
        d[4] = bf_lo(a0.z) - lam * bf_lo(b0.z); d[5] = bf_hi(a0.z) - lam * bf_hi(b0.z); d[6] = bf_lo(a0.w) - lam * bf_lo(b0.w); d[7] = bf_hi(a0.w) - lam * bf_hi(b0.w);
        d[8] = bf_lo(a1.x) - lam * bf_lo(b1.x); d[9] = bf_hi(a1.x) - lam * bf_hi(b1.x); d[10] = bf_lo(a1.y) - lam * bf_lo(b1.y); d[11] = bf_hi(a1.y) - lam * bf_hi(b1.y);
        d[12] = bf_lo(a1.z) - lam * bf_lo(b1.z); d[13] = bf_hi(a1.z) - lam * bf_hi(b1.z); d[14] = bf_lo(a1.w) - lam * bf_lo(b1.w); d[15] = bf_hi(a1.w) - lam * bf_hi(b1.w);
        float ss = 0.f;
#pragma unroll
        for (int i = 0; i < 16; ++i) ss += d[i] * d[i];
        ss += __shfl_xor(ss, 1); ss += __shfl_xor(ss, 2); ss += __shfl_xor(ss, 4);
        const float r = rsqrtf(ss * (1.f / 128.f) + EPS);
        v4u o0, o1;
        o0.x = pk2(d[0] * r * gs[0], d[1] * r * gs[1]); o0.y = pk2(d[2] * r * gs[2], d[3] * r * gs[3]); o0.z = pk2(d[4] * r * gs[4], d[5] * r * gs[5]); o0.w = pk2(d[6] * r * gs[6], d[7] * r * gs[7]);
        o1.x = pk2(d[8] * r * gs[8], d[9] * r * gs[9]); o1.y = pk2(d[10] * r * gs[10], d[11] * r * gs[11]); o1.z = pk2(d[12] * r * gs[12], d[13] * r * gs[13]); o1.w = pk2(d[14] * r * gs[14], d[15] * r * gs[15]);
        *(v4u*)(O + off) = o0; *(v4u*)(O + off + 8) = o1; }
}
__device__ __forceinline__ void ph_router(const Params& P, int bid, int nblk, int tid, int nthr, LAS float* wrT) {
    const int lane = tid & 63, wave = tid >> 6, nwv = nthr >> 6;
    { f32x4 w[8];
#pragma unroll
      for (int j = 0; j < 8; ++j) w[j] = ((const f32x4*)P.w_router)[tid + 512 * j];
#pragma unroll
      for (int j = 0; j < 8; ++j) { const int i4 = tid + 512 * j, d = i4 >> 2, e0 = (i4 & 3) * 4; wrT[(e0 + 0) * D + d] = w[j].x; wrT[(e0 + 1) * D + d] = w[j].y; wrT[(e0 + 2) * D + d] = w[j].z; wrT[(e0 + 3) * D + d] = w[j].w; } }
    __syncthreads();
    const float* X2 = (const float*)(P.ws + WS_X2); bf16* H2 = (bf16*)(P.ws + WS_H2); float* AFF = (float*)(P.ws + WS_AFF);
    f32x4 gg[4];
#pragma unroll
    for (int j = 0; j < 4; ++j) gg[j] = ((const f32x4*)P.g_ffn)[lane + 64 * j];
    const int t0 = bid * nwv + wave, tstride = nblk * nwv;
    f32x4 v[4], nv[4];
    if (t0 < T) {
#pragma unroll
        for (int j = 0; j < 4; ++j) v[j] = ((const f32x4*)(X2 + (size_t)t0 * D) + lane)[64 * j]; }
    for (int t = t0; t < T; t += tstride) {
        const int tn = t + tstride;
        if (tn < T) {
#pragma unroll
            for (int j = 0; j < 4; ++j) nv[j] = ((const f32x4*)(X2 + (size_t)tn * D) + lane)[64 * j]; }
        float s = 0.f;
#pragma unroll
        for (int j = 0; j < 4; ++j) s += (v[j].x * v[j].x + v[j].y * v[j].y) + (v[j].z * v[j].z + v[j].w * v[j].w);
        const float r = rsqrtf(wave_sum(s) * (1.f / D) + EPS);
        unsigned long long* o8 = (unsigned long long*)(H2 + (size_t)t * D) + lane;
#pragma unroll
        for (int j = 0; j < 4; ++j) { v[j].x = v[j].x * r * gg[j].x; v[j].y = v[j].y * r * gg[j].y; v[j].z = v[j].z * r * gg[j].z; v[j].w = v[j].w * r * gg[j].w;
            o8[64 * j] = (unsigned long long)pk2(v[j].x, v[j].y) | ((unsigned long long)pk2(v[j].z, v[j].w) << 32); }
        float mylg = 0.f;
#pragma unroll 4
        for (int e = 0; e < 16; ++e) { float a = 0.f;
#pragma unroll
            for (int j = 0; j < 4; ++j) { const f32x4 w = *(const LAS f32x4*)(wrT + e * D + 256 * j + 4 * lane); a += (v[j].x * w.x + v[j].y * w.y) + (v[j].z * w.z + v[j].w * w.w); }
            const float tot = wave_sum(a); mylg = (lane == e) ? tot : mylg; }
        float mx = mylg;
        mx = fmaxf(mx, __shfl_xor(mx, 1)); mx = fmaxf(mx, __shfl_xor(mx, 2)); mx = fmaxf(mx, __shfl_xor(mx, 4)); mx = fmaxf(mx, __shfl_xor(mx, 8));
        const float mine = expf(mylg - mx); float den = mine;
        den += __shfl_xor(den, 1); den += __shfl_xor(den, 2); den += __shfl_xor(den, 4); den += __shfl_xor(den, 8);
        if (lane < 16) AFF[((size_t)(t >> 12) * NE + lane) * SEQ + (t & (SEQ - 1))] = mine / den;
#pragma unroll
        for (int j = 0; j < 4; ++j) v[j] = nv[j];
    }
}
__device__ __forceinline__ void ph_topk(const Params& P, int bid, int nblk, int tid, LAS unsigned* sm) {
    const float* AFF = (const float*)(P.ws + WS_AFF); int* SELI = (int*)(P.ws + WS_SELI); float* SELV = (float*)(P.ws + WS_SELV); int* SLOT = (int*)(P.ws + WS_SLOT);
    const bf16* H2 = (const bf16*)(P.ws + WS_H2); unsigned char* XS = P.ws + WS_XS;
    LAS unsigned* hist = sm;
    LAS unsigned* wtot = sm + 256;
    LAS unsigned* ctl = sm + 272;
    LAS unsigned* cgt = sm + 320;
    LAS unsigned* ceq = sm + 384;
    LAS int* chosen = (LAS int*)(sm + 512);
    const int lane = tid & 63, wave = tid >> 6;
    for (int item = bid; item < NB * NE * 4; item += nblk) {
        const int li = item >> 2, q = item & 3, b = li >> 4, e = li & 15;
        const float* a = AFF + (size_t)li * SEQ;
        unsigned key[8];
#pragma unroll
        for (int i = 0; i < 8; ++i) key[i] = __builtin_bit_cast(unsigned, a[i * 512 + tid]);
        unsigned prefix = 0u, k = CAP;
#pragma unroll 1
        for (int rnd = 0; rnd < 4; ++rnd) { const int shift = 24 - 8 * rnd;
            if (tid < 256) hist[tid] = 0u;
            __syncthreads();
#pragma unroll
            for (int i = 0; i < 8; ++i) { const bool in = (rnd == 0) ? true : ((key[i] >> (shift + 8)) == prefix); if (in) lds_add(&hist[(key[i] >> shift) & 255u], 1u); }
            __syncthreads();
            unsigned h = 0u, sfx = 0u;
            if (tid < 256) { h = hist[tid]; sfx = h;
#pragma unroll
                for (int o = 1; o < 64; o <<= 1) { const unsigned tt = __shfl_down(sfx, o); if (lane + o < 64) sfx += tt; }
                if (lane == 0) wtot[wave] = sfx; }
            __syncthreads();
            if (tid < 256) { unsigned above = 0u;
#pragma unroll
                for (int w = 1; w < 4; ++w) above += (w > wave) ? wtot[w] : 0u;
                const unsigned incl = sfx + above, excl = incl - h;
                if (incl >= k && excl < k) { ctl[2 * rnd] = (prefix << 8) | (unsigned)tid; ctl[2 * rnd + 1] = k - excl; } }
            __syncthreads();
            prefix = ctl[2 * rnd]; k = ctl[2 * rnd + 1];
        }
        const unsigned thr = prefix, need_eq = k;
        unsigned long long gtm[8], eqm[8];
#pragma unroll
        for (int i = 0; i < 8; ++i) { gtm[i] = __ballot(key[i] > thr); eqm[i] = __ballot(key[i] == thr);
            if (lane == 0) { cgt[i * 8 + wave] = (unsigned)__popcll(gtm[i]); ceq[i * 8 + wave] = (unsigned)__popcll(eqm[i]); } }
        __syncthreads();
        if (wave == 0) { const unsigned g0 = cgt[lane], e0 = ceq[lane]; unsigned gs = g0, es = e0;
#pragma unroll
            for (int o = 1; o < 64; o <<= 1) { const unsigned tg = __shfl_up(gs, o), te = __shfl_up(es, o); if (lane >= o) { gs += tg; es += te; } }
            cgt[lane] = gs - g0; ceq[lane] = es - e0; }
        __syncthreads();
        const unsigned long long lt = (1ull << lane) - 1ull;
#pragma unroll
        for (int i = 0; i < 8; ++i) { const int s = i * 512 + tid;
            const unsigned bg = cgt[i * 8 + wave] + (unsigned)__popcll(gtm[i] & lt), be = ceq[i * 8 + wave] + (unsigned)__popcll(eqm[i] & lt);
            const bool isgt = key[i] > thr, iseq = key[i] == thr, sel = isgt || (iseq && be < need_eq);
            const int c = (int)(bg + (be < need_eq ? be : need_eq));
            if (sel && (c >> 7) == q) { chosen[c & 127] = s; SELI[li * CAP + c] = s; SELV[li * CAP + c] = __builtin_bit_cast(float, key[i]); }
            if ((i >> 1) == q) SLOT[((size_t)b * SEQ + s) * NE + e] = sel ? c : -1; }
        __syncthreads();
#pragma unroll 4
        for (int cc = wave; cc < 128; cc += 8) { const int s = chosen[cc];
            const v4u* src = (const v4u*)(H2 + ((size_t)b * SEQ + s) * D) + 2 * lane; v4u* dst = (v4u*)(XS + ((size_t)li * CAP + q * 128 + cc) * D) + lane;
            const v4u x0 = src[0], x1 = src[1]; v4u o;
            o.x = pk4_fp8(bf_lo(x0.x) * XS8_SCALE, bf_hi(x0.x) * XS8_SCALE, bf_lo(x0.y) * XS8_SCALE, bf_hi(x0.y) * XS8_SCALE); o.y = pk4_fp8(bf_lo(x0.z) * XS8_SCALE, bf_hi(x0.z) * XS8_SCALE, bf_lo(x0.w) * XS8_SCALE, bf_hi(x0.w) * XS8_SCALE);
            o.z = pk4_fp8(bf_lo(x1.x) * XS8_SCALE, bf_hi(x1.x) * XS8_SCALE, bf_lo(x1.y) * XS8_SCALE, bf_hi(x1.y) * XS8_SCALE); o.w = pk4_fp8(bf_lo(x1.z) * XS8_SCALE, bf_hi(x1.z) * XS8_SCALE, bf_lo(x1.w) * XS8_SCALE, bf_hi(x1.w) * XS8_SCALE);
            *dst = o; }
        __syncthreads();
    }
}
__device__ __forceinline__ void ph_final(const Params& P, int gw, int ngw, int lane) {
    const float* X2 = (const float*)(P.ws + WS_X2); const bf16* Y = (const bf16*)(P.ws + WS_Y); const int* SLOT = (const int*)(P.ws + WS_SLOT);
    f32x4 gg[4], v[4], nv[4]; int myslot = -1, nslot = -1;
#pragma unroll
    for (int j = 0; j < 4; ++j) gg[j] = ((const f32x4*)P.g_final)[lane + 64 * j];
    if (gw < T) { myslot = SLOT[(size_t)gw * NE + (lane & 15)];
#pragma unroll
        for (int j = 0; j < 4; ++j) v[j] = ((const f32x4*)(X2 + (size_t)gw * D) + lane)[64 * j]; }
    for (int t = gw; t < T; t += ngw) {
        const int tn = t + ngw;
        if (tn < T) { nslot = SLOT[(size_t)tn * NE + (lane & 15)];
#pragma unroll
            for (int j = 0; j < 4; ++j) nv[j] = ((const f32x4*)(X2 + (size_t)tn * D) + lane)[64 * j]; }
        const int b = t >> 12;
        unsigned mask = (unsigned)(__ballot(myslot >= 0) & 0xFFFFull);
        while (mask) {
            int e_[4]; float w_[4];
#pragma unroll
            for (int k = 0; k < 4; ++k) { const bool ok = mask != 0u; e_[k] = ok ? (int)__builtin_ctz(mask) : 0; w_[k] = ok ? 1.f : 0.f; mask = ok ? (mask & (mask - 1u)) : 0u; }
            v2u yv[4][4];
#pragma unroll
            for (int k = 0; k < 4; ++k) { const int c = __builtin_amdgcn_readlane(myslot, e_[k]); const size_t row = (w_[k] != 0.f) ? ((size_t)(b * NE + e_[k]) * CAP + c) : 0;
                const v2u* yr = (const v2u*)(Y + row * D) + lane;
#pragma unroll
                for (int j = 0; j < 4; ++j) yv[k][j] = yr[64 * j]; }
#pragma unroll
            for (int k = 0; k < 4; ++k)
#pragma unroll
                for (int j = 0; j < 4; ++j) { v[j].x += w_[k] * bf_lo(yv[k][j].x); v[j].y += w_[k] * bf_hi(yv[k][j].x); v[j].z += w_[k] * bf_lo(yv[k][j].y); v[j].w += w_[k] * bf_hi(yv[k][j].y); }
        }
        float s = 0.f;
#pragma unroll
        for (int j = 0; j < 4; ++j) s += (v[j].x * v[j].x + v[j].y * v[j].y) + (v[j].z * v[j].z + v[j].w * v[j].w);
        const float r = rsqrtf(wave_sum(s) * (1.f / D) + EPS);
        f32x4* orow = (f32x4*)(P.out + (size_t)t * D) + lane;
#pragma unroll
        for (int j = 0; j < 4; ++j) { f32x4 o; o.x = v[j].x * r * gg[j].x; o.y = v[j].y * r * gg[j].y; o.z = v[j].z * r * gg[j].z; o.w = v[j].w * r * gg[j].w; orow[64 * j] = o; }
#pragma unroll
        for (int j = 0; j < 4; ++j) v[j] = nv[j];
        myslot = nslot;
    }
}

namespace pg8 {
#define PG8_LAS __attribute__((address_space(3)))
typedef unsigned short bf16_t;
typedef short bf16x8 __attribute__((ext_vector_type(8)));
typedef float f32x4 __attribute__((ext_vector_type(4)));
typedef unsigned u32x4 __attribute__((ext_vector_type(4)));
constexpr int BM = 256, BK = 64, HALF = 128, HTB = HALF * BK * 2  , STAGE_BYTES = 8 * HTB, NXCD = 8, WGM = 8;

__host__ __device__ __forceinline__ int lds_byte(int r, int c) { const int st = (r >> 4) * 2 + (c >> 5), rr = r & 15, cc = c & 31, ob = rr * 64 + cc * 2; return st * 1024 + (ob ^ (((ob >> 9) & 1) << 5)); }
__host__ __device__ __forceinline__ void stage_rc(int b, int& R, int& C) { const int st = b / 1024, sb = b % 1024, swz = sb ^ (((sb >> 9) & 1) << 5); R = (st >> 1) * 16 + swz / 64; C = (st & 1) * 32 + (swz % 64) / 2; }
__host__ __device__ __forceinline__ int perm32(int rho) { const int n = rho >> 4, i = rho & 15; return 8 * (i >> 2) + 4 * n + (i & 3); }

struct Unit { int pm, pn, aux; };
struct Gemm { const bf16_t* A; const bf16_t* Bt; int M, N, K; };

struct StaticOrder {
    int nM, nN, nwg, G, c;
    __host__ __device__ void init(int M, int N, int G_, int c_) { nM = M / BM; nN = N / BM; nwg = nM * nN; G = G_; c = c_; }
    __host__ __device__ bool next(int i, Unit& u) const {
        const long L = (long)i * G + c; if (L >= nwg) return false;
        int wgid = (int)L; { const int q = nwg / NXCD, r = nwg % NXCD, xcd = wgid % NXCD, off = wgid / NXCD; wgid = (xcd < r ? xcd * (q + 1) : r * (q + 1) + (xcd - r) * q) + off; }
        const int nig = WGM * nN, gid = wgid / nig, fm = gid * WGM, gsz = (nM - fm) < WGM ? (nM - fm) : WGM;
        u.pm = fm + ((wgid % nig) % gsz); u.pn = (wgid % nig) / gsz; u.aux = 0; return true;
    }
    __device__ __forceinline__ void a_ready(const Unit&) const {}
    __device__ __forceinline__ void done(const Unit&) const {}
};
__device__ __forceinline__ unsigned cvt_pk_bf16(float lo, float hi) { unsigned r; asm volatile("v_cvt_pk_bf16_f32 %0, %1, %2" : "=v"(r) : "v"(lo), "v"(hi)); return r; }

__device__ __forceinline__ float fast_sigmoid(float z) { return __builtin_amdgcn_rcpf(1.0f + __builtin_amdgcn_exp2f(-1.4426950408889634f * z)); }
struct EpiIn {
    static constexpr bool PERM = true, AFTER_DRAIN = false;
    unsigned char* ws; const float* cs;
    __device__ __forceinline__ void operator()(const f32x4 (&acc)[2][2][4][2], const Unit& u, int wr, int wc, int fr, int fq) const {
        const int seg = u.pn >> 2, colt = (u.pn & 3) * BM;
        const size_t off = seg == 0 ? WS_U : seg == 1 ? WS_Q : seg == 2 ? WS_K : seg == 3 ? WS_V : seg == 4 ? WS_GP : WS_GA;
        bf16_t* base = (bf16_t*)(ws + off);
        const int row0 = u.pm * BM + wr * 64 + fr, col0 = colt + wc * 32 + 8 * fq;
        const bool rot = (seg == 1 || seg == 2) && ((wc & 1) == 0);
        const float sc = seg == 1 ? C2 : 1.f; const float sgn = fq == 0 ? -1.f : 1.f;
#pragma unroll
        for (int ai = 0; ai < 2; ++ai)
#pragma unroll
            for (int m = 0; m < 4; ++m) { const int row = row0 + ai * HALF + m * 16; bf16_t* rowp = base + (size_t)row * D + col0;
                f32x4 c0 = {1.f, 1.f, 1.f, 1.f}, c1 = c0, s0 = {0.f, 0.f, 0.f, 0.f}, s1 = s0;
                if (rot && fq < 2) { const f32x4* cp = (const f32x4*)(cs + (size_t)row * 16); c0 = cp[0]; c1 = cp[1]; s0 = cp[2] * sgn; s1 = cp[3] * sgn; }
#pragma unroll
                for (int bj = 0; bj < 2; ++bj) { f32x4 v0 = acc[ai][bj][m][0], v1 = acc[ai][bj][m][1];
                    if (rot) { f32x4 p0, p1;
#pragma unroll
                        for (int i = 0; i < 4; ++i) { p0[i] = __shfl_xor(v0[i], 16); p1[i] = __shfl_xor(v1[i], 16); }
                        v0 = v0 * c0 + p0 * s0; v1 = v1 * c1 + p1 * s1; }
                    if (seg >= 4) {
#pragma unroll
                        for (int i = 0; i < 4; ++i) { v0[i] = fast_sigmoid(v0[i]); v1[i] = fast_sigmoid(v1[i]); } }
                    v0 = v0 * sc; v1 = v1 * sc; u32x4 w; w.x = cvt_pk_bf16(v0[0], v0[1]); w.y = cvt_pk_bf16(v0[2], v0[3]); w.z = cvt_pk_bf16(v1[0], v1[1]); w.w = cvt_pk_bf16(v1[2], v1[3]);
                    *(u32x4*)(rowp + bj * HALF) = w; } }
    }
};
__device__ __forceinline__ float bfl(unsigned w) { return __builtin_bit_cast(float, w << 16); }
__device__ __forceinline__ float bfh(unsigned w) { return __builtin_bit_cast(float, w & 0xffff0000u); }
struct EpiMerge {
    static constexpr bool PERM = true, AFTER_DRAIN = false, KEEPS_ACC = true;
    const bf16_t* GP; const bf16_t* GA; bf16_t* MG;
    __device__ __forceinline__ bool keep(const Unit& u) const { return u.aux == 0; }
    __device__ __forceinline__ void operator()(f32x4 (&acc)[2][2][4][2], const Unit& u, int wr, int wc, int fr, int fq) const {
        const int row0 = u.pm * BM + wr * 64 + fr, col0 = u.pn * BM + wc * 32 + 8 * fq;
        if (u.aux == 0) {
#pragma unroll
            for (int ai = 0; ai < 2; ++ai)
#pragma unroll
                for (int m = 0; m < 4; ++m)
#pragma unroll
                    for (int bj = 0; bj < 2; ++bj) { const size_t idx = (size_t)(row0 + ai * HALF + m * 16) * D + col0 + bj * HALF;
                        const u32x4 p = *(const u32x4*)(GP + idx), a = *(const u32x4*)(GA + idx);
                        const float pv[8] = {bfl(p.x), bfh(p.x), bfl(p.y), bfh(p.y), bfl(p.z), bfh(p.z), bfl(p.w), bfh(p.w)}, av[8] = {bfl(a.x), bfh(a.x), bfl(a.y), bfh(a.y), bfl(a.z), bfh(a.z), bfl(a.w), bfh(a.w)};
#pragma unroll
                        for (int i = 0; i < 4; ++i) { acc[ai][bj][m][0][i] *= pv[i] * __builtin_amdgcn_rcpf(fmaxf(av[i], 1e-30f)); acc[ai][bj][m][1][i] *= pv[4 + i] * __builtin_amdgcn_rcpf(fmaxf(av[4 + i], 1e-30f)); } }
        } else {
#pragma unroll
            for (int ai = 0; ai < 2; ++ai)
#pragma unroll
                for (int m = 0; m < 4; ++m)
#pragma unroll
                    for (int bj = 0; bj < 2; ++bj) { const size_t idx = (size_t)(row0 + ai * HALF + m * 16) * D + col0 + bj * HALF;
                        const u32x4 a = *(const u32x4*)(GA + idx); const f32x4 v0 = acc[ai][bj][m][0], v1 = acc[ai][bj][m][1];
                        const float o[8] = {fmaxf(bfl(a.x), 1e-30f) * v0[0], fmaxf(bfh(a.x), 1e-30f) * v0[1], fmaxf(bfl(a.y), 1e-30f) * v0[2], fmaxf(bfh(a.y), 1e-30f) * v0[3],
                                            fmaxf(bfl(a.z), 1e-30f) * v1[0], fmaxf(bfh(a.z), 1e-30f) * v1[1], fmaxf(bfl(a.w), 1e-30f) * v1[2], fmaxf(bfh(a.w), 1e-30f) * v1[3]};
                        u32x4 w; w.x = cvt_pk_bf16(o[0], o[1]); w.y = cvt_pk_bf16(o[2], o[3]); w.z = cvt_pk_bf16(o[4], o[5]); w.w = cvt_pk_bf16(o[6], o[7]);
                        *(u32x4*)(MG + idx) = w; }
        }
    }
};
struct MergeOrder { StaticOrder so; const char *A0, *A1, *B0, *B1; size_t tstep;
    __device__ bool next(int i, Unit& u) const { if (!so.next(i >> 1, u)) return false; u.aux = i & 1; return true; }
    __device__ __forceinline__ const char* abase(const Unit& u) const { return (u.aux ? A1 : A0) + (size_t)u.pm * tstep; }
    __device__ __forceinline__ const char* bbase(const Unit& u) const { return (u.aux ? B1 : B0) + (size_t)u.pn * tstep; }
    __device__ __forceinline__ void a_ready(const Unit&) const {}
    __device__ __forceinline__ void done(const Unit&) const {}
};
struct EpiRes {
    static constexpr bool PERM = false, AFTER_DRAIN = false;
    const float* x; float* x2;
    __device__ __forceinline__ void operator()(const f32x4 (&acc)[2][2][4][2], const Unit& u, int wr, int wc, int fr, int fq) const {
        const int row0 = u.pm * BM + wr * 64 + fr, col0 = u.pn * BM + wc * 32 + 4 * fq;
#pragma unroll
        for (int ai = 0; ai < 2; ++ai)
#pragma unroll
            for (int m = 0; m < 4; ++m)
#pragma unroll
                for (int bj = 0; bj < 2; ++bj)
#pragma unroll
                    for (int n = 0; n < 2; ++n) { const size_t off = (size_t)(row0 + ai * HALF + m * 16) * D + col0 + bj * HALF + n * 16;
                        *(f32x4*)(x2 + off) = *(const f32x4*)(x + off) + acc[ai][bj][m][n]; }
    }
};
typedef int v8i_t __attribute__((ext_vector_type(8))); typedef int v4i_t __attribute__((ext_vector_type(4)));
__device__ __forceinline__ v8i_t pg8_cat(bf16x8 lo, bf16x8 hi) { const v4i_t a = __builtin_bit_cast(v4i_t, lo), b = __builtin_bit_cast(v4i_t, hi); return __builtin_shufflevector(a, b, 0, 1, 2, 3, 4, 5, 6, 7); }
__device__ __forceinline__ unsigned pk4_e4m3(float a, float b, float c, float d) { return pk4_fp8(a, b, c, d); }
struct EpiUp {
    static constexpr bool PERM = true, AFTER_DRAIN = false;
    unsigned char* act;
    __device__ __forceinline__ void operator()(const f32x4 (&acc)[2][2][4][2], const Unit& u, int wr, int wc, int fr, int fq) const {
        const int e = (u.pm >> 1) & 15, j = u.pn - e * 22;
        const int row0 = u.pm * BM + wr * 64 + fr, col0 = j * HALF + wc * 32 + 8 * fq;
        constexpr float SI = 1.0f / (XS8_SCALE * W8_SCALE);
#pragma unroll
        for (int ai = 0; ai < 2; ++ai)
#pragma unroll
            for (int m = 0; m < 4; ++m) { float o[8];
#pragma unroll
                for (int n = 0; n < 2; ++n)
#pragma unroll
                    for (int i = 0; i < 4; ++i) { const float g = acc[ai][0][m][n][i] * SI; o[4 * n + i] = g * fast_sigmoid(g) * (acc[ai][1][m][n][i] * (SI * ACT8_SCALE)); }
                v2u w; w.x = pk4_fp8(o[0], o[1], o[2], o[3]); w.y = pk4_fp8(o[4], o[5], o[6], o[7]);
                *(v2u*)(act + (size_t)(row0 + ai * HALF + m * 16) * FF + col0) = w; }
    }
};
struct EpiDown {
    static constexpr bool PERM = true, AFTER_DRAIN = false;
    bf16_t* y; const float* val;
    __device__ __forceinline__ void operator()(const f32x4 (&acc)[2][2][4][2], const Unit& u, int wr, int wc, int fr, int fq) const {
        const int e = (u.pm >> 1) & 15, n4 = u.pn - e * 4;
        const int row0 = u.pm * BM + wr * 64 + fr, col0 = n4 * BM + wc * 32 + 8 * fq;
#pragma unroll
        for (int ai = 0; ai < 2; ++ai)
#pragma unroll
            for (int m = 0; m < 4; ++m) { const int row = row0 + ai * HALF + m * 16; const float vv = val[row] * (1.0f / (ACT8_SCALE * W8_SCALE));
#pragma unroll
                for (int bj = 0; bj < 2; ++bj) { const f32x4 v0 = acc[ai][bj][m][0] * vv, v1 = acc[ai][bj][m][1] * vv;
                    u32x4 w; w.x = cvt_pk_bf16(v0[0], v0[1]); w.y = cvt_pk_bf16(v0[2], v0[3]); w.z = cvt_pk_bf16(v1[0], v1[1]); w.w = cvt_pk_bf16(v1[2], v1[3]);
                    *(u32x4*)(y + (size_t)row * D + col0 + bj * HALF) = w; } }
    }
};
struct InOrder { int pm0, off0, nu;
    __device__ bool next(int i, Unit& u) const { if (i >= nu) return false; const int off = off0 + 16 * i; u.pm = pm0 + (off & 7); u.pn = off >> 3; u.aux = 0; return true; }
    __device__ __forceinline__ void a_ready(const Unit&) const {}
    __device__ __forceinline__ void done(const Unit&) const {}
};
struct UpOrder { int xg, l;
    __device__ bool next(int i, Unit& u) const { if (i >= 11) return false; const int uu = i * 32 + l, e = xg * 2 + uu / 176, r = uu % 176, j = r >> 3, pmi = r & 7;
        u.pm = ((pmi >> 1) * 16 + e) * 2 + (pmi & 1); u.pn = e * 22 + j; u.aux = 0; return true; }
    __device__ __forceinline__ void a_ready(const Unit&) const {}
    __device__ __forceinline__ void done(const Unit&) const {}
};
struct DownOrder { int xg, l;
    __device__ bool next(int i, Unit& u) const { if (i >= 2) return false; const int e = xg * 2 + i, pmi = l & 7, n4 = l >> 3;
        u.pm = ((pmi >> 1) * 16 + e) * 2 + (pmi & 1); u.pn = e * 4 + n4; u.aux = 0; return true; }
    __device__ __forceinline__ void a_ready(const Unit&) const {}
    __device__ __forceinline__ void done(const Unit&) const {}
};
template <class S_, class = void> struct pg8_has_bases { static constexpr bool value = false; };
template <class S_> struct pg8_has_bases<S_, decltype((void)&S_::abase)> { static constexpr bool value = true; };
template <class E_, class = void> struct pg8_keeps_acc { static constexpr bool value = false; };
template <class E_> struct pg8_keeps_acc<E_, decltype((void)E_::KEEPS_ACC)> { static constexpr bool value = E_::KEEPS_ACC; };
template <class Epi, class Sched, bool ALIGN_EPI = false, bool SP2 = false, bool FP8 = false>
__device__ __forceinline__ void gemm_phase(PG8_LAS unsigned char* lds, const Gemm g, const Sched& S, const Epi& E) {
    const int tid = threadIdx.x, wid = __builtin_amdgcn_readfirstlane(tid >> 6), lane = tid & 63, wr = wid >> 2, wc = wid & 3, fr = lane & 15, fq = lane >> 4;
    const int K = g.K, nt = K / BK;
    unsigned voffA[2], voffB[2];
#pragma unroll
    for (int i = 0; i < 2; ++i) { int R, C; stage_rc(tid * 16 + i * 8192, R, C); const int Rb = Epi::PERM ? ((R & ~31) + perm32(R & 31)) : R;
        voffA[i] = (unsigned)(R * K + C) * 2u; voffB[i] = (unsigned)(Rb * K + C) * 2u; }
    const size_t kstep = (size_t)(BK * 2);
    const size_t hstep = (size_t)HALF * K * 2;
    const size_t tstep = 2 * hstep;
    const unsigned ldsw = (unsigned)wid * 1024u;
    const int aoff = lds_byte(wr * 64 + fr, fq * 8), boff = lds_byte(wc * 32 + fr, fq * 8);
#define PG8_SA(b, h) (((b) * 2 + (h)) * HTB)
#define PG8_SB(b, h) ((4 + (b) * 2 + (h)) * HTB)
#define PG8_STAGE(bufoff, gbase, voff) do { _Pragma("unroll") for (int _i = 0; _i < 2; ++_i) \
        __builtin_amdgcn_global_load_lds((const unsigned*)((const char*)(gbase) + (voff)[_i]), (PG8_LAS unsigned*)(lds + (bufoff) + ldsw + _i * 8192), 16, 0, 0); } while (0)
#define PG8_LDA(dst, b, h) do { _Pragma("unroll") for (int m = 0; m < 4; ++m) { const bf16x8 x0_ = *(const PG8_LAS bf16x8*)(lds + PG8_SA(b, h) + aoff + m * 2048), x1_ = *(const PG8_LAS bf16x8*)(lds + PG8_SA(b, h) + aoff + m * 2048 + 1024); \
        if constexpr (FP8) dst##8[m] = pg8_cat(x0_, x1_); else { dst[m][0] = x0_; dst[m][1] = x1_; } } } while (0)
#define PG8_LDB(dst, b, h) do { _Pragma("unroll") for (int n = 0; n < 2; ++n) { const bf16x8 x0_ = *(const PG8_LAS bf16x8*)(lds + PG8_SB(b, h) + boff + n * 2048), x1_ = *(const PG8_LAS bf16x8*)(lds + PG8_SB(b, h) + boff + n * 2048 + 1024); \
        if constexpr (FP8) dst##8[n] = pg8_cat(x0_, x1_); else { dst[n][0] = x0_; dst[n][1] = x1_; } } } while (0)
#define PG8_MMA(ai, bj, At, Bt) do { __builtin_amdgcn_s_setprio(1); \
        if constexpr (FP8) { _Pragma("unroll") for (int m = 0; m < 4; ++m) _Pragma("unroll") for (int n = 0; n < 2; ++n) \
            asm volatile("s_nop 1\n\tv_mfma_scale_f32_16x16x128_f8f6f4 %0, %1, %2, %0, %3, %3 op_sel_hi:[0,0,0]" : "+v"(acc[ai][bj][m][n]) : "v"(Bt##8[n]), "v"(At##8[m]), "v"(sc8_)); } \
        else { _Pragma("unroll") for (int m = 0; m < 4; ++m) _Pragma("unroll") for (int n = 0; n < 2; ++n) _Pragma("unroll") for (int k = 0; k < 2; ++k) \
            acc[ai][bj][m][n] = __builtin_amdgcn_mfma_f32_16x16x32_bf16(Bt[n][k], At[m][k], acc[ai][bj][m][n], 0, 0, 0); } \
        __builtin_amdgcn_s_setprio(0); } while (0)
#define PG8_WAIT_V(n) asm volatile("s_waitcnt vmcnt(" #n ")" ::: "memory")
#define PG8_WAIT_L(n) asm volatile("s_waitcnt lgkmcnt(" #n ")" ::: "memory")
#define PG8_BAR __builtin_amdgcn_s_barrier()
#define PG8_SCHED __builtin_amdgcn_sched_barrier(0)
    Unit cur, nxt; int ui = 0;
    if (!S.next(0, cur)) return;
    f32x4 acc[2][2][4][2];
#pragma unroll
    for (int a = 0; a < 2; ++a)
#pragma unroll
        for (int b = 0; b < 2; ++b)
#pragma unroll
            for (int m = 0; m < 4; ++m)
#pragma unroll
                for (int n = 0; n < 2; ++n) acc[a][b][m][n] = (f32x4){0.f, 0.f, 0.f, 0.f};
    const unsigned sc8_ = 0x7F7F7F7Fu;
    bf16x8 At[4][2], B0[2][2], B1[2][2]; v8i_t At8[4], B08[2], B18[2];
    const char* cA; const char* cB;
    if constexpr (pg8_has_bases<Sched>::value) { cA = S.abase(cur); cB = S.bbase(cur); } else { cA = (const char*)g.A + (size_t)cur.pm * tstep; cB = (const char*)g.Bt + (size_t)cur.pn * tstep; }
    S.a_ready(cur);
    if constexpr (SP2) {
        PG8_STAGE(PG8_SB(0, 0), cB, voffB); PG8_STAGE(PG8_SB(0, 1), cB + hstep, voffB); PG8_STAGE(PG8_SA(0, 0), cA, voffA); PG8_STAGE(PG8_SA(0, 1), cA + hstep, voffA);
        if (wr == 1) PG8_BAR;
        PG8_WAIT_V(2); PG8_BAR;
        PG8_STAGE(PG8_SB(1, 0), cB + kstep, voffB); PG8_STAGE(PG8_SA(1, 0), cA + kstep, voffA); PG8_STAGE(PG8_SB(1, 1), cB + hstep + kstep, voffB);
        PG8_WAIT_V(6); PG8_BAR;
    } else {
        PG8_STAGE(PG8_SB(0, 0), cB, voffB); PG8_STAGE(PG8_SA(0, 0), cA, voffA); PG8_STAGE(PG8_SB(0, 1), cB + hstep, voffB); PG8_STAGE(PG8_SA(0, 1), cA + hstep, voffA);
        if (wr == 1) PG8_BAR;
        PG8_WAIT_V(4); PG8_BAR;
        PG8_STAGE(PG8_SB(1, 0), cB + kstep, voffB); PG8_STAGE(PG8_SA(1, 0), cA + kstep, voffA); PG8_STAGE(PG8_SB(1, 1), cB + hstep + kstep, voffB);
        PG8_WAIT_V(6); PG8_BAR;
    }
    for (;;) {
        const bool has_next = S.next(ui + 1, nxt);
        const char* nA; const char* nB;
        if constexpr (pg8_has_bases<Sched>::value) { nA = has_next ? S.abase(nxt) : cA; nB = has_next ? S.bbase(nxt) : cB; } else { nA = has_next ? (const char*)g.A + (size_t)nxt.pm * tstep : cA; nB = has_next ? (const char*)g.Bt + (size_t)nxt.pn * tstep : cB; }
        for (int t = 0; t < nt; t += 2) {
            const bool last = (t == nt - 2);
            const char* a1 = cA + (size_t)(t + 1) * kstep;
            const char* a2 = last ? nA : cA + (size_t)(t + 2) * kstep; const char* b2 = last ? nB : cB + (size_t)(t + 2) * kstep;
            const char* a3 = a2 + kstep; const char* b3 = b2 + kstep;
            if (last && has_next) S.a_ready(nxt);
            if constexpr (SP2) {
            PG8_LDB(B0, 0, 0); PG8_LDB(B1, 0, 1); PG8_SCHED; PG8_LDA(At, 0, 0); PG8_STAGE(PG8_SA(1, 1), a1 + hstep, voffA);
            PG8_WAIT_V(8); PG8_WAIT_L(0); PG8_BAR; PG8_MMA(0, 0, At, B0); PG8_MMA(0, 1, At, B1); PG8_BAR; PG8_SCHED;
            PG8_LDA(At, 0, 1); PG8_STAGE(PG8_SB(0, 0), b2, voffB); PG8_STAGE(PG8_SB(0, 1), b2 + hstep, voffB); PG8_STAGE(PG8_SA(0, 0), a2, voffA);
            PG8_WAIT_V(8); PG8_WAIT_L(0); PG8_BAR; PG8_MMA(1, 0, At, B0); PG8_MMA(1, 1, At, B1); PG8_BAR; PG8_SCHED;
            PG8_LDB(B0, 1, 0); PG8_LDB(B1, 1, 1); PG8_SCHED; PG8_LDA(At, 1, 0); PG8_STAGE(PG8_SA(0, 1), a2 + hstep, voffA);
            PG8_WAIT_V(8); PG8_WAIT_L(0); PG8_BAR; PG8_MMA(0, 0, At, B0); PG8_MMA(0, 1, At, B1); PG8_BAR; PG8_SCHED;
            PG8_LDA(At, 1, 1); PG8_STAGE(PG8_SB(1, 0), b3, voffB); PG8_STAGE(PG8_SB(1, 1), b3 + hstep, voffB); PG8_STAGE(PG8_SA(1, 0), a3, voffA);
            PG8_WAIT_V(8); PG8_WAIT_L(0); PG8_BAR; PG8_MMA(1, 0, At, B0); PG8_MMA(1, 1, At, B1); PG8_BAR; PG8_SCHED;
            } else {
            PG8_LDB(B0, 0, 0); PG8_SCHED; PG8_LDA(At, 0, 0); PG8_STAGE(PG8_SA(1, 1), a1 + hstep, voffA);
            PG8_WAIT_L(8); PG8_BAR; PG8_WAIT_L(0); PG8_MMA(0, 0, At, B0); PG8_BAR; PG8_SCHED;
            PG8_LDB(B1, 0, 1); PG8_STAGE(PG8_SB(0, 0), b2, voffB);
            PG8_BAR; PG8_WAIT_L(0); PG8_MMA(0, 1, At, B1); PG8_BAR;
            PG8_LDA(At, 0, 1); PG8_STAGE(PG8_SA(0, 0), a2, voffA);
            PG8_BAR; PG8_WAIT_L(0); PG8_MMA(1, 0, At, B0); PG8_BAR; PG8_SCHED;
            PG8_STAGE(PG8_SB(0, 1), b2 + hstep, voffB);
            PG8_WAIT_V(6); PG8_BAR; PG8_MMA(1, 1, At, B1); PG8_BAR;
            PG8_LDB(B0, 1, 0); PG8_SCHED; PG8_LDA(At, 1, 0); PG8_STAGE(PG8_SA(0, 1), a2 + hstep, voffA);
            PG8_WAIT_L(8); PG8_BAR; PG8_WAIT_L(0); PG8_MMA(0, 0, At, B0); PG8_BAR; PG8_SCHED;
            PG8_LDB(B1, 1, 1); PG8_STAGE(PG8_SB(1, 0), b3, voffB);
            PG8_BAR; PG8_WAIT_L(0); PG8_MMA(0, 1, At, B1); PG8_BAR;
            PG8_LDA(At, 1, 1); PG8_STAGE(PG8_SA(1, 0), a3, voffA);
            PG8_BAR; PG8_WAIT_L(0); PG8_MMA(1, 0, At, B0); PG8_BAR; PG8_SCHED;
            PG8_STAGE(PG8_SB(1, 1), b3 + hstep, voffB);
            PG8_WAIT_V(6); PG8_BAR; PG8_MMA(1, 1, At, B1); PG8_BAR;
            }
        }
        if constexpr (ALIGN_EPI) { if (wr == 0) PG8_BAR; }
        if constexpr (!Epi::AFTER_DRAIN) { E(acc, cur, wr, wc, fr, fq); S.done(cur); }
        if (!has_next) break;
        bool keep_ = false; if constexpr (pg8_keeps_acc<Epi>::value) keep_ = E.keep(cur);
        if (!keep_) {
#pragma unroll
        for (int a = 0; a < 2; ++a)
#pragma unroll
            for (int b = 0; b < 2; ++b)
#pragma unroll
                for (int m = 0; m < 4; ++m)
#pragma unroll
                    for (int n = 0; n < 2; ++n) acc[a][b][m][n] = (f32x4){0.f, 0.f, 0.f, 0.f};
        }
        cur = nxt; cA = nA; cB = nB; ++ui;
        if constexpr (ALIGN_EPI) { if (wr == 1) PG8_BAR; }
    }
    PG8_WAIT_V(0);
    if constexpr (!ALIGN_EPI) { if (wr == 0) PG8_BAR; }
    PG8_BAR;
    if constexpr (Epi::AFTER_DRAIN) { E.fused(acc, cur, wr, wc, fr, fq, lds, wid, lane); S.done(cur); }
#undef PG8_SA
#undef PG8_SB
#undef PG8_STAGE
#undef PG8_LDA
#undef PG8_LDB
#undef PG8_MMA
#undef PG8_WAIT_V
#undef PG8_WAIT_L
#undef PG8_BAR
#undef PG8_SCHED
}
}

#include <hip/hip_bf16.h>
#include <cmath>
namespace attn_body {
using bf16=__hip_bfloat16;
using bf16x8=__attribute__((ext_vector_type(8)))short;
using s16x4=__attribute__((ext_vector_type(4)))short;
using f32x16=__attribute__((ext_vector_type(16)))float;
using u32x4=__attribute__((ext_vector_type(4)))unsigned;
constexpr int SEQ=4096,D=64,DM=1024;
constexpr int NW=8,QBLK=32,QB=QBLK*NW,KVBLK=64,NQB=SEQ/QB;
constexpr int ATTN_PITCH=DM, ATTN_UNIT_ROWS=QB;
__device__ __forceinline__ int crow(int r,int hi){return (r&3)+8*(r>>2)+4*hi;}
#define SBAR() __builtin_amdgcn_sched_barrier(0)
__device__ __forceinline__ void cmask(f32x16&p0,f32x16&p1,int jb,int qrel,int hi){
  const float NEG=-INFINITY; int kb=64*jb+4*hi;
  #pragma unroll
  for(int r=0;r<16;++r){int kv=kb+(r&3)+8*(r>>2); if(kv>qrel)p0[r]=NEG; if(kv+32>qrel)p1[r]=NEG;}
}

constexpr int NSLOT=3, SLOTB=8192;
constexpr int LDS_K=0, LDS_V=NSLOT*SLOTB, LDS_WS=2*NSLOT*SLOTB, LDS_OST=LDS_WS+NW*64*4, LDS_BYTES=LDS_OST+NW*4096;
constexpr float C2=0.125f*1.4426950408889634f;
__device__ __forceinline__ void glds16(const void*gsrc,unsigned lds_dst){unsigned keep;
  asm volatile("s_mov_b32 %0, m0\n\ts_mov_b32 m0, %2\n\ts_nop 0\n\tglobal_load_lds_dwordx4 %1, off\n\ts_mov_b32 m0, %0":"=&s"(keep):"v"(gsrc),"s"(lds_dst):"memory");}
__device__ __forceinline__ float max3f(float a,float b,float c){float r;asm("v_max3_f32 %0, %1, %2, %3":"=v"(r):"v"(a),"v"(b),"v"(c));return r;}
__device__ __forceinline__ float max2f(float a,float b){float r;asm("v_max_f32_e32 %0, %1, %2":"=v"(r):"v"(a),"v"(b));return r;}
__device__ __forceinline__ float fadd_s(float a,float b){float r;asm("v_add_f32_e32 %0, %1, %2":"=v"(r):"v"(a),"v"(b));return r;}
__device__ __forceinline__ float fsub_s(float a,float b){float r;asm("v_sub_f32_e32 %0, %1, %2":"=v"(r):"v"(a),"v"(b));return r;}
typedef float f32x2_t __attribute__((ext_vector_type(2))); typedef __bf16 bf16x2_t __attribute__((ext_vector_type(2)));
__device__ __forceinline__ unsigned cvtpk_s(float lo,float hi){f32x2_t v={lo,hi};bf16x2_t b=__builtin_convertvector(v,bf16x2_t);return __builtin_bit_cast(unsigned,b);}
#define WAIT_BAR(N) asm volatile("s_waitcnt vmcnt(" #N ") lgkmcnt(0)\n\ts_barrier":::"memory")

__device__ __forceinline__ void qkt(f32x16&p0,f32x16&p1,const char*Kslot,const bf16x8*qr,const f32x16&negm,int r32,int hi){
  const char*kb=Kslot+hi*1024+r32*16;
  #pragma unroll
  for(int d0=0;d0<4;++d0){
    const bf16x8 b0=*reinterpret_cast<const bf16x8*>(kb+d0*2048);
    const bf16x8 b1=*reinterpret_cast<const bf16x8*>(kb+d0*2048+512);
    if(d0==0){p0=__builtin_amdgcn_mfma_f32_32x32x16_bf16(b0,qr[0],negm,0,0,0);p1=__builtin_amdgcn_mfma_f32_32x32x16_bf16(b1,qr[0],negm,0,0,0);}
    else{p0=__builtin_amdgcn_mfma_f32_32x32x16_bf16(b0,qr[d0],p0,0,0,0);p1=__builtin_amdgcn_mfma_f32_32x32x16_bf16(b1,qr[d0],p1,0,0,0);}}
}
typedef __attribute__((address_space(3))) const char* lds_cptr;
typedef short v4i16_t __attribute__((ext_vector_type(4)));
__device__ __forceinline__ void kload8(bf16x8*kf,lds_cptr kp){
  kf[0]=*(const __attribute__((address_space(3))) bf16x8*)(kp);      kf[1]=*(const __attribute__((address_space(3))) bf16x8*)(kp+512);
  kf[2]=*(const __attribute__((address_space(3))) bf16x8*)(kp+2048); kf[3]=*(const __attribute__((address_space(3))) bf16x8*)(kp+2560);
  kf[4]=*(const __attribute__((address_space(3))) bf16x8*)(kp+4096); kf[5]=*(const __attribute__((address_space(3))) bf16x8*)(kp+4608);
  kf[6]=*(const __attribute__((address_space(3))) bf16x8*)(kp+6144); kf[7]=*(const __attribute__((address_space(3))) bf16x8*)(kp+6656);
}
__device__ __forceinline__ void kload2(bf16x8*kf,lds_cptr kp,int j){ kf[2*j]=*(const __attribute__((address_space(3))) bf16x8*)(kp+j*2048); kf[2*j+1]=*(const __attribute__((address_space(3))) bf16x8*)(kp+j*2048+512); }
__device__ __forceinline__ s16x4 vtr(lds_cptr p){ return __builtin_bit_cast(s16x4,__builtin_amdgcn_ds_read_tr16_b64_v4i16((__attribute__((address_space(3))) v4i16_t*)p)); }
__device__ __forceinline__ float rowmax(const f32x16&p0,const f32x16&p1){
  float a=max3f(p0[0],p0[1],p1[0]),b=max3f(p0[2],p0[3],p1[1]);a=max3f(a,p1[2],p1[3]);
  #pragma unroll
  for(int r=4;r<16;r+=4){a=max3f(a,p0[r],p0[r+1]);b=max3f(b,p0[r+2],p0[r+3]);a=max3f(a,p1[r],p1[r+1]);b=max3f(b,p1[r+2],p1[r+3]);}
  const float m=max2f(a,b);
  auto rr=__builtin_amdgcn_permlane32_swap(__float_as_uint(m),__float_as_uint(m),false,false);
  return max2f(__uint_as_float(rr[0]),__uint_as_float(rr[1]));
}
__device__ __forceinline__ void pv(f32x16*o,int vb,bf16x8 pa0,bf16x8 pa1,bf16x8 pa2,bf16x8 pa3){
  #pragma unroll
  for(int d0=0;d0<2;++d0){s16x4 lo[4],hi[4];
    #pragma unroll
    for(int ks=0;ks<4;++ks){
      asm volatile("ds_read_b64_tr_b16 %0,%1 offset:%c2":"=&v"(lo[ks]):"v"(vb),"i"(d0*4096+ks*1024):"memory");
      asm volatile("ds_read_b64_tr_b16 %0,%1 offset:%c2":"=&v"(hi[ks]):"v"(vb),"i"(d0*4096+ks*1024+512):"memory");}
    asm volatile("s_waitcnt lgkmcnt(0)":::"memory");SBAR();
    #define PK(k) (bf16x8){lo[k][0],lo[k][1],lo[k][2],lo[k][3],hi[k][0],hi[k][1],hi[k][2],hi[k][3]}
    o[d0]=__builtin_amdgcn_mfma_f32_32x32x16_bf16(pa0,PK(0),o[d0],0,0,0);
    o[d0]=__builtin_amdgcn_mfma_f32_32x32x16_bf16(pa1,PK(1),o[d0],0,0,0);
    o[d0]=__builtin_amdgcn_mfma_f32_32x32x16_bf16(pa2,PK(2),o[d0],0,0,0);
    o[d0]=__builtin_amdgcn_mfma_f32_32x32x16_bf16(pa3,PK(3),o[d0],0,0,0);
    #undef PK
  }
}

#ifndef ATTN_STORE16
#define ATTN_STORE16(p,v) (*(u32x4*)(p)=(v))
#endif
template<int THRL> __device__ __forceinline__ void attn_unit(const bf16*Qh,const bf16*__restrict__ Kh,const bf16*__restrict__ Vh,bf16*Oh,int q0,char*shm){
  const int tid=threadIdx.x,lane=tid&63,r32=lane&31,hi=lane>>5; const int wid=__builtin_amdgcn_readfirstlane(tid>>6);
  const bf16*Qw=Qh+(long)(q0+wid*QBLK)*DM;
  const unsigned lds0=(unsigned)(uintptr_t)shm;
  float*wsf=(float*)(shm+LDS_WS)+wid*64;
  const bf16*ksrc=Kh+(long)lane*DM+wid*8;
  const bf16*vsrc=Vh+(long)(16*(wid&3)+(lane>>2))*DM+(wid>>2)*32+(lane&3)*8;
  const unsigned kdst=lds0+LDS_K+wid*1024, vdst=lds0+LDS_V+wid*1024;
  #define DMA_K(t,slot) glds16(ksrc+(long)(t)*KVBLK*DM,(unsigned)__builtin_amdgcn_readfirstlane(kdst+(slot)))
  #define DMA_V(t,slot) glds16(vsrc+(long)(t)*KVBLK*DM,(unsigned)__builtin_amdgcn_readfirstlane(vdst+(slot)))
  const int vb0=(int)(lds0+LDS_V)+((lane>>4)&1)*32+(lane&3)*8+(4*hi+((lane&15)>>2))*64;
  const char*Kbase=shm+LDS_K; bf16x8 kf[8];
  const lds_cptr shm3=(lds_cptr)shm; const lds_cptr kp0=shm3+LDS_K+hi*1024+r32*16; const lds_cptr vp0=shm3+LDS_V+((lane>>4)&1)*32+(lane&3)*8+(4*hi+((lane&15)>>2))*64;
  const int NT=SEQ/KVBLK;
  DMA_K(0,0);DMA_V(0,0);DMA_K(1,SLOTB);
  bf16x8 qr[4];
  #pragma unroll
  for(int d0=0;d0<4;++d0)qr[d0]=*reinterpret_cast<const bf16x8*>(&Qw[(long)r32*DM+d0*16+hi*8]);
  float mhat=0.f,l_reg=0.f;f32x16 o[2];o[0]=f32x16{};o[1]=f32x16{};f32x16 negm=f32x16{};asm volatile("":"+v"(negm));
  const int qrel=wid*QBLK+r32;
  #define CMASK(P0,P1,t) do{}while(0)
  bool resc=false;
  #define START(P0,P1) do{ const float rm=rowmax(P0,P1); resc=false; \
    { const float dl=rm; mhat=fadd_s(mhat,dl); \
      _Pragma("unroll") for(int r=0;r<16;++r){P0[r]=fsub_s(P0[r],dl);P1[r]=fsub_s(P1[r],dl);} \
      _Pragma("unroll") for(int r=0;r<16;++r)negm[r]=-mhat; asm volatile("":"+v"(negm)); } \
    _Pragma("unroll") for(int r=0;r<16;++r)P0[r]=__builtin_amdgcn_exp2f(P0[r]); }while(0)
  #define RESC() do{ if(resc){ asm volatile("s_waitcnt lgkmcnt(0)":::"memory"); \
      _Pragma("unroll") for(int d_=0;d_<2;++d_) _Pragma("unroll") for(int r=0;r<16;++r)o[d_][r]*=wsf[crow(r,hi)]; } }while(0)
  f32x16 pA0,pA1,pB0,pB1;
  int sl_prev=0,sl_cur=0,sl_next=SLOTB;
  #define ROT() do{sl_prev=sl_cur;sl_cur=sl_next;sl_next=(sl_next==(NSLOT-1)*SLOTB)?0:sl_next+SLOTB;}while(0)
  DMA_K(2,2*SLOTB);
  WAIT_BAR(3);
  qkt(pA0,pA1,Kbase,qr,negm,r32,hi);asm volatile("s_nop 15\n\ts_nop 7":"+v"(pA0),"+v"(pA1));CMASK(pA0,pA1,0);
  START(pA0,pA1);
  _Pragma("unroll") for(int r=0;r<16;++r)pA1[r]=__builtin_amdgcn_exp2f(pA1[r]);
  WAIT_BAR(0);
  DMA_K(3,0);DMA_V(1,SLOTB);
  ROT();
  kload8(kf,kp0+sl_cur);
  WAIT_BAR(2);
  s16x4 vlo[8],vhi[8]; u32x4 pw0,pw1,pw2,pw3;
  #define PKW(P,B) cvtpk_s(P[B],P[B+1])
  #define PAF(k) __builtin_bit_cast(bf16x8,pw##k)
  #define VFR(i) (bf16x8){vlo[i][0],vlo[i][1],vlo[i][2],vlo[i][3],vhi[i][0],vhi[i][1],vhi[i][2],vhi[i][3]}
  #define PIN(x) asm volatile("":"+v"(x))
  #define MX3(a,b,c) __builtin_fmaxf(__builtin_fmaxf((a),(b)),(c))
  #define GAPA(MF,A0,A1,A2,A3,W0,W1,PW) do{ MF; sacc+=A0; sacc+=A1; sacc+=A2; sacc+=A3; PIN(sacc); W0; W1; PIN(PW); SBAR(); }while(0)
  #define EX(v) __builtin_amdgcn_exp2f(v)
  #define GAPB(MF,X,B) do{ MF; X[B]=EX(X[B]); X[B+1]=EX(X[B+1]); X[B+2]=EX(X[B+2]); X[B+3]=EX(X[B+3]); PIN(X); SBAR(); }while(0)
  #define VRD(i) do{ vlo[i]=vtr(vp_+(((i)>>2)*4096+((i)&3)*1024)); vhi[i]=vtr(vp_+(((i)>>2)*4096+((i)&3)*1024+512)); }while(0)
  #define KRD(G,j) do{ if(G){ kload2(kf,kp0+sl_next,j); SBAR(); } }while(0)
  #define STEP(C0,C1,P0,P1,t,GK,GV,GL) do{ SBAR(); \
    const lds_cptr vp_=vp0+sl_prev; \
    VRD(0); SBAR(); float sacc=(P0[0]+P0[1]); \
    GAPA(C0=__builtin_amdgcn_mfma_f32_32x32x16_bf16(kf[0],qr[0],negm,0,0,0), P0[2],P0[3],P0[4],P0[5],     pw0[0]=PKW(P0,0), pw0[1]=PKW(P0,2), pw0); \
    VRD(4); SBAR(); GAPA(C1=__builtin_amdgcn_mfma_f32_32x32x16_bf16(kf[1],qr[0],negm,0,0,0), P0[6],P0[7],P0[8],P0[9],     pw0[2]=PKW(P0,4), pw0[3]=PKW(P0,6), pw0); \
    VRD(1); SBAR(); GAPA(C0=__builtin_amdgcn_mfma_f32_32x32x16_bf16(kf[2],qr[1],C0,0,0,0),   P0[10],P0[11],P0[12],P0[13], pw1[0]=PKW(P0,8), pw1[1]=PKW(P0,10), pw1); \
    VRD(5); SBAR(); GAPA(C1=__builtin_amdgcn_mfma_f32_32x32x16_bf16(kf[3],qr[1],C1,0,0,0),   P0[14],P0[15],P1[0],P1[1],   pw1[2]=PKW(P0,12),pw1[3]=PKW(P0,14), pw1); \
    VRD(2); SBAR(); GAPA(C0=__builtin_amdgcn_mfma_f32_32x32x16_bf16(kf[4],qr[2],C0,0,0,0),   P1[2],P1[3],P1[4],P1[5],     pw2[0]=PKW(P1,0), pw2[1]=PKW(P1,2), pw2); \
    VRD(6); SBAR(); GAPA(C1=__builtin_amdgcn_mfma_f32_32x32x16_bf16(kf[5],qr[2],C1,0,0,0),   P1[6],P1[7],P1[8],P1[9],     pw2[2]=PKW(P1,4), pw2[3]=PKW(P1,6), pw2); \
    VRD(3); SBAR(); GAPA(C0=__builtin_amdgcn_mfma_f32_32x32x16_bf16(kf[6],qr[3],C0,0,0,0),   P1[10],P1[11],P1[12],P1[13], pw3[0]=PKW(P1,8), pw3[1]=PKW(P1,10), pw3); \
    VRD(7); SBAR(); GAPA(C1=__builtin_amdgcn_mfma_f32_32x32x16_bf16(kf[7],qr[3],C1,0,0,0),   P1[14],P1[15],0.f,0.f,       pw3[2]=PKW(P1,12),pw3[3]=PKW(P1,14), pw3); \
    l_reg+=sacc; \
    if(GK){DMA_K((t)+3,sl_cur);} if(GV){DMA_V((t)+1,sl_next);} \
    CMASK(C0,C1,t); \
    { float a=MX3(C0[0],C0[1],C1[0]),b=MX3(C0[2],C0[3],C1[1]); a=MX3(a,C1[2],C1[3]); \
      _Pragma("unroll") for(int r=4;r<16;r+=4){a=MX3(a,C0[r],C0[r+1]);b=MX3(b,C0[r+2],C0[r+3]);a=MX3(a,C1[r],C1[r+1]);b=MX3(b,C1[r+2],C1[r+3]);} \
      float rm=__builtin_fmaxf(a,b); { auto rr=__builtin_amdgcn_permlane32_swap(__float_as_uint(rm),__float_as_uint(rm),false,false); rm=__builtin_fmaxf(__uint_as_float(rr[0]),__uint_as_float(rr[1])); } \
      resc=false; \
      if(__builtin_expect(__any(rm>(float)THRL),0)){ const float dl=__builtin_fmaxf(rm,0.f); mhat+=dl; \
        _Pragma("unroll") for(int r=0;r<16;++r){C0[r]-=dl;C1[r]-=dl;} \
        _Pragma("unroll") for(int r=0;r<16;++r)negm[r]=-mhat; asm volatile("":"+v"(negm)); \
        const float f=__builtin_amdgcn_exp2f(-dl); l_reg*=f; if(hi==0)wsf[r32]=f; resc=true; } } \
    SBAR(); \
    GAPB(o[0]=__builtin_amdgcn_mfma_f32_32x32x16_bf16(PAF(0),VFR(0),o[0],0,0,0), C0,0); \
    GAPB(o[1]=__builtin_amdgcn_mfma_f32_32x32x16_bf16(PAF(0),VFR(4),o[1],0,0,0), C0,4); \
    KRD(GL,0); GAPB(o[0]=__builtin_amdgcn_mfma_f32_32x32x16_bf16(PAF(1),VFR(1),o[0],0,0,0), C0,8); \
    KRD(GL,1); GAPB(o[1]=__builtin_amdgcn_mfma_f32_32x32x16_bf16(PAF(1),VFR(5),o[1],0,0,0), C0,12); \
    KRD(GL,2); GAPB(o[0]=__builtin_amdgcn_mfma_f32_32x32x16_bf16(PAF(2),VFR(2),o[0],0,0,0), C1,0); \
    KRD(GL,3); GAPB(o[1]=__builtin_amdgcn_mfma_f32_32x32x16_bf16(PAF(2),VFR(6),o[1],0,0,0), C1,4); \
    GAPB(o[0]=__builtin_amdgcn_mfma_f32_32x32x16_bf16(PAF(3),VFR(3),o[0],0,0,0), C1,8); \
    GAPB(o[1]=__builtin_amdgcn_mfma_f32_32x32x16_bf16(PAF(3),VFR(7),o[1],0,0,0), C1,12); \
    }while(0)
  int t=1;
  #undef CMASK
  #define CMASK(P0,P1,t) do{}while(0)
  for(;t+5<NT;t+=2){
    STEP(pB0,pB1,pA0,pA1,t,true,true,true);     WAIT_BAR(2); RESC(); ROT();
    STEP(pA0,pA1,pB0,pB1,t+1,true,true,true);   WAIT_BAR(2); RESC(); ROT();
  }
  #undef CMASK
  #define CMASK(P0,P1,t) do{}while(0)
  #define ENDW(tt) do{ if((tt)+3<NT){WAIT_BAR(2);} else if((tt)+2<NT){WAIT_BAR(1);} else {WAIT_BAR(0);} }while(0)
  for(;t+1<NT;t+=2){
    STEP(pB0,pB1,pA0,pA1,t,(t+3<NT),(t+1<NT),(t+1<NT));       ENDW(t);   RESC(); ROT();
    STEP(pA0,pA1,pB0,pB1,t+1,(t+4<NT),(t+2<NT),(t+2<NT));     ENDW(t+1); RESC(); ROT();
  }
  STEP(pB0,pB1,pA0,pA1,NT-1,false,false,false); RESC();
  { float sacc=pB0[0]+pB0[1]; _Pragma("unroll") for(int r=2;r<16;++r)sacc+=pB0[r]; _Pragma("unroll") for(int r=0;r<16;++r)sacc+=pB1[r]; l_reg+=sacc;
    pw0=(u32x4){PKW(pB0,0),PKW(pB0,2),PKW(pB0,4),PKW(pB0,6)};pw1=(u32x4){PKW(pB0,8),PKW(pB0,10),PKW(pB0,12),PKW(pB0,14)};pw2=(u32x4){PKW(pB1,0),PKW(pB1,2),PKW(pB1,4),PKW(pB1,6)};pw3=(u32x4){PKW(pB1,8),PKW(pB1,10),PKW(pB1,12),PKW(pB1,14)};
    SBAR(); pv(o,vb0+sl_cur,PAF(0),PAF(1),PAF(2),PAF(3)); }
  #undef PKW
  #undef PAF
  #undef VFR
  #undef PIN
  #undef MX3
  #undef GAPA
  #undef GAPB
  #undef EX
  #undef VRD
  #undef KRD
  #undef STEP
  #undef ENDW
  {auto rr=__builtin_amdgcn_permlane32_swap(__float_as_uint(l_reg),__float_as_uint(l_reg),false,false);l_reg=__uint_as_float(rr[0])+__uint_as_float(rr[1]);}
  if(hi==0)wsf[32+r32]=l_reg;asm volatile("s_waitcnt lgkmcnt(0)":::"memory");
  float rli[16];
  #pragma unroll
  for(int r=0;r<16;++r)rli[r]=__builtin_amdgcn_rcpf(wsf[32+crow(r,hi)]);
  bf16*Ow=Oh+(long)(q0+wid*QBLK)*DM;
  { bf16*stg=(bf16*)(shm+LDS_OST)+wid*2048;
    #pragma unroll
    for(int r=0;r<16;++r){const int orow=crow(r,hi);
      #pragma unroll
      for(int d0=0;d0<2;++d0)stg[orow*64+d0*32+r32]=__float2bfloat16(o[d0][r]*rli[r]);}
    asm volatile("s_waitcnt lgkmcnt(0)":::"memory");
    #pragma unroll
    for(int i=0;i<4;++i){const int row=i*8+(lane>>3),ch=lane&7; const u32x4 v=*(const u32x4*)(stg+row*64+ch*8); ATTN_STORE16(Ow+(long)row*DM+ch*8,v);} }
  asm volatile("s_waitcnt lgkmcnt(0)\n\ts_barrier":::"memory");
  #undef DMA_K
  #undef DMA_V
  #undef CMASK
  #undef START
  #undef RESC
  #undef ROT
}
constexpr int ATTN_LDS_BYTES=LDS_BYTES;
#undef SBAR
#undef WAIT_BAR
}

namespace attn2 {
using bf16x8 = __attribute__((ext_vector_type(8))) short;
using s16x4  = __attribute__((ext_vector_type(4))) short;
using f32x16 = __attribute__((ext_vector_type(16))) float;
using u32x4  = __attribute__((ext_vector_type(4))) unsigned;
constexpr int NW = 8, QBLK = 32, KVBLK = 64, LD = 1024, NT = 4096 / KVBLK;
constexpr float THR = 8.0f;
constexpr int SHM_V = KVBLK * 128 * 2, SHM_K = KVBLK * 64 * 2;
constexpr int OST_PITCH = 136;
#define KSWZ(row, colB) ((row) * 128 + ((colB) ^ ((((row) >> 1) & 7) << 4)))
#define SBAR() __builtin_amdgcn_sched_barrier(0)
__device__ __forceinline__ int crow(int r, int hi) { return (r & 3) + 8 * (r >> 2) + 4 * hi; }
__device__ __forceinline__ float bf2f_(unsigned short h) { return __builtin_bit_cast(float, (unsigned)h << 16); }
typedef float f32x2_t __attribute__((ext_vector_type(2))); typedef __bf16 bf16x2_t __attribute__((ext_vector_type(2)));
__device__ __forceinline__ unsigned cvtpk(float lo, float hi) { f32x2_t v = {lo, hi}; bf16x2_t b = __builtin_convertvector(v, bf16x2_t); return __builtin_bit_cast(unsigned, b); }
__device__ __forceinline__ void partialSM(f32x16& p0, f32x16& p1, float& m_reg, float& mn, float& alpha) {
  float pmax = p0[0]; for (int r = 1; r < 16; ++r) pmax = fmaxf(pmax, p0[r]); for (int r = 0; r < 16; ++r) pmax = fmaxf(pmax, p1[r]);
  { auto rr = __builtin_amdgcn_permlane32_swap(__float_as_uint(pmax), __float_as_uint(pmax), false, false);
    pmax = fmaxf(__uint_as_float(rr[0]), __uint_as_float(rr[1])); }
  { const bool keep = __all(pmax - m_reg <= THR);
    mn = keep ? m_reg : fmaxf(m_reg, pmax); alpha = keep ? 1.f : __builtin_amdgcn_exp2f(m_reg - mn); m_reg = mn; }
  for (int r = 0; r < 16; ++r) p0[r] = p0[r] - mn; for (int r = 0; r < 16; ++r) p1[r] = p1[r] - mn;
  for (int r = 0; r < 16; ++r) p0[r] = __builtin_amdgcn_exp2f(p0[r]);
}
__device__ __forceinline__ void finishSM(f32x16& p0, f32x16& p1, float alpha, float& l_reg, bf16x8& pa0, bf16x8& pa1, bf16x8& pa2, bf16x8& pa3) {
  for (int r = 0; r < 16; ++r) p1[r] = __builtin_amdgcn_exp2f(p1[r]);
  float ps = 0; for (int r = 0; r < 16; ++r) ps += p0[r]; for (int r = 0; r < 16; ++r) ps += p1[r];
  { auto rr = __builtin_amdgcn_permlane32_swap(__float_as_uint(ps), __float_as_uint(ps), false, false);
    ps = __uint_as_float(rr[0]) + __uint_as_float(rr[1]); }
  l_reg = l_reg * alpha + ps;
#define PK4(P, BASE, OUT) do { u32x4 w = {cvtpk(P[BASE + 0], P[BASE + 1]), cvtpk(P[BASE + 2], P[BASE + 3]), cvtpk(P[BASE + 4], P[BASE + 5]), cvtpk(P[BASE + 6], P[BASE + 7])}; OUT = *reinterpret_cast<bf16x8*>(&w); } while (0)
  PK4(p0, 0, pa0); PK4(p0, 8, pa1); PK4(p1, 0, pa2); PK4(p1, 8, pa3);
#undef PK4
}
__device__ __forceinline__ void qkt(f32x16& p0, f32x16& p1, const char* Ks, const bf16x8* qr, int r32, int hi) {
  p0 = f32x16{}; p1 = f32x16{};
  for (int d0 = 0; d0 < 4; ++d0) { int cb = (d0 * 16 + hi * 8) * 2;
    bf16x8 b0 = *reinterpret_cast<const bf16x8*>(Ks + KSWZ(r32, cb));
    bf16x8 b1 = *reinterpret_cast<const bf16x8*>(Ks + KSWZ(32 + r32, cb));
    p0 = __builtin_amdgcn_mfma_f32_32x32x16_bf16(b0, qr[d0], p0, 0, 0, 0);
    p1 = __builtin_amdgcn_mfma_f32_32x32x16_bf16(b1, qr[d0], p1, 0, 0, 0); }
}
__device__ __forceinline__ int v_st(int k, int c) { const int kk = (k & ~0xC) | ((k & 4) << 1) | ((k & 8) >> 1); return ((kk >> 3) * 4 + (c >> 5)) * 512 + ((kk & 7) * 32 + (c & 31)) * 2; }
__device__ __forceinline__ int v_rd_base(int lane) { return ((lane & 3) << 3) | (((lane >> 2) & 3) << 6) | (((lane >> 4) & 1) << 5) | (((lane >> 5) & 1) << 8); }
constexpr int v_rd_off(int d0, int ks, int half) { return d0 * 512 + ks * 4096 + half * 2048; }
typedef short v4i16_t __attribute__((ext_vector_type(4)));
typedef __attribute__((address_space(3))) const char* lds_cptr;
__device__ __forceinline__ s16x4 vtr(lds_cptr p) { return __builtin_bit_cast(s16x4, __builtin_amdgcn_ds_read_tr16_b64_v4i16((__attribute__((address_space(3))) v4i16_t*)p)); }
template <int D0> __device__ __forceinline__ void pv_one(f32x16& od, lds_cptr vp, bf16x8 pa0, bf16x8 pa1, bf16x8 pa2, bf16x8 pa3) {
  const s16x4 l0 = vtr(vp + v_rd_off(D0, 0, 0)), h0 = vtr(vp + v_rd_off(D0, 0, 1)), l1 = vtr(vp + v_rd_off(D0, 1, 0)), h1 = vtr(vp + v_rd_off(D0, 1, 1));
  const s16x4 l2 = vtr(vp + v_rd_off(D0, 2, 0)), h2 = vtr(vp + v_rd_off(D0, 2, 1)), l3 = vtr(vp + v_rd_off(D0, 3, 0)), h3 = vtr(vp + v_rd_off(D0, 3, 1));
#define PK(L, H) (bf16x8){L[0], L[1], L[2], L[3], H[0], H[1], H[2], H[3]}
  od = __builtin_amdgcn_mfma_f32_32x32x16_bf16(pa0, PK(l0, h0), od, 0, 0, 0);
  od = __builtin_amdgcn_mfma_f32_32x32x16_bf16(pa1, PK(l1, h1), od, 0, 0, 0);
  od = __builtin_amdgcn_mfma_f32_32x32x16_bf16(pa2, PK(l2, h2), od, 0, 0, 0);
  od = __builtin_amdgcn_mfma_f32_32x32x16_bf16(pa3, PK(l3, h3), od, 0, 0, 0);
#undef PK
}
__device__ __forceinline__ void pv_d0(f32x16* o, lds_cptr vp, bf16x8 pa0, bf16x8 pa1, bf16x8 pa2, bf16x8 pa3) {
  pv_one<0>(o[0], vp, pa0, pa1, pa2, pa3); pv_one<1>(o[1], vp, pa0, pa1, pa2, pa3); pv_one<2>(o[2], vp, pa0, pa1, pa2, pa3); pv_one<3>(o[3], vp, pa0, pa1, pa2, pa3);
}
__device__ __forceinline__ void glds16(const void* gsrc, unsigned lds_dst) { unsigned keep;
  asm volatile("s_mov_b32 %0, m0\n\ts_mov_b32 m0, %2\n\ts_nop 0\n\tglobal_load_lds_dwordx4 %1, off\n\ts_mov_b32 m0, %0" : "=&s"(keep) : "v"(gsrc), "s"(lds_dst) : "memory"); }
#define WAIT_BAR(N) asm volatile("s_waitcnt vmcnt(" #N ") lgkmcnt(0)\n\ts_barrier" ::: "memory")
constexpr int R_V = 0, R_K = 3 * SHM_V, R_WS = R_K + 3 * SHM_K, R_BYTES = R_WS + NW * 64 * 4;
static_assert(NW * 32 * OST_PITCH * 2 <= R_WS, "O stage fits under the rings");
template <int VAR> __device__ __forceinline__ void attn_unit(const bf16* __restrict__ Qb, const bf16* __restrict__ Kh, const bf16* __restrict__ Vh, bf16* __restrict__ Ob, char* lds) {
  const int tid = threadIdx.x, lane = tid & 63, r32 = lane & 31, hi = lane >> 5; const int wid = __builtin_amdgcn_readfirstlane(tid >> 6);
  char* V_lds = lds + R_V; char* K_lds = lds + R_K;
  float* ws = (float*)(lds + R_WS) + wid * 64; float* li_l = ws; float* al_l = ws + 32;
  const unsigned lds0 = (unsigned)(uintptr_t)lds;
  const int krow = 8 * wid + (lane >> 3), kch = (lane & 7) ^ ((krow >> 1) & 7);
  const bf16* ksrc = Kh + (long)krow * LD + 8 * kch;
  const int vkk = wid * 8 + ((lane & 31) >> 2), vk = vkk;
  const bf16* vsrc0 = Vh + (long)vk * LD + (lane >> 5) * 32 + 8 * (lane & 3);
  const bf16* vsrc1 = vsrc0 + 64;
  const unsigned kdst = lds0 + R_K + wid * 1024, vdst = lds0 + R_V + wid * 2048;
#define DMA_K(t, slotB) if constexpr (!(VAR & 4)) glds16(ksrc + (long)(t) * KVBLK * LD, (unsigned)__builtin_amdgcn_readfirstlane(kdst + (slotB)))
#define DMA_V(t, slotB) do { if constexpr (!(VAR & 4)) { glds16(vsrc0 + (long)(t) * KVBLK * LD, (unsigned)__builtin_amdgcn_readfirstlane(vdst + (slotB))); glds16(vsrc1 + (long)(t) * KVBLK * LD, (unsigned)__builtin_amdgcn_readfirstlane(vdst + (slotB) + 1024)); } } while (0)
  DMA_K(0, 0); DMA_V(0, 0); DMA_K(1, SHM_K); DMA_K(2, 2 * SHM_K);
  const unsigned bsel_w = ((((lane >> 4) & 1) != 0) == ((lane & 15) >= 8)) ? 0x3F803F80u : 0u;
  const bf16x8 bsel = __builtin_bit_cast(bf16x8, (u32x4){bsel_w, bsel_w, bsel_w, bsel_w});
  f32x4 osum = {};
  const int osrow = ((lane & 15) >= 8 ? 16 : 0) + 4 * (lane >> 4);
  float mhat = 0.f; f32x16 o[4] = {}; bf16x8 qr[4];
#define QNEG(m) __builtin_bit_cast(bf16x8, (u32x4){hi == 0 ? f2bf(-(m)) : 0u, 0u, 0u, 0u})
  const bf16x8 kone = __builtin_bit_cast(bf16x8, (u32x4){hi == 0 ? 0x3F80u : 0u, 0u, 0u, 0u});
  bf16x8 qneg = QNEG(0.f);
  const bf16* Qw = Qb + (long)(wid * QBLK + r32) * LD + hi * 8;
#pragma unroll
  for (int d0 = 0; d0 < 4; ++d0) qr[d0] = *reinterpret_cast<const bf16x8*>(Qw + d0 * 16);
  const lds_cptr vb0 = (lds_cptr)(__attribute__((address_space(3))) const char*)(__attribute__((address_space(3))) char*)((__attribute__((address_space(3))) char*)0 + ((unsigned)(uintptr_t)V_lds + v_rd_base(lane)));
#define RESC(a) do { if (__any((a) < 1.f)) { if (hi == 0) al_l[r32] = (a); asm volatile("s_waitcnt lgkmcnt(0)" ::: "memory"); \
    for (int d = 0; d < 4; ++d) for (int r = 0; r < 16; ++r) o[d][r] *= al_l[crow(r, hi)]; osum *= *(const f32x4*)(al_l + osrow); } } while (0)
  f32x16 pA0, pA1, pB0, pB1; float mnA, mnB, alA, alB; bf16x8 pa0, pa1, pa2, pa3;
  u32x4 pw0 = {}, pw1 = {}, pw2 = {}, pw3 = {}; s16x4 vAl0 = {}, vAl1 = {}, vAl2 = {}, vAl3 = {}, vAh0 = {}, vAh1 = {}, vAh2 = {}, vAh3 = {}, vBl0 = {}, vBl1 = {}, vBl2 = {}, vBl3 = {}, vBh0 = {}, vBh1 = {}, vBh2 = {}, vBh3 = {};
  const int kswz_ = ((r32 >> 1) & 7) << 4;
  const int koff0 = r32 * 128 + ((0 * 32 + hi * 16) ^ kswz_), koff1 = r32 * 128 + ((1 * 32 + hi * 16) ^ kswz_), koff2 = r32 * 128 + ((2 * 32 + hi * 16) ^ kswz_), koff3 = r32 * 128 + ((3 * 32 + hi * 16) ^ kswz_);
  WAIT_BAR(1);
  qkt(pA0, pA1, K_lds, qr, r32, hi);
  bf16x8 k00, k01, k10, k11, k20, k21, k30, k31;
  { const char* Kp_ = K_lds + SHM_K;
    k00 = *reinterpret_cast<const bf16x8*>(Kp_ + koff0); k01 = *reinterpret_cast<const bf16x8*>(Kp_ + koff0 + 4096); k10 = *reinterpret_cast<const bf16x8*>(Kp_ + koff1); k11 = *reinterpret_cast<const bf16x8*>(Kp_ + koff1 + 4096);
    k20 = *reinterpret_cast<const bf16x8*>(Kp_ + koff2); k21 = *reinterpret_cast<const bf16x8*>(Kp_ + koff2 + 4096); k30 = *reinterpret_cast<const bf16x8*>(Kp_ + koff3); k31 = *reinterpret_cast<const bf16x8*>(Kp_ + koff3 + 4096); }
  { float pmax = pA0[0]; for (int r = 1; r < 16; ++r) pmax = fmaxf(pmax, pA0[r]); for (int r = 0; r < 16; ++r) pmax = fmaxf(pmax, pA1[r]);
    { auto rr = __builtin_amdgcn_permlane32_swap(__float_as_uint(pmax), __float_as_uint(pmax), false, false); pmax = fmaxf(__uint_as_float(rr[0]), __uint_as_float(rr[1])); }
    mhat = bf2f_((unsigned short)f2bf(pmax)); qneg = QNEG(mhat); alA = 1.f; mnA = mhat;
    for (int r = 0; r < 16; ++r) { pA0[r] = __builtin_amdgcn_exp2f(pA0[r] - mhat); } for (int r = 0; r < 16; ++r) pA1[r] = pA1[r] - mhat; }
  DMA_V(1, SHM_V);
  WAIT_BAR(2);
  DMA_K(3, 0);
  int kc = 2 * SHM_K, kf = SHM_K, vp = 0, vf = 2 * SHM_V;
#ifndef ATT_SGB
#define ATT_SGB 0
#endif
#if ATT_SGB == 1
#define ATT_PIPE() do { __builtin_amdgcn_sched_group_barrier(0x100, 8, 0); \
    _Pragma("unroll") for (int g_ = 0; g_ < 8; ++g_) { __builtin_amdgcn_sched_group_barrier(0x8, 1, 0); __builtin_amdgcn_sched_group_barrier(0x100, 2, 0); __builtin_amdgcn_sched_group_barrier(0x2, 12, 0); } \
    _Pragma("unroll") for (int g_ = 0; g_ < 8; ++g_) { __builtin_amdgcn_sched_group_barrier(0x8, 1, 0); __builtin_amdgcn_sched_group_barrier(0x100, 2, 0); __builtin_amdgcn_sched_group_barrier(0x2, 6, 0); } \
    _Pragma("unroll") for (int g_ = 0; g_ < 8; ++g_) { __builtin_amdgcn_sched_group_barrier(0x8, 1, 0); __builtin_amdgcn_sched_group_barrier(0x2, 6, 0); } } while (0)
#elif ATT_SGB == 2
#define ATT_PIPE() __builtin_amdgcn_iglp_opt(2)
#elif ATT_SGB == 3
#define ATT_PIPE() __builtin_amdgcn_iglp_opt(3)
#else
#define ATT_PIPE() do {} while (0)
#endif
#define STEP(N0, N1, mnN, alN, O0, O1, alO, j) do { \
    if ((j) + 2 < NT) DMA_K((j) + 2, kf); if ((j) + 1 < NT) DMA_V((j) + 1, vf); \
    SBAR(); qkt(N0, N1, K_lds + kc, qr, r32, hi); \
    finishSM(O0, O1, alO, l_reg, pa0, pa1, pa2, pa3); \
    pv_d0(o, vb0 + vp, pa0, pa1, pa2, pa3); partialSM(N0, N1, m_reg, mnN, alN); \
    ATT_PIPE(); SBAR(); \
    RESC(alN); \
    if ((j) + 2 < NT) WAIT_BAR(3); else if ((j) + 1 < NT) WAIT_BAR(2); else WAIT_BAR(0); \
    { const int t_ = kf; kf = kc; kc = (kc == 2 * SHM_K) ? 0 : kc + SHM_K; (void)t_; } \
    { vf = vp; vp = (vp == 2 * SHM_V) ? 0 : vp + SHM_V; } } while (0)
#define MX3(a, b, c) __builtin_fmaxf(__builtin_fmaxf((a), (b)), (c))
#define PIN(x) asm volatile("" : "+v"(x))
#define STEP2(N0, N1, mnN, alN, O0, O1, alO, j) do { \
    if ((j) + 3 < NT) DMA_K((j) + 3, kf); if ((j) + 1 < NT) DMA_V((j) + 1, vf); \
    SBAR(); \
    const char* Kp_ = K_lds + kc; const lds_cptr vq_ = vb0 + vp; \
    unsigned ca0, ca1, cb0, cb1; \
    SBAR(); \
    N0 = __builtin_amdgcn_mfma_f32_32x32x16_bf16(kone, qneg, (f32x16){}, 0, 0, 0); N1 = __builtin_amdgcn_mfma_f32_32x32x16_bf16(kone, qneg, (f32x16){}, 0, 0, 0); SBAR(); \
     N0 = __builtin_amdgcn_mfma_f32_32x32x16_bf16(k00, qr[0], N0, 0, 0, 0); if constexpr (!(VAR & 1)) { ca0 = cvtpk(O0[0], O0[1]); ca1 = cvtpk(O0[2], O0[3]); } SBAR(); \
     N1 = __builtin_amdgcn_mfma_f32_32x32x16_bf16(k01, qr[0], N1, 0, 0, 0); if constexpr (!(VAR & 1)) { cb0 = cvtpk(O0[4], O0[5]); cb1 = cvtpk(O0[6], O0[7]); pw0 = (u32x4){ca0, ca1, cb0, cb1}; PIN(pw0); } SBAR(); \
     N0 = __builtin_amdgcn_mfma_f32_32x32x16_bf16(k10, qr[1], N0, 0, 0, 0); if constexpr (!(VAR & 1)) { ca0 = cvtpk(O0[8], O0[9]); ca1 = cvtpk(O0[10], O0[11]); } SBAR(); \
     N1 = __builtin_amdgcn_mfma_f32_32x32x16_bf16(k11, qr[1], N1, 0, 0, 0); if constexpr (!(VAR & 1)) { cb0 = cvtpk(O0[12], O0[13]); cb1 = cvtpk(O0[14], O0[15]); pw1 = (u32x4){ca0, ca1, cb0, cb1}; PIN(pw1); } SBAR(); \
    if constexpr (!(VAR & 8)) { vAl0 = vtr(vq_ + 0); vAh0 = vtr(vq_ + 2048); } N0 = __builtin_amdgcn_mfma_f32_32x32x16_bf16(k20, qr[2], N0, 0, 0, 0); if constexpr (!(VAR & 1)) { ca0 = cvtpk(O1[0], O1[1]); ca1 = cvtpk(O1[2], O1[3]); } SBAR(); \
    if constexpr (!(VAR & 8)) { vAl1 = vtr(vq_ + 4096); vAh1 = vtr(vq_ + 6144); } N1 = __builtin_amdgcn_mfma_f32_32x32x16_bf16(k21, qr[2], N1, 0, 0, 0); if constexpr (!(VAR & 1)) { cb0 = cvtpk(O1[4], O1[5]); cb1 = cvtpk(O1[6], O1[7]); pw2 = (u32x4){ca0, ca1, cb0, cb1}; PIN(pw2); } SBAR(); \
    if constexpr (!(VAR & 8)) { vAl2 = vtr(vq_ + 8192); vAh2 = vtr(vq_ + 10240); } N0 = __builtin_amdgcn_mfma_f32_32x32x16_bf16(k30, qr[3], N0, 0, 0, 0); if constexpr (!(VAR & 1)) { ca0 = cvtpk(O1[8], O1[9]); ca1 = cvtpk(O1[10], O1[11]); } SBAR(); \
    if constexpr (!(VAR & 8)) { vAl3 = vtr(vq_ + 12288); vAh3 = vtr(vq_ + 14336); } N1 = __builtin_amdgcn_mfma_f32_32x32x16_bf16(k31, qr[3], N1, 0, 0, 0); if constexpr (!(VAR & 1)) { cb0 = cvtpk(O1[12], O1[13]); cb1 = cvtpk(O1[14], O1[15]); pw3 = (u32x4){ca0, ca1, cb0, cb1}; PIN(pw3); } SBAR(); \
    float mxa_, mxb_, rm_; \
    if constexpr (!(VAR & 8)) { vBl0 = vtr(vq_ + 512); vBh0 = vtr(vq_ + 2560); } o[0] = __builtin_amdgcn_mfma_f32_32x32x16_bf16(__builtin_bit_cast(bf16x8, pw0), (bf16x8){vAl0[0], vAl0[1], vAl0[2], vAl0[3], vAh0[0], vAh0[1], vAh0[2], vAh0[3]}, o[0], 0, 0, 0); if constexpr (!(VAR & 2)) { mxa_ = MX3(N0[0], N0[1], N1[0]); mxb_ = MX3(N0[2], N0[3], N1[1]); mxa_ = MX3(mxa_, N1[2], N1[3]); mxa_ = MX3(mxa_, N0[4], N0[5]); mxb_ = MX3(mxb_, N0[6], N0[7]); mxa_ = MX3(mxa_, N1[4], N1[5]); mxb_ = MX3(mxb_, N1[6], N1[7]); PIN(mxa_); PIN(mxb_); } SBAR(); \
    if constexpr (!(VAR & 8)) { vBl1 = vtr(vq_ + 4608); vBh1 = vtr(vq_ + 6656); } o[0] = __builtin_amdgcn_mfma_f32_32x32x16_bf16(__builtin_bit_cast(bf16x8, pw1), (bf16x8){vAl1[0], vAl1[1], vAl1[2], vAl1[3], vAh1[0], vAh1[1], vAh1[2], vAh1[3]}, o[0], 0, 0, 0); if constexpr (!(VAR & 2)) { mxa_ = MX3(mxa_, N0[8], N0[9]); mxb_ = MX3(mxb_, N0[10], N0[11]); mxa_ = MX3(mxa_, N1[8], N1[9]); mxb_ = MX3(mxb_, N1[10], N1[11]); mxa_ = MX3(mxa_, N0[12], N0[13]); mxb_ = MX3(mxb_, N0[14], N0[15]); mxa_ = MX3(mxa_, N1[12], N1[13]); mxb_ = MX3(mxb_, N1[14], N1[15]); PIN(mxa_); PIN(mxb_); } SBAR(); \
    if constexpr (!(VAR & 8)) { vBl2 = vtr(vq_ + 8704); vBh2 = vtr(vq_ + 10752); } o[0] = __builtin_amdgcn_mfma_f32_32x32x16_bf16(__builtin_bit_cast(bf16x8, pw2), (bf16x8){vAl2[0], vAl2[1], vAl2[2], vAl2[3], vAh2[0], vAh2[1], vAh2[2], vAh2[3]}, o[0], 0, 0, 0); if constexpr (!(VAR & 2)) { rm_ = __builtin_fmaxf(mxa_, mxb_); { auto rr_ = __builtin_amdgcn_permlane32_swap(__float_as_uint(rm_), __float_as_uint(rm_), false, false); rm_ = __builtin_fmaxf(__uint_as_float(rr_[0]), __uint_as_float(rr_[1])); } alN = 1.f; if (__builtin_expect(!__all(rm_ <= THR), 0)) { const float mh2_ = bf2f_((unsigned short)f2bf(mhat + __builtin_fmaxf(rm_, 0.f))), dl_ = mh2_ - mhat; mhat = mh2_; alN = __builtin_amdgcn_exp2f(-dl_); _Pragma("unroll") for (int r_ = 0; r_ < 16; ++r_) { N0[r_] -= dl_; N1[r_] -= dl_; } qneg = QNEG(mhat); } PIN(alN); } SBAR(); \
    if constexpr (!(VAR & 8)) { vBl3 = vtr(vq_ + 12800); vBh3 = vtr(vq_ + 14848); } o[0] = __builtin_amdgcn_mfma_f32_32x32x16_bf16(__builtin_bit_cast(bf16x8, pw3), (bf16x8){vAl3[0], vAl3[1], vAl3[2], vAl3[3], vAh3[0], vAh3[1], vAh3[2], vAh3[3]}, o[0], 0, 0, 0); if constexpr (!(VAR & 2)) { N0[0] = __builtin_amdgcn_exp2f(N0[0]); N0[1] = __builtin_amdgcn_exp2f(N0[1]); N0[2] = __builtin_amdgcn_exp2f(N0[2]); N0[3] = __builtin_amdgcn_exp2f(N0[3]); PIN(N0); } SBAR(); \
    if constexpr (!(VAR & 8)) { vAl0 = vtr(vq_ + 1024); vAh0 = vtr(vq_ + 3072); } o[1] = __builtin_amdgcn_mfma_f32_32x32x16_bf16(__builtin_bit_cast(bf16x8, pw0), (bf16x8){vBl0[0], vBl0[1], vBl0[2], vBl0[3], vBh0[0], vBh0[1], vBh0[2], vBh0[3]}, o[1], 0, 0, 0); if constexpr (!(VAR & 2)) { N0[4] = __builtin_amdgcn_exp2f(N0[4]); N0[5] = __builtin_amdgcn_exp2f(N0[5]); N0[6] = __builtin_amdgcn_exp2f(N0[6]); N0[7] = __builtin_amdgcn_exp2f(N0[7]); PIN(N0); } SBAR(); \
    if constexpr (!(VAR & 8)) { vAl1 = vtr(vq_ + 5120); vAh1 = vtr(vq_ + 7168); } o[1] = __builtin_amdgcn_mfma_f32_32x32x16_bf16(__builtin_bit_cast(bf16x8, pw1), (bf16x8){vBl1[0], vBl1[1], vBl1[2], vBl1[3], vBh1[0], vBh1[1], vBh1[2], vBh1[3]}, o[1], 0, 0, 0); if constexpr (!(VAR & 2)) { N0[8] = __builtin_amdgcn_exp2f(N0[8]); N0[9] = __builtin_amdgcn_exp2f(N0[9]); N0[10] = __builtin_amdgcn_exp2f(N0[10]); N0[11] = __builtin_amdgcn_exp2f(N0[11]); PIN(N0); } SBAR(); \
    if constexpr (!(VAR & 8)) { vAl2 = vtr(vq_ + 9216); vAh2 = vtr(vq_ + 11264); } o[1] = __builtin_amdgcn_mfma_f32_32x32x16_bf16(__builtin_bit_cast(bf16x8, pw2), (bf16x8){vBl2[0], vBl2[1], vBl2[2], vBl2[3], vBh2[0], vBh2[1], vBh2[2], vBh2[3]}, o[1], 0, 0, 0); if constexpr (!(VAR & 2)) { N0[12] = __builtin_amdgcn_exp2f(N0[12]); N0[13] = __builtin_amdgcn_exp2f(N0[13]); N0[14] = __builtin_amdgcn_exp2f(N0[14]); N0[15] = __builtin_amdgcn_exp2f(N0[15]); PIN(N0); } SBAR(); \
    if constexpr (!(VAR & 8)) { vAl3 = vtr(vq_ + 13312); vAh3 = vtr(vq_ + 15360); } o[1] = __builtin_amdgcn_mfma_f32_32x32x16_bf16(__builtin_bit_cast(bf16x8, pw3), (bf16x8){vBl3[0], vBl3[1], vBl3[2], vBl3[3], vBh3[0], vBh3[1], vBh3[2], vBh3[3]}, o[1], 0, 0, 0); if constexpr (!(VAR & 2)) { N1[0] = __builtin_amdgcn_exp2f(N1[0]); N1[1] = __builtin_amdgcn_exp2f(N1[1]); N1[2] = __builtin_amdgcn_exp2f(N1[2]); N1[3] = __builtin_amdgcn_exp2f(N1[3]); PIN(N1); } SBAR(); \
    if constexpr (!(VAR & 8)) { vBl0 = vtr(vq_ + 1536); vBh0 = vtr(vq_ + 3584); } o[2] = __builtin_amdgcn_mfma_f32_32x32x16_bf16(__builtin_bit_cast(bf16x8, pw0), (bf16x8){vAl0[0], vAl0[1], vAl0[2], vAl0[3], vAh0[0], vAh0[1], vAh0[2], vAh0[3]}, o[2], 0, 0, 0); if constexpr (!(VAR & 2)) { N1[4] = __builtin_amdgcn_exp2f(N1[4]); N1[5] = __builtin_amdgcn_exp2f(N1[5]); N1[6] = __builtin_amdgcn_exp2f(N1[6]); N1[7] = __builtin_amdgcn_exp2f(N1[7]); PIN(N1); } SBAR(); \
    if constexpr (!(VAR & 8)) { vBl1 = vtr(vq_ + 5632); vBh1 = vtr(vq_ + 7680); } o[2] = __builtin_amdgcn_mfma_f32_32x32x16_bf16(__builtin_bit_cast(bf16x8, pw1), (bf16x8){vAl1[0], vAl1[1], vAl1[2], vAl1[3], vAh1[0], vAh1[1], vAh1[2], vAh1[3]}, o[2], 0, 0, 0); if constexpr (!(VAR & 2)) { N1[8] = __builtin_amdgcn_exp2f(N1[8]); N1[9] = __builtin_amdgcn_exp2f(N1[9]); N1[10] = __builtin_amdgcn_exp2f(N1[10]); N1[11] = __builtin_amdgcn_exp2f(N1[11]); PIN(N1); } SBAR(); \
    if constexpr (!(VAR & 8)) { vBl2 = vtr(vq_ + 9728); vBh2 = vtr(vq_ + 11776); } o[2] = __builtin_amdgcn_mfma_f32_32x32x16_bf16(__builtin_bit_cast(bf16x8, pw2), (bf16x8){vAl2[0], vAl2[1], vAl2[2], vAl2[3], vAh2[0], vAh2[1], vAh2[2], vAh2[3]}, o[2], 0, 0, 0); if constexpr (!(VAR & 2)) { N1[12] = __builtin_amdgcn_exp2f(N1[12]); N1[13] = __builtin_amdgcn_exp2f(N1[13]); N1[14] = __builtin_amdgcn_exp2f(N1[14]); N1[15] = __builtin_amdgcn_exp2f(N1[15]); PIN(N1); } SBAR(); \
    if constexpr (!(VAR & 8)) { vBl3 = vtr(vq_ + 13824); vBh3 = vtr(vq_ + 15872); } o[2] = __builtin_amdgcn_mfma_f32_32x32x16_bf16(__builtin_bit_cast(bf16x8, pw3), (bf16x8){vAl3[0], vAl3[1], vAl3[2], vAl3[3], vAh3[0], vAh3[1], vAh3[2], vAh3[3]}, o[2], 0, 0, 0);  SBAR(); \
    k00 = *reinterpret_cast<const bf16x8*>(Kp_ + koff0); k01 = *reinterpret_cast<const bf16x8*>(Kp_ + koff0 + 4096); o[3] = __builtin_amdgcn_mfma_f32_32x32x16_bf16(__builtin_bit_cast(bf16x8, pw0), (bf16x8){vBl0[0], vBl0[1], vBl0[2], vBl0[3], vBh0[0], vBh0[1], vBh0[2], vBh0[3]}, o[3], 0, 0, 0); osum = __builtin_amdgcn_mfma_f32_16x16x32_bf16(__builtin_bit_cast(bf16x8, pw0), bsel, osum, 0, 0, 0);  SBAR(); \
    k10 = *reinterpret_cast<const bf16x8*>(Kp_ + koff1); k11 = *reinterpret_cast<const bf16x8*>(Kp_ + koff1 + 4096); o[3] = __builtin_amdgcn_mfma_f32_32x32x16_bf16(__builtin_bit_cast(bf16x8, pw1), (bf16x8){vBl1[0], vBl1[1], vBl1[2], vBl1[3], vBh1[0], vBh1[1], vBh1[2], vBh1[3]}, o[3], 0, 0, 0); osum = __builtin_amdgcn_mfma_f32_16x16x32_bf16(__builtin_bit_cast(bf16x8, pw1), bsel, osum, 0, 0, 0);  SBAR(); \
    k20 = *reinterpret_cast<const bf16x8*>(Kp_ + koff2); k21 = *reinterpret_cast<const bf16x8*>(Kp_ + koff2 + 4096); o[3] = __builtin_amdgcn_mfma_f32_32x32x16_bf16(__builtin_bit_cast(bf16x8, pw2), (bf16x8){vBl2[0], vBl2[1], vBl2[2], vBl2[3], vBh2[0], vBh2[1], vBh2[2], vBh2[3]}, o[3], 0, 0, 0); osum = __builtin_amdgcn_mfma_f32_16x16x32_bf16(__builtin_bit_cast(bf16x8, pw2), bsel, osum, 0, 0, 0);  SBAR(); \
    k30 = *reinterpret_cast<const bf16x8*>(Kp_ + koff3); k31 = *reinterpret_cast<const bf16x8*>(Kp_ + koff3 + 4096); o[3] = __builtin_amdgcn_mfma_f32_32x32x16_bf16(__builtin_bit_cast(bf16x8, pw3), (bf16x8){vBl3[0], vBl3[1], vBl3[2], vBl3[3], vBh3[0], vBh3[1], vBh3[2], vBh3[3]}, o[3], 0, 0, 0); osum = __builtin_amdgcn_mfma_f32_16x16x32_bf16(__builtin_bit_cast(bf16x8, pw3), bsel, osum, 0, 0, 0);  SBAR(); \
    if constexpr (VAR & 2) { alN = 1.f; asm volatile("" :: "v"(N0), "v"(N1)); } \
    RESC(alN); \
    if constexpr (VAR & 4) WAIT_BAR(0); else { if ((j) + 3 < NT) WAIT_BAR(3); else if ((j) + 1 < NT) WAIT_BAR(2); else WAIT_BAR(0); } \
    { const int t_ = kf; kf = kc; kc = (kc == 2 * SHM_K) ? 0 : kc + SHM_K; (void)t_; } \
    { vf = vp; vp = (vp == 2 * SHM_V) ? 0 : vp + SHM_V; } } while (0)
  for (int r = 0; r < 16; ++r) pA1[r] = __builtin_amdgcn_exp2f(pA1[r]);
  for (int j = 1; j + 1 < NT; j += 2) {
    STEP2(pB0, pB1, mnB, alB, pA0, pA1, alA, j);
    STEP2(pA0, pA1, mnA, alA, pB0, pB1, alB, j + 1);
  }
  STEP2(pB0, pB1, mnB, alB, pA0, pA1, alA, NT - 1);
  {
#define PK4(P, BASE, OUT) do { u32x4 w = {cvtpk(P[BASE + 0], P[BASE + 1]), cvtpk(P[BASE + 2], P[BASE + 3]), cvtpk(P[BASE + 4], P[BASE + 5]), cvtpk(P[BASE + 6], P[BASE + 7])}; OUT = *reinterpret_cast<bf16x8*>(&w); } while (0)
    PK4(pB0, 0, pa0); PK4(pB0, 8, pa1); PK4(pB1, 0, pa2); PK4(pB1, 8, pa3);
#undef PK4
    SBAR(); pv_d0(o, vb0 + vp, pa0, pa1, pa2, pa3);
    osum = __builtin_amdgcn_mfma_f32_16x16x32_bf16(pa0, bsel, osum, 0, 0, 0); osum = __builtin_amdgcn_mfma_f32_16x16x32_bf16(pa1, bsel, osum, 0, 0, 0);
    osum = __builtin_amdgcn_mfma_f32_16x16x32_bf16(pa2, bsel, osum, 0, 0, 0); osum = __builtin_amdgcn_mfma_f32_16x16x32_bf16(pa3, bsel, osum, 0, 0, 0); }
#undef MX3
#undef PIN
  if ((lane & 7) == 0) *(f32x4*)(li_l + osrow) = osum;
  WAIT_BAR(0);
  float rli[16];
#pragma unroll
  for (int r = 0; r < 16; ++r) rli[r] = __builtin_amdgcn_rcpf(li_l[crow(r, hi)]);
  unsigned short* stg = (unsigned short*)lds + wid * 32 * OST_PITCH;
#pragma unroll
  for (int r = 0; r < 16; ++r) { const int orow = crow(r, hi);
#pragma unroll
    for (int d0 = 0; d0 < 4; ++d0) stg[orow * OST_PITCH + d0 * 32 + r32] = (unsigned short)f2bf(o[d0][r] * rli[r]); }
  asm volatile("s_waitcnt lgkmcnt(0)" ::: "memory");
  bf16* Ow = Ob + (long)(wid * QBLK) * LD;
#pragma unroll
  for (int i = 0; i < 8; ++i) { const int row = i * 4 + (lane >> 4), ch = lane & 15; const u32x4 v = *(const u32x4*)(stg + row * OST_PITCH + ch * 8); *(u32x4*)(Ow + (long)row * LD + ch * 8) = v; }
  WAIT_BAR(0);
#undef DMA_K
#undef DMA_V
#undef RESC
#undef STEP
#undef STEP2
#undef QNEG
}
#undef WAIT_BAR
#undef KSWZ
#undef SBAR
}

#define RLX_AGENT __ATOMIC_RELAXED, __HIP_MEMORY_SCOPE_AGENT
#define XB_TMO      128
#define XB_XCNT(j)  (256  + 64 * (j))
#define XB_XSUB(j)  (1280 + 64 * (j))
#define XB_XGEN(j)  (2304 + 64 * (j))
#define XB_TOP      3328
#define XB_TOPGEN   3392
#define XCD_BAR_WORDS 3456
#define XB_SPIN_CAP (1u << 18)

__device__ __forceinline__ unsigned xb_ld(unsigned* p)              { return __hip_atomic_load(p, __ATOMIC_RELAXED, __HIP_MEMORY_SCOPE_AGENT); }
__device__ __forceinline__ unsigned xb_add(unsigned* p, unsigned v) { return __hip_atomic_fetch_add(p, v, __ATOMIC_RELAXED, __HIP_MEMORY_SCOPE_AGENT); }
__device__ __forceinline__ unsigned xb_xcc_id() { return (unsigned)__builtin_amdgcn_s_getreg((3 << 11) | 20) & 0xFu; }
#define XB_SPIN(cond, bar) do { unsigned _sp = 0; while (cond) { __builtin_amdgcn_s_sleep(1); \
    if ((++_sp & 255u) == 0u) { if (xb_ld(&(bar)[XB_TMO])) break; if (_sp > XB_SPIN_CAP) { atomicAdd(&(bar)[XB_TMO], 1u); break; } } } } while (0)

struct XcdBarrier {
    unsigned* bar; unsigned x;
    volatile LAS unsigned* st;
};

__device__ __forceinline__ XcdBarrier xcd_barrier_post(unsigned* bar, volatile LAS unsigned* st) {
    XcdBarrier b; b.bar = bar; b.x = xb_xcc_id(); b.st = st;
    if (threadIdx.x == 0) (void)xb_add(&bar[XB_XCNT(b.x)], 1u);
    return b;
}
__device__ __forceinline__ void xcd_barrier_complete(unsigned* bar, unsigned x, unsigned& nloc, unsigned& nx) {
    const unsigned G = gridDim.x * gridDim.y * gridDim.z;
    unsigned sum, cnt, mine, sp = 0u;
    for (;;) {
        sum = 0u; cnt = 0u; mine = 0u;
#pragma unroll
        for (unsigned j = 0; j < 16; ++j) { const unsigned c = xb_ld(&bar[XB_XCNT(j)]); sum += c; cnt += (c > 0u) ? 1u : 0u; mine = (j == x) ? c : mine; }
        if (sum == G) break;
        __builtin_amdgcn_s_sleep(1);
        if ((++sp & 255u) == 0u) { if (xb_ld(&bar[XB_TMO])) break; if (sp > XB_SPIN_CAP) { atomicAdd(&bar[XB_TMO], 1u); break; } }
    }
    nloc = mine > 0u ? mine : 1u; nx = cnt > 0u ? cnt : 1u;
}

__device__ __forceinline__ void xcd_barrier(const XcdBarrier& b) {
    asm volatile("s_waitcnt vmcnt(0)" ::: "memory");
    __syncthreads();
    if (threadIdx.x == 0) {
        unsigned* bar = b.bar;
        __builtin_amdgcn_s_waitcnt(0);
        unsigned nloc = b.st[0], nx = b.st[1];
        if (nloc == 0u) { xcd_barrier_complete(bar, b.x, nloc, nx); b.st[0] = nloc; b.st[1] = nx; }
        const unsigned old = xb_add(&bar[XB_XSUB(b.x)], 1u);
        const unsigned gen = old / nloc;
        if (old + 1u == (gen + 1u) * nloc) {
            __builtin_amdgcn_fence(__ATOMIC_RELEASE, "agent");
            asm volatile("s_waitcnt vmcnt(0)" ::: "memory");
            const unsigned og = xb_add(&bar[XB_TOP], 1u);
            const unsigned tg = og / nx;
            if (og + 1u == (tg + 1u) * nx) xb_add(&bar[XB_TOPGEN], 1u);
            else XB_SPIN(xb_ld(&bar[XB_TOPGEN]) == tg, bar);
            __builtin_amdgcn_fence(__ATOMIC_ACQUIRE, "agent");
            xb_add(&bar[XB_XGEN(b.x)], 1u);
            asm volatile("s_waitcnt vmcnt(0)" ::: "memory");
        } else {
            XB_SPIN(xb_ld(&bar[XB_XGEN(b.x)]) == gen, bar);
            __builtin_amdgcn_fence(__ATOMIC_ACQUIRE, "agent");
            asm volatile("s_waitcnt vmcnt(0)" ::: "memory");
        }
    }
    __syncthreads();
}

__global__ void __launch_bounds__(512) k_pool_only(Params P) { ph_pool(P, blockIdx.x * 8 + (threadIdx.x >> 6), gridDim.x * 8, threadIdx.x & 63); }
template <class Epi> __global__ void __launch_bounds__(256) k_gemm_naive(const bf16* A, const bf16* Bt, int K, Epi epi) {
    __shared__ float As[64][33], Bs[64][33];
    const int tid = threadIdx.x, tx = tid & 15, ty = tid >> 4, gz = blockIdx.z;
    const size_t arow0 = (size_t)epi.a_row0(gz) + blockIdx.y * 64, brow0 = (size_t)epi.b_row0(gz) + blockIdx.x * 64;
    float acc[4][4];
#pragma unroll
    for (int i = 0; i < 4; ++i)
#pragma unroll
        for (int j = 0; j < 4; ++j) acc[i][j] = 0.f;
    const int lr = tid >> 2, lc = (tid & 3) * 8;
    for (int k0 = 0; k0 < K; k0 += 32) {
        const v4u a = *(const v4u*)(A + (arow0 + lr) * K + k0 + lc), b = *(const v4u*)(Bt + (brow0 + lr) * K + k0 + lc);
        As[lr][lc + 0] = bf_lo(a.x); As[lr][lc + 1] = bf_hi(a.x); As[lr][lc + 2] = bf_lo(a.y); As[lr][lc + 3] = bf_hi(a.y); As[lr][lc + 4] = bf_lo(a.z); As[lr][lc + 5] = bf_hi(a.z); As[lr][lc + 6] = bf_lo(a.w); As[lr][lc + 7] = bf_hi(a.w);
        Bs[lr][lc + 0] = bf_lo(b.x); Bs[lr][lc + 1] = bf_hi(b.x); Bs[lr][lc + 2] = bf_lo(b.y); Bs[lr][lc + 3] = bf_hi(b.y); Bs[lr][lc + 4] = bf_lo(b.z); Bs[lr][lc + 5] = bf_hi(b.z); Bs[lr][lc + 6] = bf_lo(b.w); Bs[lr][lc + 7] = bf_hi(b.w);
        __syncthreads();
#pragma unroll 8
        for (int k = 0; k < 32; ++k) { float av[4], bv[4];
#pragma unroll
            for (int i = 0; i < 4; ++i) { av[i] = As[ty * 4 + i][k]; bv[i] = Bs[tx * 4 + i][k]; }
#pragma unroll
            for (int i = 0; i < 4; ++i)
#pragma unroll
                for (int j = 0; j < 4; ++j) acc[i][j] += av[i] * bv[j]; }
        __syncthreads();
    }
#pragma unroll
    for (int i = 0; i < 4; ++i)
#pragma unroll
        for (int j = 0; j < 4; ++j) epi(gz, blockIdx.y * 64 + ty * 4 + i, blockIdx.x * 64 + tx * 4 + j, acc[i][j]);
}
struct NEpiIn { unsigned char* ws;
    __device__ int a_row0(int) const { return 0; } __device__ int b_row0(int) const { return 0; }
    __device__ void operator()(int, int r, int c, float z) const {
        if (c < 1024) ((bf16*)(ws + WS_U))[(size_t)r * D + c] = (bf16)f2bf(z);
        else if (c < 3072) ((float*)(ws + WS_QKF))[(size_t)r * 2048 + (c - 1024)] = z;
        else if (c < 4096) ((bf16*)(ws + WS_V))[(size_t)r * D + c - 3072] = (bf16)f2bf(z);
        else if (c < 5120) ((bf16*)(ws + WS_GP))[(size_t)r * D + c - 4096] = (bf16)f2bf(sigmoidf_(z));
        else ((bf16*)(ws + WS_GA))[(size_t)r * D + c - 5120] = (bf16)f2bf(sigmoidf_(z));
    } };
__global__ void __launch_bounds__(256) k_rope_naive(Params P) {
    const float* QKF = (const float*)(P.ws + WS_QKF); const float* cs = (const float*)(P.ws + WS_ROPE); bf16* Q = (bf16*)(P.ws + WS_Q); bf16* K = (bf16*)(P.ws + WS_K);
    for (size_t i = (size_t)blockIdx.x * 256 + threadIdx.x; i < (size_t)T * 2048; i += (size_t)gridDim.x * 256) { const int t = (int)(i >> 11), c = (int)(i & 2047), d = c & 63;
        float z = QKF[i];
        if (d < 8) z = z * cs[t * 16 + d] - QKF[i + 8] * cs[t * 16 + 8 + d];
        else if (d < 16) z = z * cs[t * 16 + d - 8] + QKF[i - 8] * cs[t * 16 + 8 + d - 8];
        if (c < 1024) Q[(size_t)t * D + c] = (bf16)f2bf(z * C2); else K[(size_t)t * D + c - 1024] = (bf16)f2bf(z); }
}
struct NEpiGate1 { unsigned char* ws;
    __device__ int a_row0(int) const { return 0; } __device__ int b_row0(int) const { return 0; }
    __device__ void operator()(int, int r, int c, float z) const { const size_t i = (size_t)r * D + c; ((bf16*)(ws + WS_MG))[i] = (bf16)f2bf(bf2f(((const bf16*)(ws + WS_GP))[i]) * z); } };
struct NEpiGate2 { unsigned char* ws;
    __device__ int a_row0(int) const { return 0; } __device__ int b_row0(int) const { return 0; }
    __device__ void operator()(int, int r, int c, float z) const { const size_t i = (size_t)r * D + c; bf16* mg = (bf16*)(ws + WS_MG); mg[i] = (bf16)f2bf(bf2f(mg[i]) + bf2f(((const bf16*)(ws + WS_GA))[i]) * z); } };
struct NEpiRes { const float* x; unsigned char* ws;
    __device__ int a_row0(int) const { return 0; } __device__ int b_row0(int) const { return 0; }
    __device__ void operator()(int, int r, int c, float z) const { const size_t i = (size_t)r * D + c; ((float*)(ws + WS_X2))[i] = x[i] + z; } };
__global__ void __launch_bounds__(256) k_up_naive(Params P) {
    __shared__ float As[64][33], Bg[64][33], Bu[64][33];
    const bf16* XS = (const bf16*)(P.ws + WS_XS); const bf16* W13 = (const bf16*)(P.ws + WS_W13); bf16* ACT = (bf16*)(P.ws + WS_ACT);
    const int tid = threadIdx.x, tx = tid & 15, ty = tid >> 4, gz = blockIdx.z, e = gz & 15;
    const size_t arow0 = (size_t)gz * CAP + blockIdx.y * 64; const int f0 = blockIdx.x * 64;
    const size_t grow0 = (size_t)e * 5632 + (f0 >> 7) * 256 + (f0 & 127), urow0 = grow0 + 128;
    float ag[4][4], au[4][4];
#pragma unroll
    for (int i = 0; i < 4; ++i)
#pragma unroll
        for (int j = 0; j < 4; ++j) { ag[i][j] = 0.f; au[i][j] = 0.f; }
    const int lr = tid >> 2, lc = (tid & 3) * 8;
    for (int k0 = 0; k0 < D; k0 += 32) {
        const v4u a = *(const v4u*)(XS + (arow0 + lr) * D + k0 + lc), g = *(const v4u*)(W13 + (grow0 + lr) * D + k0 + lc), u = *(const v4u*)(W13 + (urow0 + lr) * D + k0 + lc);
        As[lr][lc + 0] = bf_lo(a.x); As[lr][lc + 1] = bf_hi(a.x); As[lr][lc + 2] = bf_lo(a.y); As[lr][lc + 3] = bf_hi(a.y); As[lr][lc + 4] = bf_lo(a.z); As[lr][lc + 5] = bf_hi(a.z); As[lr][lc + 6] = bf_lo(a.w); As[lr][lc + 7] = bf_hi(a.w);
        Bg[lr][lc + 0] = bf_lo(g.x); Bg[lr][lc + 1] = bf_hi(g.x); Bg[lr][lc + 2] = bf_lo(g.y); Bg[lr][lc + 3] = bf_hi(g.y); Bg[lr][lc + 4] = bf_lo(g.z); Bg[lr][lc + 5] = bf_hi(g.z); Bg[lr][lc + 6] = bf_lo(g.w); Bg[lr][lc + 7] = bf_hi(g.w);
        Bu[lr][lc + 0] = bf_lo(u.x); Bu[lr][lc + 1] = bf_hi(u.x); Bu[lr][lc + 2] = bf_lo(u.y); Bu[lr][lc + 3] = bf_hi(u.y); Bu[lr][lc + 4] = bf_lo(u.z); Bu[lr][lc + 5] = bf_hi(u.z); Bu[lr][lc + 6] = bf_lo(u.w); Bu[lr][lc + 7] = bf_hi(u.w);
        __syncthreads();
#pragma unroll 4
        for (int k = 0; k < 32; ++k) { float av[4], gv[4], uv[4];
#pragma unroll
            for (int i = 0; i < 4; ++i) { av[i] = As[ty * 4 + i][k]; gv[i] = Bg[tx * 4 + i][k]; uv[i] = Bu[tx * 4 + i][k]; }
#pragma unroll
            for (int i = 0; i < 4; ++i)
#pragma unroll
                for (int j = 0; j < 4; ++j) { ag[i][j] += av[i] * gv[j]; au[i][j] += av[i] * uv[j]; } }
        __syncthreads();
    }
#pragma unroll
    for (int i = 0; i < 4; ++i)
#pragma unroll
        for (int j = 0; j < 4; ++j) { const float g = ag[i][j]; ACT[(arow0 + ty * 4 + i) * FF + f0 + tx * 4 + j] = (bf16)f2bf(g * sigmoidf_(g) * au[i][j]); }
}
struct NEpiDown { unsigned char* ws;
    __device__ int a_row0(int gz) const { return gz * CAP; } __device__ int b_row0(int gz) const { return (gz & 15) * D; }
    __device__ void operator()(int gz, int r, int c, float z) const { const size_t row = (size_t)gz * CAP + r; ((bf16*)(ws + WS_Y))[row * D + c] = (bf16)f2bf(z * ((const float*)(ws + WS_SELV))[row]); } };

__global__ void __launch_bounds__(256) k_attn_naive(Params P) {
    __shared__ __attribute__((aligned(16))) bf16 qs[4][128];
    __shared__ float ps[4][64][2];
    const bf16* Q = (const bf16*)(P.ws + WS_Q); const bf16* K = (const bf16*)(P.ws + WS_K); const bf16* V = (const bf16*)(P.ws + WS_V);
    bf16* O0 = (bf16*)(P.ws + WS_OV); bf16* O1 = O0 + (size_t)T * D;
    const int lane = threadIdx.x & 63, wave = threadIdx.x >> 6;
    const int item = blockIdx.x * 4 + wave, t = item >> 3, h = item & 7, b0 = t & ~(SEQ - 1);
    ((unsigned*)qs[wave])[lane] = ((const unsigned*)(Q + (size_t)t * D + h * 128))[lane];
    __syncthreads();
    auto score = [&](int key, float& s0, float& s1) {
        const v4u* kr = (const v4u*)(K + (size_t)(b0 + key) * D + h * 128); const v4u* qr = (const v4u*)qs[wave];
        float a0 = 0.f, a1 = 0.f;
#pragma unroll
        for (int ch = 0; ch < 16; ++ch) { const v4u kv = kr[ch], qv = qr[ch];
            const float d = bf_lo(kv.x) * bf_lo(qv.x) + bf_hi(kv.x) * bf_hi(qv.x) + bf_lo(kv.y) * bf_lo(qv.y) + bf_hi(kv.y) * bf_hi(qv.y) + bf_lo(kv.z) * bf_lo(qv.z) + bf_hi(kv.z) * bf_hi(qv.z) + bf_lo(kv.w) * bf_lo(qv.w) + bf_hi(kv.w) * bf_hi(qv.w);
            if (ch < 8) a0 += d; else a1 += d; }
        s0 = a0; s1 = a1; };
    float m0 = -1e30f, m1 = -1e30f, l0 = 0.f, l1 = 0.f;
    for (int c = 0; c < SEQ / 64; ++c) { float s0, s1; score(c * 64 + lane, s0, s1);
        const float n0 = fmaxf(m0, s0), n1 = fmaxf(m1, s1);
        l0 = l0 * exp2f(m0 - n0) + exp2f(s0 - n0); l1 = l1 * exp2f(m1 - n1) + exp2f(s1 - n1); m0 = n0; m1 = n1; }
    const float M0 = wave_max(m0), M1 = wave_max(m1);
    const float L0 = wave_sum(l0 * exp2f(m0 - M0)), L1 = wave_sum(l1 * exp2f(m1 - M1));
    float a00 = 0.f, a01 = 0.f, a10 = 0.f, a11 = 0.f;
    for (int c = 0; c < SEQ / 64; ++c) { float s0, s1; score(c * 64 + lane, s0, s1);
        ps[wave][lane][0] = exp2f(s0 - M0); ps[wave][lane][1] = exp2f(s1 - M1);
        __syncthreads();
        for (int j = 0; j < 64; ++j) { const unsigned vv = ((const unsigned*)(V + (size_t)(b0 + c * 64 + j) * D + h * 128))[lane];
            const float p0 = ps[wave][j][0], p1 = ps[wave][j][1];
            a00 += p0 * bf_lo(vv); a01 += p0 * bf_hi(vv); a10 += p1 * bf_lo(vv); a11 += p1 * bf_hi(vv); }
        __syncthreads(); }
    ((unsigned*)(O0 + (size_t)t * D + h * 128))[lane] = pk2(a00 / L0, a01 / L0);
    ((unsigned*)(O1 + (size_t)t * D + h * 128))[lane] = pk2(a10 / L1, a11 / L1);
}


#ifndef MK_FUSED
#define MK_FUSED 1
#endif
#ifndef PROBE_RLO
#define PROBE_RLO -1
#define PROBE_RHI -1
#endif
#ifndef IN_NA
#define IN_NA 3
#endif
#ifndef PROBE_VAR
#define PROBE_VAR 0
#endif
#ifndef PROBE_PARTS
#define PROBE_PARTS 63
#endif
#ifndef NAIVE_MASK
#define NAIVE_MASK 0
#endif
constexpr int NWAVES = 8, NPH = 11;
constexpr int RING_BYTES = 131072, LDSCTL_OFF = RING_BYTES, MISC_OFF = LDSCTL_OFF + 320, LDS_BYTES = 147456;
constexpr int CW_BAR = 4096;
typedef GAS unsigned gu32;

struct Args { Params P; int ph_lo, ph_hi, parts, pad; };
__global__ void __launch_bounds__(NWAVES * 64, 2) mega(Args args) {
    extern __shared__ __attribute__((aligned(16))) unsigned char lds[];
    const Params& P = args.P;
    LAS unsigned char* L = (LAS unsigned char*)lds;
    const int tid = threadIdx.x, lane = tid & 63, wave = __builtin_amdgcn_readfirstlane(tid >> 6);
    const int G = gridDim.x, bx = blockIdx.x, vcu = (G % 8 == 0) ? (bx % 8) * (G / 8) + bx / 8 : bx;
    const int gw = vcu * NWAVES + wave, ngw = G * NWAVES, gtid = vcu * (NWAVES * 64) + tid, ngt = G * NWAVES * 64;
    for (int u = tid; u < (LDS_BYTES - LDSCTL_OFF) / 4; u += NWAVES * 64) ((LAS unsigned*)(L + LDSCTL_OFF))[u] = 0u;
    __syncthreads();
    unsigned* ctl = (unsigned*)(P.ws + WS_CTL);
    XcdBarrier bar; bar.bar = ctl + CW_BAR; bar.x = 0; bar.st = nullptr;
    const int lo = args.ph_lo, hi = args.ph_hi;
    if (hi - lo > 1) bar = xcd_barrier_post(ctl + CW_BAR, (volatile LAS unsigned*)(L + MISC_OFF) + 8);
#define IN(k) (lo <= (k) && (k) < hi)
#define SEAM(k) do { if (IN(k) && IN((k) + 1)) xcd_barrier(bar); } while (0)
    unsigned char* ws = P.ws;

    if (IN(0)) { const int parts = args.parts; if (parts & 1) ph_weights(P, WT_FP8_PAIRS, WT_ALL_PAIRS, gw, ngw, lane, (LAS float*)(L + wave * 16384));     if (parts & 2) ph_rms_x(P, gw, ngw, lane); if (parts & 4) ph_rope(P, gtid, ngt); if (parts & 8) ph_wcomb(P, gtid, ngt); }
    SEAM(0);
    if (IN(1)) { const int xg = vcu >> 5, l = vcu & 31;
        if (l >= 16) { ph_weights(P, 0, WT_FP8_PAIRS, (xg * 16 + (l - 16)) * NWAVES + wave, 128 * NWAVES, lane, (LAS float*)(L + wave * 16384)); asm volatile("s_waitcnt vmcnt(0) lgkmcnt(0)" ::: "memory"); __syncthreads(); }
        pg8::Gemm g{(const bf16*)(ws + WS_XN), (const bf16*)(ws + WS_WIN), T, INC, D}; pg8::InOrder S{__builtin_amdgcn_readfirstlane(8 * xg), __builtin_amdgcn_readfirstlane(l >= 16 ? 16 * (12 - IN_NA) + (l - 16) : l), __builtin_amdgcn_readfirstlane(l >= 16 ? IN_NA : 12 - IN_NA)};
        pg8::EpiIn E{ws, (const float*)(ws + WS_ROPE)};
        pg8::gemm_phase<pg8::EpiIn, pg8::InOrder, true, true>(L, g, S, E); }
    SEAM(1);
    if (IN(2)) { if (args.parts & 16) ph_pool(P, gw, ngw, lane);
        const bf16* Q = (const bf16*)(ws + WS_Q); const bf16* K = (const bf16*)(ws + WS_K); const bf16* V = (const bf16*)(ws + WS_V); bf16* OV = (bf16*)(ws + WS_OV);
        const int g = vcu >> 3, b = g >> 3, h = g & 7;
        const size_t rb = (size_t)b * SEQ * D;
        const float lam = lam_value(P, lane);
        if (args.parts & 32) for (int i = 0; i < 2; ++i) { const int qb = (vcu & 7) * 2 + i; const size_t q0 = (size_t)(qb * 256) * D;
            for (int m = 0; m < 2; ++m) {
                const bf16* q_ = Q + rb + q0 + h * 128 + m * 64; const bf16* k_ = K + rb + h * 128 + m * 64; const bf16* v_ = V + rb + h * 128; bf16* o_ = OV + (size_t)m * T * D + rb + q0 + h * 128;
#if PROBE_VAR
                if (args.parts & 64) attn2::attn_unit<PROBE_VAR>(q_, k_, v_, o_, (char*)lds); else
#endif
                attn2::attn_unit<0>(q_, k_, v_, o_, (char*)lds); }
            asm volatile("s_waitcnt vmcnt(0)" ::: "memory"); __syncthreads();
            combine_block(P, b * SEQ + qb * 256, h, lam, wave, lane); } }
    SEAM(2);
    if (IN(4)) { pg8::MergeOrder S; S.so.init(T, D, G, bx); S.A0 = (const char*)(ws + WS_PD); S.A1 = (const char*)(ws + WS_O); S.B0 = (const char*)(ws + WS_WCOMB); S.B1 = (const char*)(ws + WS_WAO); S.tstep = (size_t)256 * D * 2;
        pg8::Gemm g{(const bf16*)(ws + WS_PD), (const bf16*)(ws + WS_WCOMB), T, D, D}; pg8::EpiMerge E{(const bf16*)(ws + WS_GP), (const bf16*)(ws + WS_GA), (bf16*)(ws + WS_MG)};
        pg8::gemm_phase<pg8::EpiMerge, pg8::MergeOrder, true, true>(L, g, S, E); }
    SEAM(4);
    if (IN(5)) { pg8::Gemm g{(const bf16*)(ws + WS_MG), (const bf16*)(ws + WS_WOUT), T, D, D}; pg8::StaticOrder S; S.init(T, D, G, bx);
        pg8::EpiRes E{P.x, (float*)(ws + WS_X2)};
        pg8::gemm_phase<pg8::EpiRes, pg8::StaticOrder, true, true>(L, g, S, E); }
    SEAM(5);
    if (IN(6)) { ph_router(P, vcu, G, tid, NWAVES * 64, (LAS float*)L); __syncthreads(); }
    SEAM(6);
    if (IN(7)) { ph_topk(P, vcu, G, tid, (LAS unsigned*)L); __syncthreads(); }
    SEAM(7);
    if (IN(8)) { pg8::Gemm g{(const bf16*)(ws + WS_XS), (const bf16*)(ws + WS_W13), NSEL, NE * 5632, D / 2}; pg8::UpOrder S{vcu >> 5, vcu & 31};
        pg8::EpiUp E{ws + WS_ACT};
        pg8::gemm_phase<pg8::EpiUp, pg8::UpOrder, true, true, true>(L, g, S, E); }
    SEAM(8);
    if (IN(9)) { pg8::Gemm g{(const bf16*)(ws + WS_ACT), (const bf16*)(ws + WS_WD), NSEL, NE * D, FF / 2}; pg8::DownOrder S{vcu >> 5, vcu & 31};
        pg8::EpiDown E{(bf16*)(ws + WS_Y), (const float*)(ws + WS_SELV)};
        pg8::gemm_phase<pg8::EpiDown, pg8::DownOrder, true, true, true>(L, g, S, E); }
    SEAM(9);
    if (IN(10)) ph_final(P, gw, ngw, lane);
#undef IN
#undef SEAM
}

extern "C" void kernel_launch(void* const* d_in, const int* in_sizes, int n_in, void* d_out, int out_size, void* d_ws, size_t ws_size, hipStream_t stream) {
    static int grid = 0;
    if (grid == 0) {
        if (n_in != 20 || in_sizes[0] != T * D || out_size != T * D || ws_size < WS_END) { fprintf(stderr, "kernel_launch: unexpected shapes (n_in %d, in0 %d, out %d, ws %zu, need %zu)\n", n_in, n_in > 0 ? in_sizes[0] : -1, out_size, ws_size, (size_t)WS_END); grid = -1; return; }
        int dev = 0, cus = 0;
        if (hipGetDevice(&dev) != hipSuccess || hipDeviceGetAttribute(&cus, hipDeviceAttributeMultiprocessorCount, dev) != hipSuccess) { grid = -1; return; }
        if (hipFuncSetAttribute((const void*)mega, hipFuncAttributeMaxDynamicSharedMemorySize, LDS_BYTES) != hipSuccess) { fprintf(stderr, "kernel_launch: hipFuncSetAttribute failed\n"); grid = -1; return; }
        if (cus != 256) { fprintf(stderr, "kernel_launch: built for a 256-CU device, found %d\n", cus); grid = -1; return; }
        grid = cus;
    }
    if (grid < 0) return;
    Args a{}; a.parts = 63;
    Params& P = a.P;
    P.x = (const float*)d_in[0]; P.pos = (const int*)d_in[1]; P.g_mix = (const float*)d_in[2]; P.w_in = (const float*)d_in[3]; P.w_pmix = (const float*)d_in[4]; P.pscale = (const float*)d_in[5];
    P.w_pout = (const float*)d_in[6]; P.lq1 = (const float*)d_in[7]; P.lk1 = (const float*)d_in[8]; P.lq2 = (const float*)d_in[9]; P.lk2 = (const float*)d_in[10]; P.g_sub = (const float*)d_in[11];
    P.w_ao = (const float*)d_in[12]; P.w_out = (const float*)d_in[13]; P.g_ffn = (const float*)d_in[14]; P.w_router = (const float*)d_in[15]; P.w_gate = (const float*)d_in[16]; P.w_up = (const float*)d_in[17];
    P.w_down = (const float*)d_in[18]; P.g_final = (const float*)d_in[19]; P.out = (float*)d_out; P.ws = (unsigned char*)d_ws;
#if MK_FUSED
    (void)hipMemsetAsync((char*)d_ws + WS_CTL, 0, 65536, stream);
#if PROBE_RLO >= 0
    a.ph_lo = 0; a.ph_hi = PROBE_RHI + 1; a.parts = PROBE_PARTS;
    hipLaunchKernelGGL(mega, dim3(grid), dim3(NWAVES * 64), LDS_BYTES, stream, a);
    (void)hipMemsetAsync((char*)d_ws + WS_CTL, 0, 65536, stream);
    a.ph_lo = PROBE_RLO; a.ph_hi = NPH; a.parts = 63;
    hipLaunchKernelGGL(mega, dim3(grid), dim3(NWAVES * 64), LDS_BYTES, stream, a);
#else
    a.ph_lo = 0; a.ph_hi = NPH;
    hipLaunchKernelGGL(mega, dim3(grid), dim3(NWAVES * 64), LDS_BYTES, stream, a);
#endif
#else
    unsigned char* ws = P.ws;
    for (int p = 0; p < NPH; ++p) {
        if ((NAIVE_MASK >> p) & 1) {
            if (p == 1) { k_gemm_naive<NEpiIn><<<dim3(INC / 64, T / 64, 1), 256, 0, stream>>>((const bf16*)(ws + WS_XN), (const bf16*)(ws + WS_WIN), D, NEpiIn{ws}); k_rope_naive<<<2048, 256, 0, stream>>>(P); continue; }
            if (p == 2) { a.ph_lo = 2; a.ph_hi = 2; k_pool_only<<<256, 512, 0, stream>>>(P); k_attn_naive<<<T * NH / 4, 256, 0, stream>>>(P); continue; }
            if (p == 4) { k_gemm_naive<NEpiGate1><<<dim3(D / 64, T / 64, 1), 256, 0, stream>>>((const bf16*)(ws + WS_PD), (const bf16*)(ws + WS_WCOMB), D, NEpiGate1{ws});
                          k_gemm_naive<NEpiGate2><<<dim3(D / 64, T / 64, 1), 256, 0, stream>>>((const bf16*)(ws + WS_O), (const bf16*)(ws + WS_WAO), D, NEpiGate2{ws}); continue; }
            if (p == 5) { k_gemm_naive<NEpiRes><<<dim3(D / 64, T / 64, 1), 256, 0, stream>>>((const bf16*)(ws + WS_MG), (const bf16*)(ws + WS_WOUT), D, NEpiRes{P.x, ws}); continue; }
            if (p == 8) { k_up_naive<<<dim3(FF / 64, CAP / 64, NB * NE), 256, 0, stream>>>(P); continue; }
            if (p == 9) { k_gemm_naive<NEpiDown><<<dim3(D / 64, CAP / 64, NB * NE), 256, 0, stream>>>((const bf16*)(ws + WS_ACT), (const bf16*)(ws + WS_WD), FF, NEpiDown{ws}); continue; }
        }
        a.ph_lo = p; a.ph_hi = p + 1;
        hipLaunchKernelGGL(mega, dim3(grid), dim3(NWAVES * 64), LDS_BYTES, stream, a);
    }
#endif
}
```

```cpp
#include <hip/hip_runtime.h>
#include <cstdio>
#include <cstdint>

#define GAS __attribute__((address_space(1)))
#define LAS __attribute__((address_space(3)))
typedef unsigned short bf16;
typedef unsigned v4u __attribute__((ext_vector_type(4)));
typedef unsigned v2u __attribute__((ext_vector_type(2)));
typedef float f32x4 __attribute__((ext_vector_type(4)));

constexpr int NB = 4, SEQ = 4096, T = NB * SEQ, D = 1024, NH = 8, INC = 6144, NE = 16, CAP = 512, FF = 2816;
constexpr int NSEL = NB * NE * CAP;
constexpr float EPS = 1e-6f;
constexpr float C2 = 0.18033688011112042f;
constexpr float LAM_INIT = 0.2f, ONE_M_LAM_INIT = 0.8f;

constexpr size_t MiB = 1u << 20;
constexpr size_t WS_CTL = 0, CTL_ZERO_BYTES = 1 * MiB;
constexpr size_t WS_ROPE = 1 * MiB;
constexpr size_t WS_AFF = 2 * MiB;
constexpr size_t WS_SELI = 3 * MiB;
constexpr size_t WS_SELV = 3 * MiB + 512 * 1024;
constexpr size_t WS_SLOT = 4 * MiB;
constexpr size_t WS_WIN = 6 * MiB;
constexpr size_t WS_WCOMB = 18 * MiB, WS_WAO = 20 * MiB, WS_WOUT = 22 * MiB;
constexpr size_t WS_W13 = 24 * MiB;
constexpr size_t WS_WD = 200 * MiB;
constexpr size_t WS_ACT0 = 288 * MiB;
constexpr size_t SLOTB = 32 * MiB;
constexpr size_t WS_Q = WS_ACT0 + 0 * SLOTB, WS_K = WS_ACT0 + 1 * SLOTB, WS_X2 = WS_ACT0;
constexpr size_t WS_XN = WS_ACT0 + 2 * SLOTB, WS_O = WS_XN, WS_H2 = WS_XN;
constexpr size_t WS_U = WS_ACT0 + 3 * SLOTB, WS_MG = WS_U;
constexpr size_t WS_V = WS_ACT0 + 4 * SLOTB, WS_GP = WS_ACT0 + 5 * SLOTB, WS_GA = WS_ACT0 + 6 * SLOTB, WS_PD = WS_ACT0 + 7 * SLOTB;
constexpr size_t WS_OV = WS_ACT0 + 8 * SLOTB;
constexpr size_t WS_XS = WS_ACT0 + 3 * SLOTB, WS_Y = WS_XS;
constexpr size_t WS_ACT = WS_ACT0 + 5 * SLOTB;
constexpr size_t WS_QKF = WS_ACT0 + 7 * SLOTB;
constexpr size_t WS_END = WS_ACT0 + 11 * SLOTB;

struct Params {
    const float* x; const int* pos; const float* g_mix; const float* w_in; const float* w_pmix; const float* pscale; const float* w_pout;
    const float *lq1, *lk1, *lq2, *lk2; const float* g_sub; const float* w_ao; const float* w_out; const float* g_ffn; const float* w_router;
    const float *w_gate, *w_up, *w_down; const float* g_final; float* out; unsigned char* ws;
};

__device__ const float ROPE_INV[8] = {1.0f, 0.1939227432012558f, 0.03760603070259094f, 0.007292664609849453f, 0.0014142135623842478f, 0.00027424818836152554f, 5.3182957344688475e-05f, 1.0313385246263351e-05f};

__device__ __forceinline__ unsigned f2bf(float f) { unsigned u = __builtin_bit_cast(unsigned, f); return (u + 0x7fffu + ((u >> 16) & 1u)) >> 16; }
__device__ __forceinline__ unsigned pk2(float lo, float hi) { return f2bf(lo) | (f2bf(hi) << 16); }
__device__ __forceinline__ float bf_lo(unsigned w) { return __builtin_bit_cast(float, w << 16); }
__device__ __forceinline__ float bf_hi(unsigned w) { return __builtin_bit_cast(float, w & 0xffff0000u); }
__device__ __forceinline__ float bf2f(bf16 h) { return __builtin_bit_cast(float, (unsigned)h << 16); }
__device__ __forceinline__ unsigned pk4_fp8(float a, float b, float c, float d) {
    a = __builtin_amdgcn_fmed3f(a, -448.f, 448.f); b = __builtin_amdgcn_fmed3f(b, -448.f, 448.f); c = __builtin_amdgcn_fmed3f(c, -448.f, 448.f); d = __builtin_amdgcn_fmed3f(d, -448.f, 448.f);
    int r = __builtin_amdgcn_cvt_pk_fp8_f32(a, b, 0, false); r = __builtin_amdgcn_cvt_pk_fp8_f32(c, d, r, true); return (unsigned)r; }
constexpr float W8_SCALE = 64.f, XS8_SCALE = 8.f, ACT8_SCALE = 4.f;
__device__ __forceinline__ float wave_sum(float v) {
#pragma unroll
    for (int o = 1; o < 64; o <<= 1) v += __shfl_xor(v, o);
    return v;
}
__device__ __forceinline__ float wave_max(float v) {
#pragma unroll
    for (int o = 1; o < 64; o <<= 1) v = fmaxf(v, __shfl_xor(v, o));
    return v;
}
__device__ __forceinline__ unsigned lds_add(LAS unsigned* p, unsigned v) { return __hip_atomic_fetch_add(p, v, __ATOMIC_RELAXED, __HIP_MEMORY_SCOPE_WORKGROUP); }
__device__ __forceinline__ float sigmoidf_(float z) { return 1.0f / (1.0f + __expf(-z)); }
__device__ __forceinline__ float lam_value(const Params& P, int lane) {
    const float a = wave_sum(P.lq1[lane] * P.lk1[lane]), b = wave_sum(P.lq2[lane] * P.lk2[lane]);
    return expf(a) - expf(b) + LAM_INIT;
}

__device__ __forceinline__ void rms_row_bf16(const float* xrow, const float* g, bf16* orow, int lane) {
    const f32x4* xr = (const f32x4*)xrow + lane;
    f32x4 v[4]; float s = 0.f;
#pragma unroll
    for (int j = 0; j < 4; ++j) { v[j] = xr[64 * j]; s += (v[j].x * v[j].x + v[j].y * v[j].y) + (v[j].z * v[j].z + v[j].w * v[j].w); }
    const float r = rsqrtf(wave_sum(s) * (1.f / D) + EPS);
    unsigned long long* o8 = (unsigned long long*)orow + lane;
#pragma unroll
    for (int j = 0; j < 4; ++j) { const f32x4 gg = ((const f32x4*)g)[lane + 64 * j];
        o8[64 * j] = (unsigned long long)pk2(v[j].x * r * gg.x, v[j].y * r * gg.y) | ((unsigned long long)pk2(v[j].z * r * gg.z, v[j].w * r * gg.w) << 32); }
}
__device__ __forceinline__ void ph_rms_x(const Params& P, int gw, int ngw, int lane) {
    bf16* XN = (bf16*)(P.ws + WS_XN);
    f32x4 gg[4], v[4], nv[4];
#pragma unroll
    for (int j = 0; j < 4; ++j) gg[j] = ((const f32x4*)P.g_mix)[lane + 64 * j];
    if (gw < T) {
#pragma unroll
        for (int j = 0; j < 4; ++j) v[j] = ((const f32x4*)(P.x + (size_t)gw * D) + lane)[64 * j]; }
    for (int m = gw; m < T; m += ngw) {
        if (m + ngw < T) {
#pragma unroll
            for (int j = 0; j < 4; ++j) nv[j] = ((const f32x4*)(P.x + (size_t)(m + ngw) * D) + lane)[64 * j]; }
        float s = 0.f;
#pragma unroll
        for (int j = 0; j < 4; ++j) s += (v[j].x * v[j].x + v[j].y * v[j].y) + (v[j].z * v[j].z + v[j].w * v[j].w);
        const float r = rsqrtf(wave_sum(s) * (1.f / D) + EPS);
        unsigned long long* o8 = (unsigned long long*)(XN + (size_t)m * D) + lane;
#pragma unroll
        for (int j = 0; j < 4; ++j) o8[64 * j] = (unsigned long long)pk2(v[j].x * r * gg[j].x, v[j].y * r * gg[j].y) | ((unsigned long long)pk2(v[j].z * r * gg[j].z, v[j].w * r * gg[j].w) << 32);
#pragma unroll
        for (int j = 0; j < 4; ++j) v[j] = nv[j];
    }
}
__device__ __forceinline__ void ph_rope(const Params& P, int gtid, int ngt) {
    float* cs = (float*)(P.ws + WS_ROPE);
    for (int i = gtid; i < T * 8; i += ngt) { const int t = i >> 3, k = i & 7;
        const float ang = (float)P.pos[t] * ROPE_INV[k];
        double fr = (double)ang * 0.15915494309189535; fr -= rint(fr);
        cs[t * 16 + k] = __builtin_amdgcn_cosf((float)fr); cs[t * 16 + 8 + k] = __builtin_amdgcn_sinf((float)fr); }
}
__device__ __forceinline__ void ph_wcomb(const Params& P, int gtid, int ngt) {
    bf16* WT = (bf16*)(P.ws + WS_WCOMB);
    for (int it = gtid; it < 512 * 256; it += ngt) { const int c0 = (it & 255) * 4, k0 = (it >> 8) * 2, g = k0 >> 8;
        f32x4 acc0 = {0.f, 0.f, 0.f, 0.f}, acc1 = acc0;
        const float* wm = P.w_pmix + (size_t)k0 * 256; const float* sc = P.pscale + g * 256; const float* wp = P.w_pout + (size_t)(g * 256) * D + c0;
#pragma unroll 4
        for (int j4 = 0; j4 < 64; ++j4) {
            const f32x4 m0 = *(const f32x4*)(wm + 4 * j4), m1 = *(const f32x4*)(wm + 256 + 4 * j4), s4 = *(const f32x4*)(sc + 4 * j4);
#pragma unroll
            for (int jj = 0; jj < 4; ++jj) { const f32x4 w4 = *(const f32x4*)(wp + (size_t)(4 * j4 + jj) * D) * s4[jj]; acc0 += w4 * m0[jj]; acc1 += w4 * m1[jj]; } }
#pragma unroll
        for (int cc = 0; cc < 4; ++cc) *(unsigned*)(WT + (size_t)(c0 + cc) * D + k0) = pk2(acc0[cc], acc1[cc]); }
}
struct WTile { const float* src; unsigned char* dst; int N, Kb, fp8; };
__device__ __forceinline__ WTile wtile_decode(const Params& P, int pair, int half) {
    constexpr int I_GU = 8 * 88, I_DN = 22 * 32, I_E = 2 * I_GU + I_DN, I_IN = 8 * 192, I_SQ = 8 * 32;
    WTile t; int r = pair;
    if (r < NE * I_E) { const int e = r / I_E; r -= e * I_E; t.fp8 = 1;
        if (r < 2 * I_GU) { const int up = r >= I_GU ? 1 : 0; r -= up * I_GU; const int kb = r / 88, nb = r % 88, n0 = 32 * nb, k0 = 128 * kb + 64 * half;
            const float* W = (up ? P.w_up : P.w_gate) + (size_t)e * D * FF; const int orow = (n0 >> 7) * 256 + (n0 & 127) + up * 128;
            t.src = W + (size_t)k0 * FF + n0; t.N = FF; t.Kb = D; t.dst = P.ws + WS_W13 + ((size_t)e * 5632 + orow) * D + k0; return t; }
        r -= 2 * I_GU;
        { const int kb = r / 32, nb = r % 32, n0 = 32 * nb, k0 = 128 * kb + 64 * half; const float* W = P.w_down + (size_t)e * FF * D;
          t.src = W + (size_t)k0 * D + n0; t.N = D; t.Kb = FF; t.dst = P.ws + WS_WD + ((size_t)e * D + n0) * FF + k0; return t; } }
    r -= NE * I_E; t.fp8 = 0;
    if (r < I_IN) { const int kb = r / 192, nb = r % 192, n0 = 32 * nb, k0 = 128 * kb + 64 * half; t.src = P.w_in + (size_t)k0 * INC + n0; t.N = INC; t.Kb = 2 * D; t.dst = P.ws + WS_WIN + ((size_t)n0 * D + k0) * 2; return t; }
    r -= I_IN;
    { const int which = r >= I_SQ ? 1 : 0; r -= which * I_SQ; const int kb = r / 32, nb = r % 32, n0 = 32 * nb, k0 = 128 * kb + 64 * half;
      t.src = (which ? P.w_out : P.w_ao) + (size_t)k0 * D + n0; t.N = D; t.Kb = 2 * D; t.dst = P.ws + (which ? WS_WOUT : WS_WAO) + ((size_t)n0 * D + k0) * 2; return t; }
}
#define WT_LOAD(buf, t) do { const float* sp_ = (t).src + (size_t)(lane >> 5) * (t).N + (lane & 31); _Pragma("unroll") for (int i = 0; i < 32; ++i) buf[i] = __builtin_nontemporal_load(sp_ + (size_t)(2 * i) * (t).N); } while (0)
#define WT_PROC(buf, t) do { _Pragma("unroll") for (int i = 0; i < 32; ++i) scr[(2 * i + (lane >> 5)) * 33 + (lane & 31)] = buf[i]; \
        asm volatile("s_waitcnt lgkmcnt(0)" ::: "memory"); const int c = lane & 7; \
        if ((t).fp8) { _Pragma("unroll") for (int jj = 0; jj < 4; ++jj) { const int n = (lane >> 3) + 8 * jj; const LAS float* s = scr + (8 * c) * 33 + n; \
                v2u o; o.x = pk4_fp8(s[0 * 33] * W8_SCALE, s[1 * 33] * W8_SCALE, s[2 * 33] * W8_SCALE, s[3 * 33] * W8_SCALE); o.y = pk4_fp8(s[4 * 33] * W8_SCALE, s[5 * 33] * W8_SCALE, s[6 * 33] * W8_SCALE, s[7 * 33] * W8_SCALE); \
                *(v2u*)((t).dst + (size_t)n * (t).Kb + 8 * c) = o; } } \
        else { _Pragma("unroll") for (int jj = 0; jj < 4; ++jj) { const int n = (lane >> 3) + 8 * jj; const LAS float* s = scr + (8 * c) * 33 + n; \
                v4u o; o.x = pk2(s[0 * 33], s[1 * 33]); o.y = pk2(s[2 * 33], s[3 * 33]); o.z = pk2(s[4 * 33], s[5 * 33]); o.w = pk2(s[6 * 33], s[7 * 33]); \
                *(v4u*)((t).dst + (size_t)n * (t).Kb + 16 * c) = o; } } \
        asm volatile("s_waitcnt lgkmcnt(0)" ::: "memory"); } while (0)
constexpr int WT_FP8_PAIRS = NE * (2 * 8 * 88 + 22 * 32), WT_ALL_PAIRS = WT_FP8_PAIRS + 8 * 192 + 2 * 8 * 32;
__device__ __forceinline__ void ph_weights(const Params& P, int pair0, int pair1, int gw, int ngw, int lane, LAS float* scr) {
    const int npw = (pair1 - pair0 - gw + ngw - 1) / ngw;
    if (npw <= 0) return;
    float va[32], vb[32];
    WTile ta = wtile_decode(P, pair0 + gw, 0), tb;
    WT_LOAD(va, ta);
    for (int p = 0; p < npw; ++p) {
        tb = wtile_decode(P, pair0 + gw + p * ngw, 1); WT_LOAD(vb, tb);
        WT_PROC(va, ta);
        if (p + 1 < npw) { ta = wtile_decode(P, pair0 + gw + (p + 1) * ngw, 0); WT_LOAD(va, ta); }
        WT_PROC(vb, tb);
    }
}
#undef WT_LOAD
#undef WT_PROC
__device__ __forceinline__ void pool_add(float (&a)[8], const v4u w, float sg) {
    a[0] += sg * bf_lo(w.x); a[1] += sg * bf_hi(w.x); a[2] += sg * bf_lo(w.y); a[3] += sg * bf_hi(w.y); a[4] += sg * bf_lo(w.z); a[5] += sg * bf_hi(w.z); a[6] += sg * bf_lo(w.w); a[7] += sg * bf_hi(w.w); }
template <int HW> __device__ __forceinline__ void pool_rows4(const bf16* U, bf16* PD, int t0, int c0) {
    const int s0 = t0 & (SEQ - 1), b0 = t0 - s0;
    constexpr int NR = 2 * HW + 3;
    v4u w[NR];
#pragma unroll
    for (int i = 0; i < NR; ++i) { const int r = s0 - HW + i, rc = min(max(r, 0), SEQ - 1); w[i] = *(const v4u*)(U + (size_t)(b0 + rc) * D + c0); }
#pragma unroll
    for (int i = 0; i < NR; ++i) { const int r = s0 - HW + i; if (r < 0 || r >= SEQ) w[i] = (v4u){0u, 0u, 0u, 0u}; }
    float acc[8];
#pragma unroll
    for (int j = 0; j < 8; ++j) acc[j] = 0.f;
#pragma unroll
    for (int i = 0; i < 2 * HW; ++i) pool_add(acc, w[i], 1.f);
#pragma unroll
    for (int k = 0; k < 4; ++k) { const int sr = s0 + k; const float inv = 1.0f / (float)(min(sr + HW, SEQ) - max(sr - HW, 0));
        const v4u c = w[k + HW];
        v4u o; o.x = pk2(acc[0] * inv - bf_lo(c.x), acc[1] * inv - bf_hi(c.x)); o.y = pk2(acc[2] * inv - bf_lo(c.y), acc[3] * inv - bf_hi(c.y));
        o.z = pk2(acc[4] * inv - bf_lo(c.z), acc[5] * inv - bf_hi(c.z)); o.w = pk2(acc[6] * inv - bf_lo(c.w), acc[7] * inv - bf_hi(c.w));
        *(v4u*)(PD + (size_t)(t0 + k) * D + c0) = o;
        if (k < 3) { pool_add(acc, w[k + 2 * HW], 1.f); pool_add(acc, w[k], -1.f); } }
}
__device__ __forceinline__ void ph_pool(const Params& P, int gw, int ngw, int lane) {
    const bf16* U = (const bf16*)(P.ws + WS_U); bf16* PD = (bf16*)(P.ws + WS_PD);
    for (int wi = gw; wi < (T / 8) * 4; wi += ngw) {
        const int grp = __builtin_amdgcn_readfirstlane(wi & 3), rb2 = wi >> 2;
        const int t0 = (rb2 * 2 + (lane >> 5)) * 4, c0 = grp * 256 + (lane & 31) * 8;
        if (grp == 0) pool_rows4<1>(U, PD, t0, c0); else if (grp == 1) pool_rows4<2>(U, PD, t0, c0); else if (grp == 2) pool_rows4<4>(U, PD, t0, c0); else pool_rows4<8>(U, PD, t0, c0);
    }
}
__device__ __forceinline__ void ph_combine(const Params& P, int gw, int ngw, int lane) {
    const bf16* O0 = (const bf16*)(P.ws + WS_OV); const bf16* O1 = O0 + (size_t)T * D; bf16* O = (bf16*)(P.ws + WS_O);
    const float lam = lam_value(P, lane);
    float gs[16];
#pragma unroll
    for (int i = 0; i < 16; ++i) gs[i] = P.g_sub[((16 * lane) & 127) + i] * ONE_M_LAM_INIT;
    for (int t = gw; t < T; t += ngw) {
        const v4u a0 = *(const v4u*)(O0 + (size_t)t * D + 16 * lane), a1 = *(const v4u*)(O0 + (size_t)t * D + 16 * lane + 8);
        const v4u b0 = *(const v4u*)(O1 + (size_t)t * D + 16 * lane), b1 = *(const v4u*)(O1 + (size_t)t * D + 16 * lane + 8);
        float d[16];
        d[0] = bf_lo(a0.x) - lam * bf_lo(b0.x); d[1] = bf_hi(a0.x) - lam * bf_hi(b0.x); d[2] = bf_lo(a0.y) - lam * bf_lo(b0.y); d[3] = bf_hi(a0.y) - lam * bf_hi(b0.y);
        d[4] = bf_lo(a0.z) - lam * bf_lo(b0.z); d[5] = bf_hi(a0.z) - lam * bf_hi(b0.z); d[6] = bf_lo(a0.w) - lam * bf_lo(b0.w); d[7] = bf_hi(a0.w) - lam * bf_hi(b0.w);
        d[8] = bf_lo(a1.x) - lam * bf_lo(b1.x); d[9] = bf_hi(a1.x) - lam * bf_hi(b1.x); d[10] = bf_lo(a1.y) - lam * bf_lo(b1.y); d[11] = bf_hi(a1.y) - lam * bf_hi(b1.y);
        d[12] = bf_lo(a1.z) - lam * bf_lo(b1.z); d[13] = bf_hi(a1.z) - lam * bf_hi(b1.z); d[14] = bf_lo(a1.w) - lam * bf_lo(b1.w); d[15] = bf_hi(a1.w) - lam * bf_hi(b1.w);
        float ss = 0.f;
#pragma unroll
        for (int i = 0; i < 16; ++i) ss += d[i] * d[i];
        ss += __shfl_xor(ss, 1); ss += __shfl_xor(ss, 2); ss += __shfl_xor(ss, 4);
        const float r = rsqrtf(ss * (1.f / 128.f) + EPS);
        v4u o0, o1;
        o0.x = pk2(d[0] * r * gs[0], d[1] * r * gs[1]); o0.y = pk2(d[2] * r * gs[2], d[3] * r * gs[3]); o0.z = pk2(d[4] * r * gs[4], d[5] * r * gs[5]); o0.w = pk2(d[6] * r * gs[6], d[7] * r * gs[7]);
        o1.x = pk2(d[8] * r * gs[8], d[9] * r * gs[9]); o1.y = pk2(d[10] * r * gs[10], d[11] * r * gs[11]); o1.z = pk2(d[12] * r * gs[12], d[13] * r * gs[13]); o1.w = pk2(d[14] * r * gs[14], d[15] * r * gs[15]);
        *(v4u*)(O + (size_t)t * D + 16 * lane) = o0; *(v4u*)(O + (size_t)t * D + 16 * lane + 8) = o1;
    }
}
__device__ __forceinline__ void combine_block(const Params& P, int t0, int h, float lam, int wave, int lane) {
    const bf16* O0 = (const bf16*)(P.ws + WS_OV); const bf16* O1 = O0 + (size_t)T * D; bf16* O = (bf16*)(P.ws + WS_O);
    const int cl = (lane & 7) * 16;
    float gs[16];
#pragma unroll
    for (int i = 0; i < 16; ++i) gs[i] = P.g_sub[cl + i] * ONE_M_LAM_INIT;
#pragma unroll
    for (int it = 0; it < 4; ++it) { const int t = t0 + wave * 32 + it * 8 + (lane >> 3); const size_t off = (size_t)t * D + h * 128 + cl;
        const v4u a0 = *(const v4u*)(O0 + off), a1 = *(const v4u*)(O0 + off + 8), b0 = *(const v4u*)(O1 + off), b1 = *(const v4u*)(O1 + off + 8);
        float d[16];
        d[0] = bf_lo(a0.x) - lam * bf_lo(b0.x); d[1] = bf_hi(a0.x) - lam * bf_hi(b0.x); d[2] = bf_lo(a0.y) - lam * bf_lo(b0.y); d[3] = bf_hi(a0.y) - lam * bf_hi(b0.y);
        d[4] = bf_lo(a0.z) - lam * bf_lo(b0.z); d[5] = bf_hi(a0.z) - lam * bf_hi(b0.z); d[6] = bf_lo(a0.w) - lam * bf_lo(b0.w); d[7] = bf_hi(a0.w) - lam * bf_hi(b0.w);
        d[8] = bf_lo(a1.x) - lam * bf_lo(b1.x); d[9] = bf_hi(a1.x) - lam * bf_hi(b1.x); d[10] = bf_lo(a1.y) - lam * bf_lo(b1.y); d[11] = bf_hi(a1.y) - lam * bf_hi(b1.y);
        d[12] = bf_lo(a1.z) - lam * bf_lo(b1.z); d[13] = bf_hi(a1.z) - lam * bf_hi(b1.z); d[14] = bf_lo(a1.w) - lam * bf_lo(b1.w); d[15] = bf_hi(a1.w) - lam * bf_hi(b1.w);
        float ss = 0.f;
#pragma unroll
        for (int i = 0; i < 16; ++i) ss += d[i] * d[i];
        ss += __shfl_xor(ss, 1); ss += __shfl_xor(ss, 2); ss += __shfl_xor(ss, 4);
        const float r = rsqrtf(ss * (1.f / 128.f) + EPS);
        v4u o0, o1;
        o0.x = pk2(d[0] * r * gs[0], d[1] * r * gs[1]); o0.y = pk2(d[2] * r * gs[2], d[3] * r * gs[3]); o0.z = pk2(d[4] * r * gs[4], d[5] * r * gs[5]); o0.w = pk2(d[6] * r * gs[6], d[7] * r * gs[7]);
        o1.x = pk2(d[8] * r * gs[8], d[9] * r * gs[9]); o1.y = pk2(d[10] * r * gs[10], d[11] * r * gs[11]); o1.z = pk2(d[12] * r * gs[12], d[13] * r * gs[13]); o1.w = pk2(d[14] * r * gs[14], d[15] * r * gs[15]);
        *(v4u*)(O + off) = o0; *(v4u*)(O + off + 8) = o1; }
}
__device__ __forceinline__ void ph_router(const Params& P, int bid, int nblk, int tid, int nthr, LAS float* wrT) {
    const int lane = tid & 63, wave = tid >> 6, nwv = nthr >> 6;
    { f32x4 w[8];
#pragma unroll
      for (int j = 0; j < 8; ++j) w[j] = ((const f32x4*)P.w_router)[tid + 512 * j];
#pragma unroll
      for (int j = 0; j < 8; ++j) { const int i4 = tid + 512 * j, d = i4 >> 2, e0 = (i4 & 3) * 4; wrT[(e0 + 0) * D + d] = w[j].x; wrT[(e0 + 1) * D + d] = w[j].y; wrT[(e0 + 2) * D + d] = w[j].z; wrT[(e0 + 3) * D + d] = w[j].w; } }
    __syncthreads();
    const bf16* X2 = (const bf16*)(P.ws + WS_X2); bf16* H2 = (bf16*)(P.ws + WS_H2); float* AFF = (float*)(P.ws + WS_AFF);
    f32x4 gg[4];
#pragma unroll
    for (int j = 0; j < 4; ++j) gg[j] = ((const f32x4*)P.g_ffn)[lane + 64 * j];
    const int t0 = bid * nwv + wave, tstride = nblk * nwv;
    f32x4 v[4]; v2u cv[4], nv[4];
    if (t0 < T) {
#pragma unroll
        for (int j = 0; j < 4; ++j) cv[j] = ((const v2u*)(X2 + (size_t)t0 * D) + lane)[64 * j]; }
    for (int t = t0; t < T; t += tstride) {
        const int tn = t + tstride;
        if (tn < T) {
#pragma unroll
            for (int j = 0; j < 4; ++j) nv[j] = ((const v2u*)(X2 + (size_t)tn * D) + lane)[64 * j]; }
#pragma unroll
        for (int j = 0; j < 4; ++j) { v[j].x = bf_lo(cv[j].x); v[j].y = bf_hi(cv[j].x); v[j].z = bf_lo(cv[j].y); v[j].w = bf_hi(cv[j].y); }
        float s = 0.f;
#pragma unroll
        for (int j = 0; j < 4; ++j) s += (v[j].x * v[j].x + v[j].y * v[j].y) + (v[j].z * v[j].z + v[j].w * v[j].w);
        const float r = rsqrtf(wave_sum(s) * (1.f / D) + EPS);
        unsigned long long* o8 = (unsigned long long*)(H2 + (size_t)t * D) + lane;
#pragma unroll
        for (int j = 0; j < 4; ++j) { v[j].x = v[j].x * r * gg[j].x; v[j].y = v[j].y * r * gg[j].y; v[j].z = v[j].z * r * gg[j].z; v[j].w = v[j].w * r * gg[j].w;
            o8[64 * j] = (unsigned long long)pk2(v[j].x, v[j].y) | ((unsigned long long)pk2(v[j].z, v[j].w) << 32); }
        float mylg = 0.f;
#pragma unroll 4
        for (int e = 0; e < 16; ++e) { float a = 0.f;
#pragma unroll
            for (int j = 0; j < 4; ++j) { const f32x4 w = *(const LAS f32x4*)(wrT + e * D + 256 * j + 4 * lane); a += (v[j].x * w.x + v[j].y * w.y) + (v[j].z * w.z + v[j].w * w.w); }
            const float tot = wave_sum(a); mylg = (lane == e) ? tot : mylg; }
        float mx = mylg;
        mx = fmaxf(mx, __shfl_xor(mx, 1)); mx = fmaxf(mx, __shfl_xor(mx, 2)); mx = fmaxf(mx, __shfl_xor(mx, 4)); mx = fmaxf(mx, __shfl_xor(mx, 8));
        const float mine = expf(mylg - mx); float den = mine;
        den += __shfl_xor(den, 1); den += __shfl_xor(den, 2); den += __shfl_xor(den, 4); den += __shfl_xor(den, 8);
        if (lane < 16) AFF[((size_t)(t >> 12) * NE + lane) * SEQ + (t & (SEQ - 1))] = mine / den;
#pragma unroll
        for (int j = 0; j < 4; ++j) cv[j] = nv[j];
    }
}
__device__ __forceinline__ void ph_topk(const Params& P, int bid, int nblk, int tid, LAS unsigned* sm) {
    const float* AFF = (const float*)(P.ws + WS_AFF); int* SELI = (int*)(P.ws + WS_SELI); float* SELV = (float*)(P.ws + WS_SELV); int* SLOT = (int*)(P.ws + WS_SLOT);
    const bf16* H2 = (const bf16*)(P.ws + WS_H2); unsigned char* XS = P.ws + WS_XS;
    LAS unsigned* hist = sm;
    LAS unsigned* wtot = sm + 256;
    LAS unsigned* ctl = sm + 272;
    LAS unsigned* cgt = sm + 320;
    LAS unsigned* ceq = sm + 384;
    LAS int* chosen = (LAS int*)(sm + 512);
    const int lane = tid & 63, wave = tid >> 6;
    for (int item = bid; item < NB * NE * 4; item += nblk) {
        const int li = item >> 2, q = item & 3, b = li >> 4, e = li & 15;
        const float* a = AFF + (size_t)li * SEQ;
        unsigned key[8];
#pragma unroll
        for (int i = 0; i < 8; ++i) key[i] = __builtin_bit_cast(unsigned, a[i * 512 + tid]);
        unsigned prefix = 0u, k = CAP;
#pragma unroll 1
        for (int rnd = 0; rnd < 4; ++rnd) { const int shift = 24 - 8 * rnd;
            if (tid < 256) hist[tid] = 0u;
            __syncthreads();
#pragma unroll
            for (int i = 0; i < 8; ++i) { const bool in = (rnd == 0) ? true : ((key[i] >> (shift + 8)) == prefix); if (in) lds_add(&hist[(key[i] >> shift) & 255u], 1u); }
            __syncthreads();
            unsigned h = 0u, sfx = 0u;
            if (tid < 256) { h = hist[tid]; sfx = h;
#pragma unroll
                for (int o = 1; o < 64; o <<= 1) { const unsigned tt = __shfl_down(sfx, o); if (lane + o < 64) sfx += tt; }
                if (lane == 0) wtot[wave] = sfx; }
            __syncthreads();
            if (tid < 256) { unsigned above = 0u;
#pragma unroll
                for (int w = 1; w < 4; ++w) above += (w > wave) ? wtot[w] : 0u;
                const unsigned incl = sfx + above, excl = incl - h;
                if (incl >= k && excl < k) { ctl[2 * rnd] = (prefix << 8) | (unsigned)tid; ctl[2 * rnd + 1] = k - excl; } }
            __syncthreads();
            prefix = ctl[2 * rnd]; k = ctl[2 * rnd + 1];
        }
        const unsigned thr = prefix, need_eq = k;
        unsigned long long gtm[8], eqm[8];
#pragma unroll
        for (int i = 0; i < 8; ++i) { gtm[i] = __ballot(key[i] > thr); eqm[i] = __ballot(key[i] == thr);
            if (lane == 0) { cgt[i * 8 + wave] = (unsigned)__popcll(gtm[i]); ceq[i * 8 + wave] = (unsigned)__popcll(eqm[i]); } }
        __syncthreads();
        if (wave == 0) { const unsigned g0 = cgt[lane], e0 = ceq[lane]; unsigned gs = g0, es = e0;
#pragma unroll
            for (int o = 1; o < 64; o <<= 1) { const unsigned tg = __shfl_up(gs, o), te = __shfl_up(es, o); if (lane >= o) { gs += tg; es += te; } }
            cgt[lane] = gs - g0; ceq[lane] = es - e0; }
        __syncthreads();
        const unsigned long long lt = (1ull << lane) - 1ull;
#pragma unroll
        for (int i = 0; i < 8; ++i) { const int s = i * 512 + tid;
            const unsigned bg = cgt[i * 8 + wave] + (unsigned)__popcll(gtm[i] & lt), be = ceq[i * 8 + wave] + (unsigned)__popcll(eqm[i] & lt);
            const bool isgt = key[i] > thr, iseq = key[i] == thr, sel = isgt || (iseq && be < need_eq);
            const int c = (int)(bg + (be < need_eq ? be : need_eq));
            if (sel && (c >> 7) == q) { chosen[c & 127] = s; SELI[li * CAP + c] = s; SELV[li * CAP + c] = __builtin_bit_cast(float, key[i]); }
            if ((i >> 1) == q) SLOT[((size_t)b * SEQ + s) * NE + e] = sel ? c : -1; }
        __syncthreads();
#pragma unroll 4
        for (int cc = wave; cc < 128; cc += 8) { const int s = chosen[cc];
            const v4u* src = (const v4u*)(H2 + ((size_t)b * SEQ + s) * D) + 2 * lane; v4u* dst = (v4u*)(XS + ((size_t)li * CAP + q * 128 + cc) * D) + lane;
            const v4u x0 = src[0], x1 = src[1]; v4u o;
            o.x = pk4_fp8(bf_lo(x0.x) * XS8_SCALE, bf_hi(x0.x) * XS8_SCALE, bf_lo(x0.y) * XS8_SCALE, bf_hi(x0.y) * XS8_SCALE); o.y = pk4_fp8(bf_lo(x0.z) * XS8_SCALE, bf_hi(x0.z) * XS8_SCALE, bf_lo(x0.w) * XS8_SCALE, bf_hi(x0.w) * XS8_SCALE);
            o.z = pk4_fp8(bf_lo(x1.x) * XS8_SCALE, bf_hi(x1.x) * XS8_SCALE, bf_lo(x1.y) * XS8_SCALE, bf_hi(x1.y) * XS8_SCALE); o.w = pk4_fp8(bf_lo(x1.z) * XS8_SCALE, bf_hi(x1.z) * XS8_SCALE, bf_lo(x1.w) * XS8_SCALE, bf_hi(x1.w) * XS8_SCALE);
            *dst = o; }
        __syncthreads();
    }
}
__device__ __forceinline__ void ph_final(const Params& P, int gw, int ngw, int lane) {
    const bf16* X2 = (const bf16*)(P.ws + WS_X2); const bf16* Y = (const bf16*)(P.ws + WS_Y); const int* SLOT = (const int*)(P.ws + WS_SLOT);
    f32x4 gg[4], v[4]; v2u cv[4], nv[4]; int myslot = -1, nslot = -1;
#pragma unroll
    for (int j = 0; j < 4; ++j) gg[j] = ((const f32x4*)P.g_final)[lane + 64 * j];
    if (gw < T) { myslot = SLOT[(size_t)gw * NE + (lane & 15)];
#pragma unroll
        for (int j = 0; j < 4; ++j) cv[j] = ((const v2u*)(X2 + (size_t)gw * D) + lane)[64 * j]; }
    for (int t = gw; t < T; t += ngw) {
        const int tn = t + ngw;
        if (tn < T) { nslot = SLOT[(size_t)tn * NE + (lane & 15)];
#pragma unroll
            for (int j = 0; j < 4; ++j) nv[j] = ((const v2u*)(X2 + (size_t)tn * D) + lane)[64 * j]; }
#pragma unroll
        for (int j = 0; j < 4; ++j) { v[j].x = bf_lo(cv[j].x); v[j].y = bf_hi(cv[j].x); v[j].z = bf_lo(cv[j].y); v[j].w = bf_hi(cv[j].y); }
        const int b = t >> 12;
        unsigned mask = (unsigned)(__ballot(myslot >= 0) & 0xFFFFull);
        while (mask) {
            int e_[4]; float w_[4];
#pragma unroll
            for (int k = 0; k < 4; ++k) { const bool ok = mask != 0u; e_[k] = ok ? (int)__builtin_ctz(mask) : 0; w_[k] = ok ? 1.f : 0.f; mask = ok ? (mask & (mask - 1u)) : 0u; }
            v2u yv[4][4];
#pragma unroll
            for (int k = 0; k < 4; ++k) { const int c = __builtin_amdgcn_readlane(myslot, e_[k]); const size_t row = (w_[k] != 0.f) ? ((size_t)(b * NE + e_[k]) * CAP + c) : 0;
                const v2u* yr = (const v2u*)(Y + row * D) + lane;
#pragma unroll
                for (int j = 0; j < 4; ++j) yv[k][j] = yr[64 * j]; }
#pragma unroll
            for (int k = 0; k < 4; ++k)
#pragma unroll
                for (int j = 0; j < 4; ++j) { v[j].x += w_[k] * bf_lo(yv[k][j].x); v[j].y += w_[k] * bf_hi(yv[k][j].x); v[j].z += w_[k] * bf_lo(yv[k][j].y); v[j].w += w_[k] * bf_hi(yv[k][j].y); }
        }
        float s = 0.f;
#pragma unroll
        for (int j = 0; j < 4; ++j) s += (v[j].x * v[j].x + v[j].y * v[j].y) + (v[j].z * v[j].z + v[j].w * v[j].w);
        const float r = rsqrtf(wave_sum(s) * (1.f / D) + EPS);
        f32x4* orow = (f32x4*)(P.out + (size_t)t * D) + lane;
#pragma unroll
        for (int j = 0; j < 4; ++j) { f32x4 o; o.x = v[j].x * r * gg[j].x; o.y = v[j].y * r * gg[j].y; o.z = v[j].z * r * gg[j].z; o.w = v[j].w * r * gg[j].w; orow[64 * j] = o; }
#pragma unroll
        for (int j = 0; j < 4; ++j) cv[j] = nv[j];
        myslot = nslot;
    }
}

namespace pg8 {
#define PG8_LAS __attribute__((address_space(3)))
typedef unsigned short bf16_t;
typedef short bf16x8 __attribute__((ext_vector_type(8)));
typedef float f32x4 __attribute__((ext_vector_type(4)));
typedef unsigned u32x4 __attribute__((ext_vector_type(4)));
constexpr int BM = 256, BK = 64, HALF = 128, HTB = HALF * BK * 2  , STAGE_BYTES = 8 * HTB, NXCD = 8, WGM = 8;

__host__ __device__ __forceinline__ int lds_byte(int r, int c) { const int st = (r >> 4) * 2 + (c >> 5), rr = r & 15, cc = c & 31, ob = rr * 64 + cc * 2; return st * 1024 + (ob ^ (((ob >> 9) & 1) << 5)); }
__host__ __device__ __forceinline__ void stage_rc(int b, int& R, int& C) { const int st = b / 1024, sb = b % 1024, swz = sb ^ (((sb >> 9) & 1) << 5); R = (st >> 1) * 16 + swz / 64; C = (st & 1) * 32 + (swz % 64) / 2; }
__host__ __device__ __forceinline__ int perm32(int rho) { const int n = rho >> 4, i = rho & 15; return 8 * (i >> 2) + 4 * n + (i & 3); }

struct Unit { int pm, pn, aux; };
struct Gemm { const bf16_t* A; const bf16_t* Bt; int M, N, K; };

struct StaticOrder {
    int nM, nN, nwg, G, c;
    __host__ __device__ void init(int M, int N, int G_, int c_) { nM = M / BM; nN = N / BM; nwg = nM * nN; G = G_; c = c_; }
    __host__ __device__ bool next(int i, Unit& u) const {
        const long L = (long)i * G + c; if (L >= nwg) return false;
        int wgid = (int)L; { const int q = nwg / NXCD, r = nwg % NXCD, xcd = wgid % NXCD, off = wgid / NXCD; wgid = (xcd < r ? xcd * (q + 1) : r * (q + 1) + (xcd - r) * q) + off; }
        const int nig = WGM * nN, gid = wgid / nig, fm = gid * WGM, gsz = (nM - fm) < WGM ? (nM - fm) : WGM;
        u.pm = fm + ((wgid % nig) % gsz); u.pn = (wgid % nig) / gsz; u.aux = 0; return true;
    }
    __device__ __forceinline__ void a_ready(const Unit&) const {}
    __device__ __forceinline__ void done(const Unit&) const {}
};
__device__ __forceinline__ unsigned cvt_pk_bf16(float lo, float hi) { unsigned r; asm volatile("v_cvt_pk_bf16_f32 %0, %1, %2" : "=v"(r) : "v"(lo), "v"(hi)); return r; }

__device__ __forceinline__ float fast_sigmoid(float z) { return __builtin_amdgcn_rcpf(1.0f + __builtin_amdgcn_exp2f(-1.4426950408889634f * z)); }
struct EpiIn {
    static constexpr bool PERM = true, AFTER_DRAIN = false;
    unsigned char* ws; const float* cs;
    __device__ __forceinline__ void operator()(const f32x4 (&acc)[2][2][4][2], const Unit& u, int wr, int wc, int fr, int fq) const {
        const int seg = u.pn >> 2, colt = (u.pn & 3) * BM;
        const size_t off = seg == 0 ? WS_U : seg == 1 ? WS_Q : seg == 2 ? WS_K : seg == 3 ? WS_V : seg == 4 ? WS_GP : WS_GA;
        bf16_t* base = (bf16_t*)(ws + off);
        const int row0 = u.pm * BM + wr * 64 + fr, col0 = colt + wc * 32 + 8 * fq;
        const bool rot = (seg == 1 || seg == 2) && ((wc & 1) == 0);
        const float sc = seg == 1 ? C2 : 1.f; const float sgn = fq == 0 ? -1.f : 1.f;
#pragma unroll
        for (int ai = 0; ai < 2; ++ai)
#pragma unroll
            for (int m = 0; m < 4; ++m) { const int row = row0 + ai * HALF + m * 16; bf16_t* rowp = base + (size_t)row * D + col0;
                f32x4 c0 = {1.f, 1.f, 1.f, 1.f}, c1 = c0, s0 = {0.f, 0.f, 0.f, 0.f}, s1 = s0;
                if (rot && fq < 2) { const f32x4* cp = (const f32x4*)(cs + (size_t)row * 16); c0 = cp[0]; c1 = cp[1]; s0 = cp[2] * sgn; s1 = cp[3] * sgn; }
#pragma unroll
                for (int bj = 0; bj < 2; ++bj) { f32x4 v0 = acc[ai][bj][m][0], v1 = acc[ai][bj][m][1];
                    if (rot) { f32x4 p0, p1;
#pragma unroll
                        for (int i = 0; i < 4; ++i) { p0[i] = __shfl_xor(v0[i], 16); p1[i] = __shfl_xor(v1[i], 16); }
                        v0 = v0 * c0 + p0 * s0; v1 = v1 * c1 + p1 * s1; }
                    if (seg >= 4) {
#pragma unroll
                        for (int i = 0; i < 4; ++i) { v0[i] = fast_sigmoid(v0[i]); v1[i] = fast_sigmoid(v1[i]); } }
                    v0 = v0 * sc; v1 = v1 * sc; u32x4 w; w.x = cvt_pk_bf16(v0[0], v0[1]); w.y = cvt_pk_bf16(v0[2], v0[3]); w.z = cvt_pk_bf16(v1[0], v1[1]); w.w = cvt_pk_bf16(v1[2], v1[3]);
                    *(u32x4*)(rowp + bj * HALF) = w; } }
    }
};
__device__ __forceinline__ float bfl(unsigned w) { return __builtin_bit_cast(float, w << 16); }
__device__ __forceinline__ float bfh(unsigned w) { return __builtin_bit_cast(float, w & 0xffff0000u); }
struct EpiMerge {
    static constexpr bool PERM = true, AFTER_DRAIN = false, KEEPS_ACC = true;
    const bf16_t* GP; const bf16_t* GA; bf16_t* MG;
    __device__ __forceinline__ bool keep(const Unit& u) const { return u.aux == 0; }
    __device__ __forceinline__ void operator()(f32x4 (&acc)[2][2][4][2], const Unit& u, int wr, int wc, int fr, int fq) const {
        const int row0 = u.pm * BM + wr * 64 + fr, col0 = u.pn * BM + wc * 32 + 8 * fq;
        if (u.aux == 0) {
#pragma unroll
            for (int ai = 0; ai < 2; ++ai)
#pragma unroll
                for (int m = 0; m < 4; ++m)
#pragma unroll
                    for (int bj = 0; bj < 2; ++bj) { const size_t idx = (size_t)(row0 + ai * HALF + m * 16) * D + col0 + bj * HALF;
                        const u32x4 p = *(const u32x4*)(GP + idx), a = *(const u32x4*)(GA + idx);
                        const float pv[8] = {bfl(p.x), bfh(p.x), bfl(p.y), bfh(p.y), bfl(p.z), bfh(p.z), bfl(p.w), bfh(p.w)}, av[8] = {bfl(a.x), bfh(a.x), bfl(a.y), bfh(a.y), bfl(a.z), bfh(a.z), bfl(a.w), bfh(a.w)};
#pragma unroll
                        for (int i = 0; i < 4; ++i) { acc[ai][bj][m][0][i] *= pv[i] * __builtin_amdgcn_rcpf(fmaxf(av[i], 1e-30f)); acc[ai][bj][m][1][i] *= pv[4 + i] * __builtin_amdgcn_rcpf(fmaxf(av[4 + i], 1e-30f)); } }
        } else {
#pragma unroll
            for (int ai = 0; ai < 2; ++ai)
#pragma unroll
                for (int m = 0; m < 4; ++m)
#pragma unroll
                    for (int bj = 0; bj < 2; ++bj) { const size_t idx = (size_t)(row0 + ai * HALF + m * 16) * D + col0 + bj * HALF;
                        const u32x4 a = *(const u32x4*)(GA + idx); const f32x4 v0 = acc[ai][bj][m][0], v1 = acc[ai][bj][m][1];
                        const float o[8] = {fmaxf(bfl(a.x), 1e-30f) * v0[0], fmaxf(bfh(a.x), 1e-30f) * v0[1], fmaxf(bfl(a.y), 1e-30f) * v0[2], fmaxf(bfh(a.y), 1e-30f) * v0[3],
                                            fmaxf(bfl(a.z), 1e-30f) * v1[0], fmaxf(bfh(a.z), 1e-30f) * v1[1], fmaxf(bfl(a.w), 1e-30f) * v1[2], fmaxf(bfh(a.w), 1e-30f) * v1[3]};
                        u32x4 w; w.x = cvt_pk_bf16(o[0], o[1]); w.y = cvt_pk_bf16(o[2], o[3]); w.z = cvt_pk_bf16(o[4], o[5]); w.w = cvt_pk_bf16(o[6], o[7]);
                        *(u32x4*)(MG + idx) = w; }
        }
    }
};
struct MergeOrder { StaticOrder so; const char *A0, *A1, *B0, *B1; size_t tstep;
    __device__ bool next(int i, Unit& u) const { if (!so.next(i >> 1, u)) return false; u.aux = i & 1; return true; }
    __device__ __forceinline__ const char* abase(const Unit& u) const { return (u.aux ? A1 : A0) + (size_t)u.pm * tstep; }
    __device__ __forceinline__ const char* bbase(const Unit& u) const { return (u.aux ? B1 : B0) + (size_t)u.pn * tstep; }
    __device__ __forceinline__ void a_ready(const Unit&) const {}
    __device__ __forceinline__ void done(const Unit&) const {}
};
struct EpiRes {
    static constexpr bool PERM = true, AFTER_DRAIN = false;
    const float* x; bf16_t* x2;
    __device__ __forceinline__ void operator()(const f32x4 (&acc)[2][2][4][2], const Unit& u, int wr, int wc, int fr, int fq) const {
        const int row0 = u.pm * BM + wr * 64 + fr, col0 = u.pn * BM + wc * 32 + 8 * fq;
#pragma unroll
        for (int ai = 0; ai < 2; ++ai)
#pragma unroll
            for (int m = 0; m < 4; ++m)
#pragma unroll
                for (int bj = 0; bj < 2; ++bj) { const size_t off = (size_t)(row0 + ai * HALF + m * 16) * D + col0 + bj * HALF;
                    const f32x4 v0 = *(const f32x4*)(x + off) + acc[ai][bj][m][0], v1 = *(const f32x4*)(x + off + 4) + acc[ai][bj][m][1];
                    u32x4 w; w.x = cvt_pk_bf16(v0[0], v0[1]); w.y = cvt_pk_bf16(v0[2], v0[3]); w.z = cvt_pk_bf16(v1[0], v1[1]); w.w = cvt_pk_bf16(v1[2], v1[3]);
                    *(u32x4*)(x2 + off) = w; }
    }
};
typedef int v8i_t __attribute__((ext_vector_type(8))); typedef int v4i_t __attribute__((ext_vector_type(4)));
__device__ __forceinline__ v8i_t pg8_cat(bf16x8 lo, bf16x8 hi) { const v4i_t a = __builtin_bit_cast(v4i_t, lo), b = __builtin_bit_cast(v4i_t, hi); return __builtin_shufflevector(a, b, 0, 1, 2, 3, 4, 5, 6, 7); }
__device__ __forceinline__ unsigned pk4_e4m3(float a, float b, float c, float d) { return pk4_fp8(a, b, c, d); }
struct EpiUp {
    static constexpr bool PERM = true, AFTER_DRAIN = false;
    unsigned char* act;
    __device__ __forceinline__ void operator()(const f32x4 (&acc)[2][2][4][2], const Unit& u, int wr, int wc, int fr, int fq) const {
        const int e = (u.pm >> 1) & 15, j = u.pn - e * 22;
        const int row0 = u.pm * BM + wr * 64 + fr, col0 = j * HALF + wc * 32 + 8 * fq;
        constexpr float SI = 1.0f / (XS8_SCALE * W8_SCALE);
#pragma unroll
        for (int ai = 0; ai < 2; ++ai)
#pragma unroll
            for (int m = 0; m < 4; ++m) { float o[8];
#pragma unroll
                for (int n = 0; n < 2; ++n)
#pragma unroll
                    for (int i = 0; i < 4; ++i) { const float g = acc[ai][0][m][n][i] * SI; o[4 * n + i] = g * fast_sigmoid(g) * (acc[ai][1][m][n][i] * (SI * ACT8_SCALE)); }
                v2u w; w.x = pk4_fp8(o[0], o[1], o[2], o[3]); w.y = pk4_fp8(o[4], o[5], o[6], o[7]);
                *(v2u*)(act + (size_t)(row0 + ai * HALF + m * 16) * FF + col0) = w; }
    }
};
struct EpiDown {
    static constexpr bool PERM = true, AFTER_DRAIN = false;
    bf16_t* y; const float* val;
    __device__ __forceinline__ void operator()(const f32x4 (&acc)[2][2][4][2], const Unit& u, int wr, int wc, int fr, int fq) const {
        const int e = (u.pm >> 1) & 15, n4 = u.pn - e * 4;
        const int row0 = u.pm * BM + wr * 64 + fr, col0 = n4 * BM + wc * 32 + 8 * fq;
#pragma unroll
        for (int ai = 0; ai < 2; ++ai)
#pragma unroll
            for (int m = 0; m < 4; ++m) { const int row = row0 + ai * HALF + m * 16; const float vv = val[row] * (1.0f / (ACT8_SCALE * W8_SCALE));
#pragma unroll
                for (int bj = 0; bj < 2; ++bj) { const f32x4 v0 = acc[ai][bj][m][0] * vv, v1 = acc[ai][bj][m][1] * vv;
                    u32x4 w; w.x = cvt_pk_bf16(v0[0], v0[1]); w.y = cvt_pk_bf16(v0[2], v0[3]); w.z = cvt_pk_bf16(v1[0], v1[1]); w.w = cvt_pk_bf16(v1[2], v1[3]);
                    *(u32x4*)(y + (size_t)row * D + col0 + bj * HALF) = w; } }
    }
};
struct InOrder { int pm0, off0, nu;
    __device__ bool next(int i, Unit& u) const { if (i >= nu) return false; const int off = off0 + 16 * i; u.pm = pm0 + (off & 7); u.pn = off >> 3; u.aux = 0; return true; }
    __device__ __forceinline__ void a_ready(const Unit&) const {}
    __device__ __forceinline__ void done(const Unit&) const {}
};
struct UpOrder { int xg, l;
    __device__ bool next(int i, Unit& u) const { if (i >= 11) return false; const int uu = i * 32 + l, e = xg * 2 + uu / 176, r = uu % 176, j = r >> 3, pmi = r & 7;
        u.pm = ((pmi >> 1) * 16 + e) * 2 + (pmi & 1); u.pn = e * 22 + j; u.aux = 0; return true; }
    __device__ __forceinline__ void a_ready(const Unit&) const {}
    __device__ __forceinline__ void done(const Unit&) const {}
};
struct DownOrder { int xg, l;
    __device__ bool next(int i, Unit& u) const { if (i >= 2) return false; const int e = xg * 2 + i, pmi = l & 7, n4 = l >> 3;
        u.pm = ((pmi >> 1) * 16 + e) * 2 + (pmi & 1); u.pn = e * 4 + n4; u.aux = 0; return true; }
    __device__ __forceinline__ void a_ready(const Unit&) const {}
    __device__ __forceinline__ void done(const Unit&) const {}
};
template <class S_, class = void> struct pg8_has_bases { static constexpr bool value = false; };
template <class S_> struct pg8_has_bases<S_, decltype((void)&S_::abase)> { static constexpr bool value = true; };
template <class E_, class = void> struct pg8_keeps_acc { static constexpr bool value = false; };
template <class E_> struct pg8_keeps_acc<E_, decltype((void)E_::KEEPS_ACC)> { static constexpr bool value = E_::KEEPS_ACC; };
template <class Epi, class Sched, bool ALIGN_EPI = false, bool SP2 = false, bool FP8 = false>
__device__ __forceinline__ void gemm_phase(PG8_LAS unsigned char* lds, const Gemm g, const Sched& S, const Epi& E) {
    const int tid = threadIdx.x, wid = __builtin_amdgcn_readfirstlane(tid >> 6), lane = tid & 63, wr = wid >> 2, wc = wid & 3, fr = lane & 15, fq = lane >> 4;
    const int K = g.K, nt = K / BK;
    unsigned voffA[2], voffB[2];
#pragma unroll
    for (int i = 0; i < 2; ++i) { int R, C; stage_rc(tid * 16 + i * 8192, R, C); const int Rb = Epi::PERM ? ((R & ~31) + perm32(R & 31)) : R;
        voffA[i] = (unsigned)(R * K + C) * 2u; voffB[i] = (unsigned)(Rb * K + C) * 2u; }
    const size_t kstep = (size_t)(BK * 2);
    const size_t hstep = (size_t)HALF * K * 2;
    const size_t tstep = 2 * hstep;
    const unsigned ldsw = (unsigned)wid * 1024u;
    const int aoff = lds_byte(wr * 64 + fr, fq * 8), boff = lds_byte(wc * 32 + fr, fq * 8);
#define PG8_SA(b, h) (((b) * 2 + (h)) * HTB)
#define PG8_SB(b, h) ((4 + (b) * 2 + (h)) * HTB)
#define PG8_STAGE(bufoff, gbase, voff) do { _Pragma("unroll") for (int _i = 0; _i < 2; ++_i) \
        __builtin_amdgcn_global_load_lds((const unsigned*)((const char*)(gbase) + (voff)[_i]), (PG8_LAS unsigned*)(lds + (bufoff) + ldsw + _i * 8192), 16, 0, 0); } while (0)
#define PG8_LDA(dst, b, h) do { _Pragma("unroll") for (int m = 0; m < 4; ++m) { const bf16x8 x0_ = *(const PG8_LAS bf16x8*)(lds + PG8_SA(b, h) + aoff + m * 2048), x1_ = *(const PG8_LAS bf16x8*)(lds + PG8_SA(b, h) + aoff + m * 2048 + 1024); \
        if constexpr (FP8) dst##8[m] = pg8_cat(x0_, x1_); else { dst[m][0] = x0_; dst[m][1] = x1_; } } } while (0)
#define PG8_LDB(dst, b, h) do { _Pragma("unroll") for (int n = 0; n < 2; ++n) { const bf16x8 x0_ = *(const PG8_LAS bf16x8*)(lds + PG8_SB(b, h) + boff + n * 2048), x1_ = *(const PG8_LAS bf16x8*)(lds + PG8_SB(b, h) + boff + n * 2048 + 1024); \
        if constexpr (FP8) dst##8[n] = pg8_cat(x0_, x1_); else { dst[n][0] = x0_; dst[n][1] = x1_; } } } while (0)
#define PG8_MMA(ai, bj, At, Bt) do { __builtin_amdgcn_s_setprio(1); \
        if constexpr (FP8) { _Pragma("unroll") for (int m = 0; m < 4; ++m) _Pragma("unroll") for (int n = 0; n < 2; ++n) \
            asm volatile("s_nop 1\n\tv_mfma_scale_f32_16x16x128_f8f6f4 %0, %1, %2, %0, %3, %3 op_sel_hi:[0,0,0]" : "+v"(acc[ai][bj][m][n]) : "v"(Bt##8[n]), "v"(At##8[m]), "v"(sc8_)); } \
        else { _Pragma("unroll") for (int m = 0; m < 4; ++m) _Pragma("unroll") for (int n = 0; n < 2; ++n) _Pragma("unroll") for (int k = 0; k < 2; ++k) \
            acc[ai][bj][m][n] = __builtin_amdgcn_mfma_f32_16x16x32_bf16(Bt[n][k], At[m][k], acc[ai][bj][m][n], 0, 0, 0); } \
        __builtin_amdgcn_s_setprio(0); } while (0)
#define PG8_WAIT_V(n) asm volatile("s_waitcnt vmcnt(" #n ")" ::: "memory")
#define PG8_WAIT_L(n) asm volatile("s_waitcnt lgkmcnt(" #n ")" ::: "memory")
#define PG8_BAR __builtin_amdgcn_s_barrier()
#define PG8_SCHED __builtin_amdgcn_sched_barrier(0)
    Unit cur, nxt; int ui = 0;
    if (!S.next(0, cur)) return;
    f32x4 acc[2][2][4][2];
#pragma unroll
    for (int a = 0; a < 2; ++a)
#pragma unroll
        for (int b = 0; b < 2; ++b)
#pragma unroll
            for (int m = 0; m < 4; ++m)
#pragma unroll
                for (int n = 0; n < 2; ++n) acc[a][b][m][n] = (f32x4){0.f, 0.f, 0.f, 0.f};
    const unsigned sc8_ = 0x7F7F7F7Fu;
    bf16x8 At[4][2], B0[2][2], B1[2][2]; v8i_t At8[4], B08[2], B18[2];
    const char* cA; const char* cB;
    if constexpr (pg8_has_bases<Sched>::value) { cA = S.abase(cur); cB = S.bbase(cur); } else { cA = (const char*)g.A + (size_t)cur.pm * tstep; cB = (const char*)g.Bt + (size_t)cur.pn * tstep; }
    S.a_ready(cur);
    if constexpr (SP2) {
        PG8_STAGE(PG8_SB(0, 0), cB, voffB); PG8_STAGE(PG8_SB(0, 1), cB + hstep, voffB); PG8_STAGE(PG8_SA(0, 0), cA, voffA); PG8_STAGE(PG8_SA(0, 1), cA + hstep, voffA);
        if (wr == 1) PG8_BAR;
        PG8_WAIT_V(2); PG8_BAR;
        PG8_STAGE(PG8_SB(1, 0), cB + kstep, voffB); PG8_STAGE(PG8_SA(1, 0), cA + kstep, voffA); PG8_STAGE(PG8_SB(1, 1), cB + hstep + kstep, voffB);
        PG8_WAIT_V(6); PG8_BAR;
    } else {
        PG8_STAGE(PG8_SB(0, 0), cB, voffB); PG8_STAGE(PG8_SA(0, 0), cA, voffA); PG8_STAGE(PG8_SB(0, 1), cB + hstep, voffB); PG8_STAGE(PG8_SA(0, 1), cA + hstep, voffA);
        if (wr == 1) PG8_BAR;
        PG8_WAIT_V(4); PG8_BAR;
        PG8_STAGE(PG8_SB(1, 0), cB + kstep, voffB); PG8_STAGE(PG8_SA(1, 0), cA + kstep, voffA); PG8_STAGE(PG8_SB(1, 1), cB + hstep + kstep, voffB);
        PG8_WAIT_V(6); PG8_BAR;
    }
    for (;;) {
        const bool has_next = S.next(ui + 1, nxt);
        const char* nA; const char* nB;
        if constexpr (pg8_has_bases<Sched>::value) { nA = has_next ? S.abase(nxt) : cA; nB = has_next ? S.bbase(nxt) : cB; } else { nA = has_next ? (const char*)g.A + (size_t)nxt.pm * tstep : cA; nB = has_next ? (const char*)g.Bt + (size_t)nxt.pn * tstep : cB; }
        for (int t = 0; t < nt; t += 2) {
            const bool last = (t == nt - 2);
            const char* a1 = cA + (size_t)(t + 1) * kstep;
            const char* a2 = last ? nA : cA + (size_t)(t + 2) * kstep; const char* b2 = last ? nB : cB + (size_t)(t + 2) * kstep;
            const char* a3 = a2 + kstep; const char* b3 = b2 + kstep;
            if (last && has_next) S.a_ready(nxt);
            if constexpr (SP2) {
            PG8_LDB(B0, 0, 0); PG8_LDB(B1, 0, 1); PG8_SCHED; PG8_LDA(At, 0, 0); PG8_STAGE(PG8_SA(1, 1), a1 + hstep, voffA);
            PG8_WAIT_V(8); PG8_WAIT_L(0); PG8_BAR; PG8_MMA(0, 0, At, B0); PG8_MMA(0, 1, At, B1); PG8_BAR; PG8_SCHED;
            PG8_LDA(At, 0, 1); PG8_STAGE(PG8_SB(0, 0), b2, voffB); PG8_STAGE(PG8_SB(0, 1), b2 + hstep, voffB); PG8_STAGE(PG8_SA(0, 0), a2, voffA);
            PG8_WAIT_V(8); PG8_WAIT_L(0); PG8_BAR; PG8_MMA(1, 0, At, B0); PG8_MMA(1, 1, At, B1); PG8_BAR; PG8_SCHED;
            PG8_LDB(B0, 1, 0); PG8_LDB(B1, 1, 1); PG8_SCHED; PG8_LDA(At, 1, 0); PG8_STAGE(PG8_SA(0, 1), a2 + hstep, voffA);
            PG8_WAIT_V(8); PG8_WAIT_L(0); PG8_BAR; PG8_MMA(0, 0, At, B0); PG8_MMA(0, 1, At, B1); PG8_BAR; PG8_SCHED;
            PG8_LDA(At, 1, 1); PG8_STAGE(PG8_SB(1, 0), b3, voffB); PG8_STAGE(PG8_SB(1, 1), b3 + hstep, voffB); PG8_STAGE(PG8_SA(1, 0), a3, voffA);
            PG8_WAIT_V(8); PG8_WAIT_L(0); PG8_BAR; PG8_MMA(1, 0, At, B0); PG8_MMA(1, 1, At, B1); PG8_BAR; PG8_SCHED;
            } else {
            PG8_LDB(B0, 0, 0); PG8_SCHED; PG8_LDA(At, 0, 0); PG8_STAGE(PG8_SA(1, 1), a1 + hstep, voffA);
            PG8_WAIT_L(8); PG8_BAR; PG8_WAIT_L(0); PG8_MMA(0, 0, At, B0); PG8_BAR; PG8_SCHED;
            PG8_LDB(B1, 0, 1); PG8_STAGE(PG8_SB(0, 0), b2, voffB);
            PG8_BAR; PG8_WAIT_L(0); PG8_MMA(0, 1, At, B1); PG8_BAR;
            PG8_LDA(At, 0, 1); PG8_STAGE(PG8_SA(0, 0), a2, voffA);
            PG8_BAR; PG8_WAIT_L(0); PG8_MMA(1, 0, At, B0); PG8_BAR; PG8_SCHED;
            PG8_STAGE(PG8_SB(0, 1), b2 + hstep, voffB);
            PG8_WAIT_V(6); PG8_BAR; PG8_MMA(1, 1, At, B1); PG8_BAR;
            PG8_LDB(B0, 1, 0); PG8_SCHED; PG8_LDA(At, 1, 0); PG8_STAGE(PG8_SA(0, 1), a2 + hstep, voffA);
            PG8_WAIT_L(8); PG8_BAR; PG8_WAIT_L(0); PG8_MMA(0, 0, At, B0); PG8_BAR; PG8_SCHED;
            PG8_LDB(B1, 1, 1); PG8_STAGE(PG8_SB(1, 0), b3, voffB);
            PG8_BAR; PG8_WAIT_L(0); PG8_MMA(0, 1, At, B1); PG8_BAR;
            PG8_LDA(At, 1, 1); PG8_STAGE(PG8_SA(1, 0), a3, voffA);
            PG8_BAR; PG8_WAIT_L(0); PG8_MMA(1, 0, At, B0); PG8_BAR; PG8_SCHED;
            PG8_STAGE(PG8_SB(1, 1), b3 + hstep, voffB);
            PG8_WAIT_V(6); PG8_BAR; PG8_MMA(1, 1, At, B1); PG8_BAR;
            }
        }
        if constexpr (ALIGN_EPI) { if (wr == 0) PG8_BAR; }
        if constexpr (!Epi::AFTER_DRAIN) { E(acc, cur, wr, wc, fr, fq); S.done(cur); }
        if (!has_next) break;
        bool keep_ = false; if constexpr (pg8_keeps_acc<Epi>::value) keep_ = E.keep(cur);
        if (!keep_) {
#pragma unroll
        for (int a = 0; a < 2; ++a)
#pragma unroll
            for (int b = 0; b < 2; ++b)
#pragma unroll
                for (int m = 0; m < 4; ++m)
#pragma unroll
                    for (int n = 0; n < 2; ++n) acc[a][b][m][n] = (f32x4){0.f, 0.f, 0.f, 0.f};
        }
        cur = nxt; cA = nA; cB = nB; ++ui;
        if constexpr (ALIGN_EPI) { if (wr == 1) PG8_BAR; }
    }
    PG8_WAIT_V(0);
    if constexpr (!ALIGN_EPI) { if (wr == 0) PG8_BAR; }
    PG8_BAR;
    if constexpr (Epi::AFTER_DRAIN) { E.fused(acc, cur, wr, wc, fr, fq, lds, wid, lane); S.done(cur); }
#undef PG8_SA
#undef PG8_SB
#undef PG8_STAGE
#undef PG8_LDA
#undef PG8_LDB
#undef PG8_MMA
#undef PG8_WAIT_V
#undef PG8_WAIT_L
#undef PG8_BAR
#undef PG8_SCHED
}
}

#include <hip/hip_bf16.h>
#include <cmath>
namespace attn_body {
using bf16=__hip_bfloat16;
using bf16x8=__attribute__((ext_vector_type(8)))short;
using s16x4=__attribute__((ext_vector_type(4)))short;
using f32x16=__attribute__((ext_vector_type(16)))float;
using u32x4=__attribute__((ext_vector_type(4)))unsigned;
constexpr int SEQ=4096,D=64,DM=1024;
constexpr int NW=8,QBLK=32,QB=QBLK*NW,KVBLK=64,NQB=SEQ/QB;
constexpr int ATTN_PITCH=DM, ATTN_UNIT_ROWS=QB;
__device__ __forceinline__ int crow(int r,int hi){return (r&3)+8*(r>>2)+4*hi;}
#define SBAR() __builtin_amdgcn_sched_barrier(0)
__device__ __forceinline__ void cmask(f32x16&p0,f32x16&p1,int jb,int qrel,int hi){
  const float NEG=-INFINITY; int kb=64*jb+4*hi;
  #pragma unroll
  for(int r=0;r<16;++r){int kv=kb+(r&3)+8*(r>>2); if(kv>qrel)p0[r]=NEG; if(kv+32>qrel)p1[r]=NEG;}
}

constexpr int NSLOT=3, SLOTB=8192;
constexpr int LDS_K=0, LDS_V=NSLOT*SLOTB, LDS_WS=2*NSLOT*SLOTB, LDS_OST=LDS_WS+NW*64*4, LDS_BYTES=LDS_OST+NW*4096;
constexpr float C2=0.125f*1.4426950408889634f;
__device__ __forceinline__ void glds16(const void*gsrc,unsigned lds_dst){unsigned keep;
  asm volatile("s_mov_b32 %0, m0\n\ts_mov_b32 m0, %2\n\ts_nop 0\n\tglobal_load_lds_dwordx4 %1, off\n\ts_mov_b32 m0, %0":"=&s"(keep):"v"(gsrc),"s"(lds_dst):"memory");}
__device__ __forceinline__ float max3f(float a,float b,float c){float r;asm("v_max3_f32 %0, %1, %2, %3":"=v"(r):"v"(a),"v"(b),"v"(c));return r;}
__device__ __forceinline__ float max2f(float a,float b){float r;asm("v_max_f32_e32 %0, %1, %2":"=v"(r):"v"(a),"v"(b));return r;}
__device__ __forceinline__ float fadd_s(float a,float b){float r;asm("v_add_f32_e32 %0, %1, %2":"=v"(r):"v"(a),"v"(b));return r;}
__device__ __forceinline__ float fsub_s(float a,float b){float r;asm("v_sub_f32_e32 %0, %1, %2":"=v"(r):"v"(a),"v"(b));return r;}
typedef float f32x2_t __attribute__((ext_vector_type(2))); typedef __bf16 bf16x2_t __attribute__((ext_vector_type(2)));
__device__ __forceinline__ unsigned cvtpk_s(float lo,float hi){f32x2_t v={lo,hi};bf16x2_t b=__builtin_convertvector(v,bf16x2_t);return __builtin_bit_cast(unsigned,b);}
#define WAIT_BAR(N) asm volatile("s_waitcnt vmcnt(" #N ") lgkmcnt(0)\n\ts_barrier":::"memory")

__device__ __forceinline__ void qkt(f32x16&p0,f32x16&p1,const char*Kslot,const bf16x8*qr,const f32x16&negm,int r32,int hi){
  const char*kb=Kslot+hi*1024+r32*16;
  #pragma unroll
  for(int d0=0;d0<4;++d0){
    const bf16x8 b0=*reinterpret_cast<const bf16x8*>(kb+d0*2048);
    const bf16x8 b1=*reinterpret_cast<const bf16x8*>(kb+d0*2048+512);
    if(d0==0){p0=__builtin_amdgcn_mfma_f32_32x32x16_bf16(b0,qr[0],negm,0,0,0);p1=__builtin_amdgcn_mfma_f32_32x32x16_bf16(b1,qr[0],negm,0,0,0);}
    else{p0=__builtin_amdgcn_mfma_f32_32x32x16_bf16(b0,qr[d0],p0,0,0,0);p1=__builtin_amdgcn_mfma_f32_32x32x16_bf16(b1,qr[d0],p1,0,0,0);}}
}
typedef __attribute__((address_space(3))) const char* lds_cptr;
typedef short v4i16_t __attribute__((ext_vector_type(4)));
__device__ __forceinline__ void kload8(bf16x8*kf,lds_cptr kp){
  kf[0]=*(const __attribute__((address_space(3))) bf16x8*)(kp);      kf[1]=*(const __attribute__((address_space(3))) bf16x8*)(kp+512);
  kf[2]=*(const __attribute__((address_space(3))) bf16x8*)(kp+2048); kf[3]=*(const __attribute__((address_space(3))) bf16x8*)(kp+2560);
  kf[4]=*(const __attribute__((address_space(3))) bf16x8*)(kp+4096); kf[5]=*(const __attribute__((address_space(3))) bf16x8*)(kp+4608);
  kf[6]=*(const __attribute__((address_space(3))) bf16x8*)(kp+6144); kf[7]=*(const __attribute__((address_space(3))) bf16x8*)(kp+6656);
}
__device__ __forceinline__ void kload2(bf16x8*kf,lds_cptr kp,int j){ kf[2*j]=*(const __attribute__((address_space(3))) bf16x8*)(kp+j*2048); kf[2*j+1]=*(const __attribute__((address_space(3))) bf16x8*)(kp+j*2048+512); }
__device__ __forceinline__ s16x4 vtr(lds_cptr p){ return __builtin_bit_cast(s16x4,__builtin_amdgcn_ds_read_tr16_b64_v4i16((__attribute__((address_space(3))) v4i16_t*)p)); }
__device__ __forceinline__ float rowmax(const f32x16&p0,const f32x16&p1){
  float a=max3f(p0[0],p0[1],p1[0]),b=max3f(p0[2],p0[3],p1[1]);a=max3f(a,p1[2],p1[3]);
  #pragma unroll
  for(int r=4;r<16;r+=4){a=max3f(a,p0[r],p0[r+1]);b=max3f(b,p0[r+2],p0[r+3]);a=max3f(a,p1[r],p1[r+1]);b=max3f(b,p1[r+2],p1[r+3]);}
  const float m=max2f(a,b);
  auto rr=__builtin_amdgcn_permlane32_swap(__float_as_uint(m),__float_as_uint(m),false,false);
  return max2f(__uint_as_float(rr[0]),__uint_as_float(rr[1]));
}
__device__ __forceinline__ void pv(f32x16*o,int vb,bf16x8 pa0,bf16x8 pa1,bf16x8 pa2,bf16x8 pa3){
  #pragma unroll
  for(int d0=0;d0<2;++d0){s16x4 lo[4],hi[4];
    #pragma unroll
    for(int ks=0;ks<4;++ks){
      asm volatile("ds_read_b64_tr_b16 %0,%1 offset:%c2":"=&v"(lo[ks]):"v"(vb),"i"(d0*4096+ks*1024):"memory");
      asm volatile("ds_read_b64_tr_b16 %0,%1 offset:%c2":"=&v"(hi[ks]):"v"(vb),"i"(d0*4096+ks*1024+512):"memory");}
    asm volatile("s_waitcnt lgkmcnt(0)":::"memory");SBAR();
    #define PK(k) (bf16x8){lo[k][0],lo[k][1],lo[k][2],lo[k][3],hi[k][0],hi[k][1],hi[k][2],hi[k][3]}
    o[d0]=__builtin_amdgcn_mfma_f32_32x32x16_bf16(pa0,PK(0),o[d0],0,0,0);
    o[d0]=__builtin_amdgcn_mfma_f32_32x32x16_bf16(pa1,PK(1),o[d0],0,0,0);
    o[d0]=__builtin_amdgcn_mfma_f32_32x32x16_bf16(pa2,PK(2),o[d0],0,0,0);
    o[d0]=__builtin_amdgcn_mfma_f32_32x32x16_bf16(pa3,PK(3),o[d0],0,0,0);
    #undef PK
  }
}

#ifndef ATTN_STORE16
#define ATTN_STORE16(p,v) (*(u32x4*)(p)=(v))
#endif
template<int THRL> __device__ __forceinline__ void attn_unit(const bf16*Qh,const bf16*__restrict__ Kh,const bf16*__restrict__ Vh,bf16*Oh,int q0,char*shm){
  const int tid=threadIdx.x,lane=tid&63,r32=lane&31,hi=lane>>5; const int wid=__builtin_amdgcn_readfirstlane(tid>>6);
  const bf16*Qw=Qh+(long)(q0+wid*QBLK)*DM;
  const unsigned lds0=(unsigned)(uintptr_t)shm;
  float*wsf=(float*)(shm+LDS_WS)+wid*64;
  const bf16*ksrc=Kh+(long)lane*DM+wid*8;
  const bf16*vsrc=Vh+(long)(16*(wid&3)+(lane>>2))*DM+(wid>>2)*32+(lane&3)*8;
  const unsigned kdst=lds0+LDS_K+wid*1024, vdst=lds0+LDS_V+wid*1024;
  #define DMA_K(t,slot) glds16(ksrc+(long)(t)*KVBLK*DM,(unsigned)__builtin_amdgcn_readfirstlane(kdst+(slot)))
  #define DMA_V(t,slot) glds16(vsrc+(long)(t)*KVBLK*DM,(unsigned)__builtin_amdgcn_readfirstlane(vdst+(slot)))
  const int vb0=(int)(lds0+LDS_V)+((lane>>4)&1)*32+(lane&3)*8+(4*hi+((lane&15)>>2))*64;
  const char*Kbase=shm+LDS_K; bf16x8 kf[8];
  const lds_cptr shm3=(lds_cptr)shm; const lds_cptr kp0=shm3+LDS_K+hi*1024+r32*16; const lds_cptr vp0=shm3+LDS_V+((lane>>4)&1)*32+(lane&3)*8+(4*hi+((lane&15)>>2))*64;
  const int NT=SEQ/KVBLK;
  DMA_K(0,0);DMA_V(0,0);DMA_K(1,SLOTB);
  bf16x8 qr[4];
  #pragma unroll
  for(int d0=0;d0<4;++d0)qr[d0]=*reinterpret_cast<const bf16x8*>(&Qw[(long)r32*DM+d0*16+hi*8]);
  float mhat=0.f,l_reg=0.f;f32x16 o[2];o[0]=f32x16{};o[1]=f32x16{};f32x16 negm=f32x16{};asm volatile("":"+v"(negm));
  const int qrel=wid*QBLK+r32;
  #define CMASK(P0,P1,t) do{}while(0)
  bool resc=false;
  #define START(P0,P1) do{ const float rm=rowmax(P0,P1); resc=false; \
    { const float dl=rm; mhat=fadd_s(mhat,dl); \
      _Pragma("unroll") for(int r=0;r<16;++r){P0[r]=fsub_s(P0[r],dl);P1[r]=fsub_s(P1[r],dl);} \
      _Pragma("unroll") for(int r=0;r<16;++r)negm[r]=-mhat; asm volatile("":"+v"(negm)); } \
    _Pragma("unroll") for(int r=0;r<16;++r)P0[r]=__builtin_amdgcn_exp2f(P0[r]); }while(0)
  #define RESC() do{ if(resc){ asm volatile("s_waitcnt lgkmcnt(0)":::"memory"); \
      _Pragma("unroll") for(int d_=0;d_<2;++d_) _Pragma("unroll") for(int r=0;r<16;++r)o[d_][r]*=wsf[crow(r,hi)]; } }while(0)
  f32x16 pA0,pA1,pB0,pB1;
  int sl_prev=0,sl_cur=0,sl_next=SLOTB;
  #define ROT() do{sl_prev=sl_cur;sl_cur=sl_next;sl_next=(sl_next==(NSLOT-1)*SLOTB)?0:sl_next+SLOTB;}while(0)
  DMA_K(2,2*SLOTB);
  WAIT_BAR(3);
  qkt(pA0,pA1,Kbase,qr,negm,r32,hi);asm volatile("s_nop 15\n\ts_nop 7":"+v"(pA0),"+v"(pA1));CMASK(pA0,pA1,0);
  START(pA0,pA1);
  _Pragma("unroll") for(int r=0;r<16;++r)pA1[r]=__builtin_amdgcn_exp2f(pA1[r]);
  WAIT_BAR(0);
  DMA_K(3,0);DMA_V(1,SLOTB);
  ROT();
  kload8(kf,kp0+sl_cur);
  WAIT_BAR(2);
  s16x4 vlo[8],vhi[8]; u32x4 pw0,pw1,pw2,pw3;
  #define PKW(P,B) cvtpk_s(P[B],P[B+1])
  #define PAF(k) __builtin_bit_cast(bf16x8,pw##k)
  #define VFR(i) (bf16x8){vlo[i][0],vlo[i][1],vlo[i][2],vlo[i][3],vhi[i][0],vhi[i][1],vhi[i][2],vhi[i][3]}
  #define PIN(x) asm volatile("":"+v"(x))
  #define MX3(a,b,c) __builtin_fmaxf(__builtin_fmaxf((a),(b)),(c))
  #define GAPA(MF,A0,A1,A2,A3,W0,W1,PW) do{ MF; sacc+=A0; sacc+=A1; sacc+=A2; sacc+=A3; PIN(sacc); W0; W1; PIN(PW); SBAR(); }while(0)
  #define EX(v) __builtin_amdgcn_exp2f(v)
  #define GAPB(MF,X,B) do{ MF; X[B]=EX(X[B]); X[B+1]=EX(X[B+1]); X[B+2]=EX(X[B+2]); X[B+3]=EX(X[B+3]); PIN(X); SBAR(); }while(0)
  #define VRD(i) do{ vlo[i]=vtr(vp_+(((i)>>2)*4096+((i)&3)*1024)); vhi[i]=vtr(vp_+(((i)>>2)*4096+((i)&3)*1024+512)); }while(0)
  #define KRD(G,j) do{ if(G){ kload2(kf,kp0+sl_next,j); SBAR(); } }while(0)
  #define STEP(C0,C1,P0,P1,t,GK,GV,GL) do{ SBAR(); \
    const lds_cptr vp_=vp0+sl_prev; \
    VRD(0); SBAR(); float sacc=(P0[0]+P0[1]); \
    GAPA(C0=__builtin_amdgcn_mfma_f32_32x32x16_bf16(kf[0],qr[0],negm,0,0,0), P0[2],P0[3],P0[4],P0[5],     pw0[0]=PKW(P0,0), pw0[1]=PKW(P0,2), pw0); \
    VRD(4); SBAR(); GAPA(C1=__builtin_amdgcn_mfma_f32_32x32x16_bf16(kf[1],qr[0],negm,0,0,0), P0[6],P0[7],P0[8],P0[9],     pw0[2]=PKW(P0,4), pw0[3]=PKW(P0,6), pw0); \
    VRD(1); SBAR(); GAPA(C0=__builtin_amdgcn_mfma_f32_32x32x16_bf16(kf[2],qr[1],C0,0,0,0),   P0[10],P0[11],P0[12],P0[13], pw1[0]=PKW(P0,8), pw1[1]=PKW(P0,10), pw1); \
    VRD(5); SBAR(); GAPA(C1=__builtin_amdgcn_mfma_f32_32x32x16_bf16(kf[3],qr[1],C1,0,0,0),   P0[14],P0[15],P1[0],P1[1],   pw1[2]=PKW(P0,12),pw1[3]=PKW(P0,14), pw1); \
    VRD(2); SBAR(); GAPA(C0=__builtin_amdgcn_mfma_f32_32x32x16_bf16(kf[4],qr[2],C0,0,0,0),   P1[2],P1[3],P1[4],P1[5],     pw2[0]=PKW(P1,0), pw2[1]=PKW(P1,2), pw2); \
    VRD(6); SBAR(); GAPA(C1=__builtin_amdgcn_mfma_f32_32x32x16_bf16(kf[5],qr[2],C1,0,0,0),   P1[6],P1[7],P1[8],P1[9],     pw2[2]=PKW(P1,4), pw2[3]=PKW(P1,6), pw2); \
    VRD(3); SBAR(); GAPA(C0=__builtin_amdgcn_mfma_f32_32x32x16_bf16(kf[6],qr[3],C0,0,0,0),   P1[10],P1[11],P1[12],P1[13], pw3[0]=PKW(P1,8), pw3[1]=PKW(P1,10), pw3); \
    VRD(7); SBAR(); GAPA(C1=__builtin_amdgcn_mfma_f32_32x32x16_bf16(kf[7],qr[3],C1,0,0,0),   P1[14],P1[15],0.f,0.f,       pw3[2]=PKW(P1,12),pw3[3]=PKW(P1,14), pw3); \
    l_reg+=sacc; \
    if(GK){DMA_K((t)+3,sl_cur);} if(GV){DMA_V((t)+1,sl_next);} \
    CMASK(C0,C1,t); \
    { float a=MX3(C0[0],C0[1],C1[0]),b=MX3(C0[2],C0[3],C1[1]); a=MX3(a,C1[2],C1[3]); \
      _Pragma("unroll") for(int r=4;r<16;r+=4){a=MX3(a,C0[r],C0[r+1]);b=MX3(b,C0[r+2],C0[r+3]);a=MX3(a,C1[r],C1[r+1]);b=MX3(b,C1[r+2],C1[r+3]);} \
      float rm=__builtin_fmaxf(a,b); { auto rr=__builtin_amdgcn_permlane32_swap(__float_as_uint(rm),__float_as_uint(rm),false,false); rm=__builtin_fmaxf(__uint_as_float(rr[0]),__uint_as_float(rr[1])); } \
      resc=false; \
      if(__builtin_expect(__any(rm>(float)THRL),0)){ const float dl=__builtin_fmaxf(rm,0.f); mhat+=dl; \
        _Pragma("unroll") for(int r=0;r<16;++r){C0[r]-=dl;C1[r]-=dl;} \
        _Pragma("unroll") for(int r=0;r<16;++r)negm[r]=-mhat; asm volatile("":"+v"(negm)); \
        const float f=__builtin_amdgcn_exp2f(-dl); l_reg*=f; if(hi==0)wsf[r32]=f; resc=true; } } \
    SBAR(); \
    GAPB(o[0]=__builtin_amdgcn_mfma_f32_32x32x16_bf16(PAF(0),VFR(0),o[0],0,0,0), C0,0); \
    GAPB(o[1]=__builtin_amdgcn_mfma_f32_32x32x16_bf16(PAF(0),VFR(4),o[1],0,0,0), C0,4); \
    KRD(GL,0); GAPB(o[0]=__builtin_amdgcn_mfma_f32_32x32x16_bf16(PAF(1),VFR(1),o[0],0,0,0), C0,8); \
    KRD(GL,1); GAPB(o[1]=__builtin_amdgcn_mfma_f32_32x32x16_bf16(PAF(1),VFR(5),o[1],0,0,0), C0,12); \
    KRD(GL,2); GAPB(o[0]=__builtin_amdgcn_mfma_f32_32x32x16_bf16(PAF(2),VFR(2),o[0],0,0,0), C1,0); \
    KRD(GL,3); GAPB(o[1]=__builtin_amdgcn_mfma_f32_32x32x16_bf16(PAF(2),VFR(6),o[1],0,0,0), C1,4); \
    GAPB(o[0]=__builtin_amdgcn_mfma_f32_32x32x16_bf16(PAF(3),VFR(3),o[0],0,0,0), C1,8); \
    GAPB(o[1]=__builtin_amdgcn_mfma_f32_32x32x16_bf16(PAF(3),VFR(7),o[1],0,0,0), C1,12); \
    }while(0)
  int t=1;
  #undef CMASK
  #define CMASK(P0,P1,t) do{}while(0)
  for(;t+5<NT;t+=2){
    STEP(pB0,pB1,pA0,pA1,t,true,true,true);     WAIT_BAR(2); RESC(); ROT();
    STEP(pA0,pA1,pB0,pB1,t+1,true,true,true);   WAIT_BAR(2); RESC(); ROT();
  }
  #undef CMASK
  #define CMASK(P0,P1,t) do{}while(0)
  #define ENDW(tt) do{ if((tt)+3<NT){WAIT_BAR(2);} else if((tt)+2<NT){WAIT_BAR(1);} else {WAIT_BAR(0);} }while(0)
  for(;t+1<NT;t+=2){
    STEP(pB0,pB1,pA0,pA1,t,(t+3<NT),(t+1<NT),(t+1<NT));       ENDW(t);   RESC(); ROT();
    STEP(pA0,pA1,pB0,pB1,t+1,(t+4<NT),(t+2<NT),(t+2<NT));     ENDW(t+1); RESC(); ROT();
  }
  STEP(pB0,pB1,pA0,pA1,NT-1,false,false,false); RESC();
  { float sacc=pB0[0]+pB0[1]; _Pragma("unroll") for(int r=2;r<16;++r)sacc+=pB0[r]; _Pragma("unroll") for(int r=0;r<16;++r)sacc+=pB1[r]; l_reg+=sacc;
    pw0=(u32x4){PKW(pB0,0),PKW(pB0,2),PKW(pB0,4),PKW(pB0,6)};pw1=(u32x4){PKW(pB0,8),PKW(pB0,10),PKW(pB0,12),PKW(pB0,14)};pw2=(u32x4){PKW(pB1,0),PKW(pB1,2),PKW(pB1,4),PKW(pB1,6)};pw3=(u32x4){PKW(pB1,8),PKW(pB1,10),PKW(pB1,12),PKW(pB1,14)};
    SBAR(); pv(o,vb0+sl_cur,PAF(0),PAF(1),PAF(2),PAF(3)); }
  #undef PKW
  #undef PAF
  #undef VFR
  #undef PIN
  #undef MX3
  #undef GAPA
  #undef GAPB
  #undef EX
  #undef VRD
  #undef KRD
  #undef STEP
  #undef ENDW
  {auto rr=__builtin_amdgcn_permlane32_swap(__float_as_uint(l_reg),__float_as_uint(l_reg),false,false);l_reg=__uint_as_float(rr[0])+__uint_as_float(rr[1]);}
  if(hi==0)wsf[32+r32]=l_reg;asm volatile("s_waitcnt lgkmcnt(0)":::"memory");
  float rli[16];
  #pragma unroll
  for(int r=0;r<16;++r)rli[r]=__builtin_amdgcn_rcpf(wsf[32+crow(r,hi)]);
  bf16*Ow=Oh+(long)(q0+wid*QBLK)*DM;
  { bf16*stg=(bf16*)(shm+LDS_OST)+wid*2048;
    #pragma unroll
    for(int r=0;r<16;++r){const int orow=crow(r,hi);
      #pragma unroll
      for(int d0=0;d0<2;++d0)stg[orow*64+d0*32+r32]=__float2bfloat16(o[d0][r]*rli[r]);}
    asm volatile("s_waitcnt lgkmcnt(0)":::"memory");
    #pragma unroll
    for(int i=0;i<4;++i){const int row=i*8+(lane>>3),ch=lane&7; const u32x4 v=*(const u32x4*)(stg+row*64+ch*8); ATTN_STORE16(Ow+(long)row*DM+ch*8,v);} }
  asm volatile("s_waitcnt lgkmcnt(0)\n\ts_barrier":::"memory");
  #undef DMA_K
  #undef DMA_V
  #undef CMASK
  #undef START
  #undef RESC
  #undef ROT
}
constexpr int ATTN_LDS_BYTES=LDS_BYTES;
#undef SBAR
#undef WAIT_BAR
}

namespace attn2 {
using bf16x8 = __attribute__((ext_vector_type(8))) short;
using s16x4  = __attribute__((ext_vector_type(4))) short;
using f32x16 = __attribute__((ext_vector_type(16))) float;
using u32x4  = __attribute__((ext_vector_type(4))) unsigned;
constexpr int NW = 8, QBLK = 32, KVBLK = 64, LD = 1024, NT = 4096 / KVBLK;
constexpr float THR = 8.0f;
constexpr int SHM_V = KVBLK * 128 * 2, SHM_K = KVBLK * 64 * 2;
constexpr int OST_PITCH = 136;
#define KSWZ(row, colB) ((row) * 128 + ((colB) ^ ((((row) >> 1) & 7) << 4)))
#define SBAR() __builtin_amdgcn_sched_barrier(0)
__device__ __forceinline__ int crow(int r, int hi) { return (r & 3) + 8 * (r >> 2) + 4 * hi; }
__device__ __forceinline__ float bf2f_(unsigned short h) { return __builtin_bit_cast(float, (unsigned)h << 16); }
typedef float f32x2_t __attribute__((ext_vector_type(2))); typedef __bf16 bf16x2_t __attribute__((ext_vector_type(2)));
__device__ __forceinline__ unsigned cvtpk(float lo, float hi) { f32x2_t v = {lo, hi}; bf16x2_t b = __builtin_convertvector(v, bf16x2_t); return __builtin_bit_cast(unsigned, b); }
__device__ __forceinline__ void partialSM(f32x16& p0, f32x16& p1, float& m_reg, float& mn, float& alpha) {
  float pmax = p0[0]; for (int r = 1; r < 16; ++r) pmax = fmaxf(pmax, p0[r]); for (int r = 0; r < 16; ++r) pmax = fmaxf(pmax, p1[r]);
  { auto rr = __builtin_amdgcn_permlane32_swap(__float_as_uint(pmax), __float_as_uint(pmax), false, false);
    pmax = fmaxf(__uint_as_float(rr[0]), __uint_as_float(rr[1])); }
  { const bool keep = __all(pmax - m_reg <= THR);
    mn = keep ? m_reg : fmaxf(m_reg, pmax); alpha = keep ? 1.f : __builtin_amdgcn_exp2f(m_reg - mn); m_reg = mn; }
  for (int r = 0; r < 16; ++r) p0[r] = p0[r] - mn; for (int r = 0; r < 16; ++r) p1[r] = p1[r] - mn;
  for (int r = 0; r < 16; ++r) p0[r] = __builtin_amdgcn_exp2f(p0[r]);
}
__device__ __forceinline__ void finishSM(f32x16& p0, f32x16& p1, float alpha, float& l_reg, bf16x8& pa0, bf16x8& pa1, bf16x8& pa2, bf16x8& pa3) {
  for (int r = 0; r < 16; ++r) p1[r] = __builtin_amdgcn_exp2f(p1[r]);
  float ps = 0; for (int r = 0; r < 16; ++r) ps += p0[r]; for (int r = 0; r < 16; ++r) ps += p1[r];
  { auto rr = __builtin_amdgcn_permlane32_swap(__float_as_uint(ps), __float_as_uint(ps), false, false);
    ps = __uint_as_float(rr[0]) + __uint_as_float(rr[1]); }
  l_reg = l_reg * alpha + ps;
#define PK4(P, BASE, OUT) do { u32x4 w = {cvtpk(P[BASE + 0], P[BASE + 1]), cvtpk(P[BASE + 2], P[BASE + 3]), cvtpk(P[BASE + 4], P[BASE + 5]), cvtpk(P[BASE + 6], P[BASE + 7])}; OUT = *reinterpret_cast<bf16x8*>(&w); } while (0)
  PK4(p0, 0, pa0); PK4(p0, 8, pa1); PK4(p1, 0, pa2); PK4(p1, 8, pa3);
#undef PK4
}
__device__ __forceinline__ void qkt(f32x16& p0, f32x16& p1, const char* Ks, const bf16x8* qr, int r32, int hi) {
  p0 = f32x16{}; p1 = f32x16{};
  for (int d0 = 0; d0 < 4; ++d0) { int cb = (d0 * 16 + hi * 8) * 2;
    bf16x8 b0 = *reinterpret_cast<const bf16x8*>(Ks + KSWZ(r32, cb));
    bf16x8 b1 = *reinterpret_cast<const bf16x8*>(Ks + KSWZ(32 + r32, cb));
    p0 = __builtin_amdgcn_mfma_f32_32x32x16_bf16(b0, qr[d0], p0, 0, 0, 0);
    p1 = __builtin_amdgcn_mfma_f32_32x32x16_bf16(b1, qr[d0], p1, 0, 0, 0); }
}
__device__ __forceinline__ int v_st(int k, int c) { const int kk = (k & ~0xC) | ((k & 4) << 1) | ((k & 8) >> 1); return ((kk >> 3) * 4 + (c >> 5)) * 512 + ((kk & 7) * 32 + (c & 31)) * 2; }
__device__ __forceinline__ int v_rd_base(int lane) { return ((lane & 3) << 3) | (((lane >> 2) & 3) << 6) | (((lane >> 4) & 1) << 5) | (((lane >> 5) & 1) << 8); }
constexpr int v_rd_off(int d0, int ks, int half) { return d0 * 512 + ks * 4096 + half * 2048; }
typedef short v4i16_t __attribute__((ext_vector_type(4)));
typedef __attribute__((address_space(3))) const char* lds_cptr;
__device__ __forceinline__ s16x4 vtr(lds_cptr p) { return __builtin_bit_cast(s16x4, __builtin_amdgcn_ds_read_tr16_b64_v4i16((__attribute__((address_space(3))) v4i16_t*)p)); }
template <int D0> __device__ __forceinline__ void pv_one(f32x16& od, lds_cptr vp, bf16x8 pa0, bf16x8 pa1, bf16x8 pa2, bf16x8 pa3) {
  const s16x4 l0 = vtr(vp + v_rd_off(D0, 0, 0)), h0 = vtr(vp + v_rd_off(D0, 0, 1)), l1 = vtr(vp + v_rd_off(D0, 1, 0)), h1 = vtr(vp + v_rd_off(D0, 1, 1));
  const s16x4 l2 = vtr(vp + v_rd_off(D0, 2, 0)), h2 = vtr(vp + v_rd_off(D0, 2, 1)), l3 = vtr(vp + v_rd_off(D0, 3, 0)), h3 = vtr(vp + v_rd_off(D0, 3, 1));
#define PK(L, H) (bf16x8){L[0], L[1], L[2], L[3], H[0], H[1], H[2], H[3]}
  od = __builtin_amdgcn_mfma_f32_32x32x16_bf16(pa0, PK(l0, h0), od, 0, 0, 0);
  od = __builtin_amdgcn_mfma_f32_32x32x16_bf16(pa1, PK(l1, h1), od, 0, 0, 0);
  od = __builtin_amdgcn_mfma_f32_32x32x16_bf16(pa2, PK(l2, h2), od, 0, 0, 0);
  od = __builtin_amdgcn_mfma_f32_32x32x16_bf16(pa3, PK(l3, h3), od, 0, 0, 0);
#undef PK
}
__device__ __forceinline__ void pv_d0(f32x16* o, lds_cptr vp, bf16x8 pa0, bf16x8 pa1, bf16x8 pa2, bf16x8 pa3) {
  pv_one<0>(o[0], vp, pa0, pa1, pa2, pa3); pv_one<1>(o[1], vp, pa0, pa1, pa2, pa3); pv_one<2>(o[2], vp, pa0, pa1, pa2, pa3); pv_one<3>(o[3], vp, pa0, pa1, pa2, pa3);
}
__device__ __forceinline__ void glds16(const void* gsrc, unsigned lds_dst) { unsigned keep;
  asm volatile("s_mov_b32 %0, m0\n\ts_mov_b32 m0, %2\n\ts_nop 0\n\tglobal_load_lds_dwordx4 %1, off\n\ts_mov_b32 m0, %0" : "=&s"(keep) : "v"(gsrc), "s"(lds_dst) : "memory"); }
#define WAIT_BAR(N) asm volatile("s_waitcnt vmcnt(" #N ") lgkmcnt(0)\n\ts_barrier" ::: "memory")
constexpr int R_V = 0, R_K = 3 * SHM_V, R_WS = R_K + 3 * SHM_K, R_BYTES = R_WS + NW * 64 * 4;
static_assert(NW * 32 * OST_PITCH * 2 <= R_WS, "O stage fits under the rings");
template <int VAR> __device__ __forceinline__ void attn_unit(const bf16* __restrict__ Qb, const bf16* __restrict__ Kh, const bf16* __restrict__ Vh, bf16* __restrict__ Ob, char* lds) {
  const int tid = threadIdx.x, lane = tid & 63, r32 = lane & 31, hi = lane >> 5; const int wid = __builtin_amdgcn_readfirstlane(tid >> 6);
  char* V_lds = lds + R_V; char* K_lds = lds + R_K;
  float* ws = (float*)(lds + R_WS) + wid * 64; float* li_l = ws; float* al_l = ws + 32;
  const unsigned lds0 = (unsigned)(uintptr_t)lds;
  const int krow = 8 * wid + (lane >> 3), kch = (lane & 7) ^ ((krow >> 1) & 7);
  const bf16* ksrc = Kh + (long)krow * LD + 8 * kch;
  const int vkk = wid * 8 + ((lane & 31) >> 2), vk = vkk;
  const bf16* vsrc0 = Vh + (long)vk * LD + (lane >> 5) * 32 + 8 * (lane & 3);
  const bf16* vsrc1 = vsrc0 + 64;
  const unsigned kdst = lds0 + R_K + wid * 1024, vdst = lds0 + R_V + wid * 2048;
#define DMA_K(t, slotB) if constexpr (!(VAR & 4)) glds16(ksrc + (long)(t) * KVBLK * LD, (unsigned)__builtin_amdgcn_readfirstlane(kdst + (slotB)))
#define DMA_V(t, slotB) do { if constexpr (!(VAR & 4)) { glds16(vsrc0 + (long)(t) * KVBLK * LD, (unsigned)__builtin_amdgcn_readfirstlane(vdst + (slotB))); glds16(vsrc1 + (long)(t) * KVBLK * LD, (unsigned)__builtin_amdgcn_readfirstlane(vdst + (slotB) + 1024)); } } while (0)
  DMA_K(0, 0); DMA_V(0, 0); DMA_K(1, SHM_K);
  const unsigned bsel_w = ((((lane >> 4) & 1) != 0) == ((lane & 15) >= 8)) ? 0x3F803F80u : 0u;
  const bf16x8 bsel = __builtin_bit_cast(bf16x8, (u32x4){bsel_w, bsel_w, bsel_w, bsel_w});
  f32x4 osum = {};
  const int osrow = ((lane & 15) >= 8 ? 16 : 0) + 4 * (lane >> 4);
  float mhat = 0.f; f32x16 o[4] = {}; bf16x8 qr[4];
#define QNEG(m) __builtin_bit_cast(bf16x8, (u32x4){hi == 0 ? f2bf(-(m)) : 0u, 0u, 0u, 0u})
  const bf16x8 kone = __builtin_bit_cast(bf16x8, (u32x4){hi == 0 ? 0x3F80u : 0u, 0u, 0u, 0u});
  bf16x8 qneg = QNEG(0.f);
  const bf16* Qw = Qb + (long)(wid * QBLK + r32) * LD + hi * 8;
#pragma unroll
  for (int d0 = 0; d0 < 4; ++d0) qr[d0] = *reinterpret_cast<const bf16x8*>(Qw + d0 * 16);
  const lds_cptr vb0 = (lds_cptr)(__attribute__((address_space(3))) const char*)(__attribute__((address_space(3))) char*)((__attribute__((address_space(3))) char*)0 + ((unsigned)(uintptr_t)V_lds + v_rd_base(lane)));
#define RESC(a) do { if (__any((a) < 1.f)) { if (hi == 0) al_l[r32] = (a); asm volatile("s_waitcnt lgkmcnt(0)" ::: "memory"); \
    for (int d = 0; d < 4; ++d) for (int r = 0; r < 16; ++r) o[d][r] *= al_l[crow(r, hi)]; osum *= *(const f32x4*)(al_l + osrow); } } while (0)
  f32x16 pA0, pA1, pB0, pB1; float mnA, mnB, alA, alB; bf16x8 pa0, pa1, pa2, pa3;
  u32x4 pw0 = {}, pw1 = {}, pw2 = {}, pw3 = {}; s16x4 vAl0 = {}, vAl1 = {}, vAl2 = {}, vAl3 = {}, vAh0 = {}, vAh1 = {}, vAh2 = {}, vAh3 = {}, vBl0 = {}, vBl1 = {}, vBl2 = {}, vBl3 = {}, vBh0 = {}, vBh1 = {}, vBh2 = {}, vBh3 = {};
  WAIT_BAR(0);
  qkt(pA0, pA1, K_lds, qr, r32, hi);
  { float pmax = pA0[0]; for (int r = 1; r < 16; ++r) pmax = fmaxf(pmax, pA0[r]); for (int r = 0; r < 16; ++r) pmax = fmaxf(pmax, pA1[r]);
    { auto rr = __builtin_amdgcn_permlane32_swap(__float_as_uint(pmax), __float_as_uint(pmax), false, false); pmax = fmaxf(__uint_as_float(rr[0]), __uint_as_float(rr[1])); }
    mhat = bf2f_((unsigned short)f2bf(pmax)); qneg = QNEG(mhat); alA = 1.f; mnA = mhat;
    for (int r = 0; r < 16; ++r) { pA0[r] = __builtin_amdgcn_exp2f(pA0[r] - mhat); } for (int r = 0; r < 16; ++r) pA1[r] = pA1[r] - mhat; }
  DMA_K(2, 2 * SHM_K); DMA_V(1, SHM_V);
  WAIT_BAR(3);
  int kc = SHM_K, kf = 0, vp = 0, vf = 2 * SHM_V;
#ifndef ATT_SGB
#define ATT_SGB 0
#endif
#if ATT_SGB == 1
#define ATT_PIPE() do { __builtin_amdgcn_sched_group_barrier(0x100, 8, 0); \
    _Pragma("unroll") for (int g_ = 0; g_ < 8; ++g_) { __builtin_amdgcn_sched_group_barrier(0x8, 1, 0); __builtin_amdgcn_sched_group_barrier(0x100, 2, 0); __builtin_amdgcn_sched_group_barrier(0x2, 12, 0); } \
    _Pragma("unroll") for (int g_ = 0; g_ < 8; ++g_) { __builtin_amdgcn_sched_group_barrier(0x8, 1, 0); __builtin_amdgcn_sched_group_barrier(0x100, 2, 0); __builtin_amdgcn_sched_group_barrier(0x2, 6, 0); } \
    _Pragma("unroll") for (int g_ = 0; g_ < 8; ++g_) { __builtin_amdgcn_sched_group_barrier(0x8, 1, 0); __builtin_amdgcn_sched_group_barrier(0x2, 6, 0); } } while (0)
#elif ATT_SGB == 2
#define ATT_PIPE() __builtin_amdgcn_iglp_opt(2)
#elif ATT_SGB == 3
#define ATT_PIPE() __builtin_amdgcn_iglp_opt(3)
#else
#define ATT_PIPE() do {} while (0)
#endif
#define STEP(N0, N1, mnN, alN, O0, O1, alO, j) do { \
    if ((j) + 2 < NT) DMA_K((j) + 2, kf); if ((j) + 1 < NT) DMA_V((j) + 1, vf); \
    SBAR(); qkt(N0, N1, K_lds + kc, qr, r32, hi); \
    finishSM(O0, O1, alO, l_reg, pa0, pa1, pa2, pa3); \
    pv_d0(o, vb0 + vp, pa0, pa1, pa2, pa3); partialSM(N0, N1, m_reg, mnN, alN); \
    ATT_PIPE(); SBAR(); \
    RESC(alN); \
    if ((j) + 2 < NT) WAIT_BAR(3); else if ((j) + 1 < NT) WAIT_BAR(2); else WAIT_BAR(0); \
    { const int t_ = kf; kf = kc; kc = (kc == 2 * SHM_K) ? 0 : kc + SHM_K; (void)t_; } \
    { vf = vp; vp = (vp == 2 * SHM_V) ? 0 : vp + SHM_V; } } while (0)
#define MX3(a, b, c) __builtin_fmaxf(__builtin_fmaxf((a), (b)), (c))
#define PIN(x) asm volatile("" : "+v"(x))
  const int kswz_ = ((r32 >> 1) & 7) << 4;
  const int koff0 = r32 * 128 + ((0 * 32 + hi * 16) ^ kswz_), koff1 = r32 * 128 + ((1 * 32 + hi * 16) ^ kswz_), koff2 = r32 * 128 + ((2 * 32 + hi * 16) ^ kswz_), koff3 = r32 * 128 + ((3 * 32 + hi * 16) ^ kswz_);
#define STEP2(N0, N1, mnN, alN, O0, O1, alO, j) do { \
    if ((j) + 2 < NT) DMA_K((j) + 2, kf); if ((j) + 1 < NT) DMA_V((j) + 1, vf); \
    SBAR(); \
    const char* Kp_ = K_lds + kc; const lds_cptr vq_ = vb0 + vp; \
    const bf16x8 k00 = *reinterpret_cast<const bf16x8*>(Kp_ + koff0), k01 = *reinterpret_cast<const bf16x8*>(Kp_ + koff0 + 4096); \
    const bf16x8 k10 = *reinterpret_cast<const bf16x8*>(Kp_ + koff1), k11 = *reinterpret_cast<const bf16x8*>(Kp_ + koff1 + 4096); \
    const bf16x8 k20 = *reinterpret_cast<const bf16x8*>(Kp_ + koff2), k21 = *reinterpret_cast<const bf16x8*>(Kp_ + koff2 + 4096); \
    const bf16x8 k30 = *reinterpret_cast<const bf16x8*>(Kp_ + koff3), k31 = *reinterpret_cast<const bf16x8*>(Kp_ + koff3 + 4096); \
    unsigned ca0, ca1, cb0, cb1; \
    SBAR(); \
    N0 = __builtin_amdgcn_mfma_f32_32x32x16_bf16(kone, qneg, (f32x16){}, 0, 0, 0); N1 = __builtin_amdgcn_mfma_f32_32x32x16_bf16(kone, qneg, (f32x16){}, 0, 0, 0); SBAR(); \
     N0 = __builtin_amdgcn_mfma_f32_32x32x16_bf16(k00, qr[0], N0, 0, 0, 0); if constexpr (!(VAR & 1)) { ca0 = cvtpk(O0[0], O0[1]); ca1 = cvtpk(O0[2], O0[3]); } SBAR(); \
     N1 = __builtin_amdgcn_mfma_f32_32x32x16_bf16(k01, qr[0], N1, 0, 0, 0); if constexpr (!(VAR & 1)) { cb0 = cvtpk(O0[4], O0[5]); cb1 = cvtpk(O0[6], O0[7]); pw0 = (u32x4){ca0, ca1, cb0, cb1}; PIN(pw0); } SBAR(); \
     N0 = __builtin_amdgcn_mfma_f32_32x32x16_bf16(k10, qr[1], N0, 0, 0, 0); if constexpr (!(VAR & 1)) { ca0 = cvtpk(O0[8], O0[9]); ca1 = cvtpk(O0[10], O0[11]); } SBAR(); \
     N1 = __builtin_amdgcn_mfma_f32_32x32x16_bf16(k11, qr[1], N1, 0, 0, 0); if constexpr (!(VAR & 1)) { cb0 = cvtpk(O0[12], O0[13]); cb1 = cvtpk(O0[14], O0[15]); pw1 = (u32x4){ca0, ca1, cb0, cb1}; PIN(pw1); } SBAR(); \
    if constexpr (!(VAR & 8)) { vAl0 = vtr(vq_ + 0); vAh0 = vtr(vq_ + 2048); } N0 = __builtin_amdgcn_mfma_f32_32x32x16_bf16(k20, qr[2], N0, 0, 0, 0); if constexpr (!(VAR & 1)) { ca0 = cvtpk(O1[0], O1[1]); ca1 = cvtpk(O1[2], O1[3]); } SBAR(); \
    if constexpr (!(VAR & 8)) { vAl1 = vtr(vq_ + 4096); vAh1 = vtr(vq_ + 6144); } N1 = __builtin_amdgcn_mfma_f32_32x32x16_bf16(k21, qr[2], N1, 0, 0, 0); if constexpr (!(VAR & 1)) { cb0 = cvtpk(O1[4], O1[5]); cb1 = cvtpk(O1[6], O1[7]); pw2 = (u32x4){ca0, ca1, cb0, cb1}; PIN(pw2); } SBAR(); \
    if constexpr (!(VAR & 8)) { vAl2 = vtr(vq_ + 8192); vAh2 = vtr(vq_ + 10240); } N0 = __builtin_amdgcn_mfma_f32_32x32x16_bf16(k30, qr[3], N0, 0, 0, 0); if constexpr (!(VAR & 1)) { ca0 = cvtpk(O1[8], O1[9]); ca1 = cvtpk(O1[10], O1[11]); } SBAR(); \
    if constexpr (!(VAR & 8)) { vAl3 = vtr(vq_ + 12288); vAh3 = vtr(vq_ + 14336); } N1 = __builtin_amdgcn_mfma_f32_32x32x16_bf16(k31, qr[3], N1, 0, 0, 0); if constexpr (!(VAR & 1)) { cb0 = cvtpk(O1[12], O1[13]); cb1 = cvtpk(O1[14], O1[15]); pw3 = (u32x4){ca0, ca1, cb0, cb1}; PIN(pw3); } SBAR(); \
    float mxa_, mxb_, rm_; \
    if constexpr (!(VAR & 8)) { vBl0 = vtr(vq_ + 512); vBh0 = vtr(vq_ + 2560); } o[0] = __builtin_amdgcn_mfma_f32_32x32x16_bf16(__builtin_bit_cast(bf16x8, pw0), (bf16x8){vAl0[0], vAl0[1], vAl0[2], vAl0[3], vAh0[0], vAh0[1], vAh0[2], vAh0[3]}, o[0], 0, 0, 0); if constexpr (!(VAR & 2)) { mxa_ = MX3(N0[0], N0[1], N1[0]); mxb_ = MX3(N0[2], N0[3], N1[1]); mxa_ = MX3(mxa_, N1[2], N1[3]); mxa_ = MX3(mxa_, N0[4], N0[5]); mxb_ = MX3(mxb_, N0[6], N0[7]); mxa_ = MX3(mxa_, N1[4], N1[5]); mxb_ = MX3(mxb_, N1[6], N1[7]); PIN(mxa_); PIN(mxb_); } SBAR(); \
    if constexpr (!(VAR & 8)) { vBl1 = vtr(vq_ + 4608); vBh1 = vtr(vq_ + 6656); } o[0] = __builtin_amdgcn_mfma_f32_32x32x16_bf16(__builtin_bit_cast(bf16x8, pw1), (bf16x8){vAl1[0], vAl1[1], vAl1[2], vAl1[3], vAh1[0], vAh1[1], vAh1[2], vAh1[3]}, o[0], 0, 0, 0); if constexpr (!(VAR & 2)) { mxa_ = MX3(mxa_, N0[8], N0[9]); mxb_ = MX3(mxb_, N0[10], N0[11]); mxa_ = MX3(mxa_, N1[8], N1[9]); mxb_ = MX3(mxb_, N1[10], N1[11]); mxa_ = MX3(mxa_, N0[12], N0[13]); mxb_ = MX3(mxb_, N0[14], N0[15]); mxa_ = MX3(mxa_, N1[12], N1[13]); mxb_ = MX3(mxb_, N1[14], N1[15]); PIN(mxa_); PIN(mxb_); } SBAR(); \
    if constexpr (!(VAR & 8)) { vBl2 = vtr(vq_ + 8704); vBh2 = vtr(vq_ + 10752); } o[0] = __builtin_amdgcn_mfma_f32_32x32x16_bf16(__builtin_bit_cast(bf16x8, pw2), (bf16x8){vAl2[0], vAl2[1], vAl2[2], vAl2[3], vAh2[0], vAh2[1], vAh2[2], vAh2[3]}, o[0], 0, 0, 0); if constexpr (!(VAR & 2)) { rm_ = __builtin_fmaxf(mxa_, mxb_); { auto rr_ = __builtin_amdgcn_permlane32_swap(__float_as_uint(rm_), __float_as_uint(rm_), false, false); rm_ = __builtin_fmaxf(__uint_as_float(rr_[0]), __uint_as_float(rr_[1])); } alN = 1.f; if (__builtin_expect(!__all(rm_ <= THR), 0)) { const float mh2_ = bf2f_((unsigned short)f2bf(mhat + __builtin_fmaxf(rm_, 0.f))), dl_ = mh2_ - mhat; mhat = mh2_; alN = __builtin_amdgcn_exp2f(-dl_); _Pragma("unroll") for (int r_ = 0; r_ < 16; ++r_) { N0[r_] -= dl_; N1[r_] -= dl_; } qneg = QNEG(mhat); } PIN(alN); } SBAR(); \
    if constexpr (!(VAR & 8)) { vBl3 = vtr(vq_ + 12800); vBh3 = vtr(vq_ + 14848); } o[0] = __builtin_amdgcn_mfma_f32_32x32x16_bf16(__builtin_bit_cast(bf16x8, pw3), (bf16x8){vAl3[0], vAl3[1], vAl3[2], vAl3[3], vAh3[0], vAh3[1], vAh3[2], vAh3[3]}, o[0], 0, 0, 0); if constexpr (!(VAR & 2)) { N0[0] = __builtin_amdgcn_exp2f(N0[0]); N0[1] = __builtin_amdgcn_exp2f(N0[1]); N0[2] = __builtin_amdgcn_exp2f(N0[2]); N0[3] = __builtin_amdgcn_exp2f(N0[3]); PIN(N0); } SBAR(); \
    if constexpr (!(VAR & 8)) { vAl0 = vtr(vq_ + 1024); vAh0 = vtr(vq_ + 3072); } o[1] = __builtin_amdgcn_mfma_f32_32x32x16_bf16(__builtin_bit_cast(bf16x8, pw0), (bf16x8){vBl0[0], vBl0[1], vBl0[2], vBl0[3], vBh0[0], vBh0[1], vBh0[2], vBh0[3]}, o[1], 0, 0, 0); if constexpr (!(VAR & 2)) { N0[4] = __builtin_amdgcn_exp2f(N0[4]); N0[5] = __builtin_amdgcn_exp2f(N0[5]); N0[6] = __builtin_amdgcn_exp2f(N0[6]); N0[7] = __builtin_amdgcn_exp2f(N0[7]); PIN(N0); } SBAR(); \
    if constexpr (!(VAR & 8)) { vAl1 = vtr(vq_ + 5120); vAh1 = vtr(vq_ + 7168); } o[1] = __builtin_amdgcn_mfma_f32_32x32x16_bf16(__builtin_bit_cast(bf16x8, pw1), (bf16x8){vBl1[0], vBl1[1], vBl1[2], vBl1[3], vBh1[0], vBh1[1], vBh1[2], vBh1[3]}, o[1], 0, 0, 0); if constexpr (!(VAR & 2)) { N0[8] = __builtin_amdgcn_exp2f(N0[8]); N0[9] = __builtin_amdgcn_exp2f(N0[9]); N0[10] = __builtin_amdgcn_exp2f(N0[10]); N0[11] = __builtin_amdgcn_exp2f(N0[11]); PIN(N0); } SBAR(); \
    if constexpr (!(VAR & 8)) { vAl2 = vtr(vq_ + 9216); vAh2 = vtr(vq_ + 11264); } o[1] = __builtin_amdgcn_mfma_f32_32x32x16_bf16(__builtin_bit_cast(bf16x8, pw2), (bf16x8){vBl2[0], vBl2[1], vBl2[2], vBl2[3], vBh2[0], vBh2[1], vBh2[2], vBh2[3]}, o[1], 0, 0, 0); if constexpr (!(VAR & 2)) { N0[12] = __builtin_amdgcn_exp2f(N0[12]); N0[13] = __builtin_amdgcn_exp2f(N0[13]); N0[14] = __builtin_amdgcn_exp2f(N0[14]); N0[15] = __builtin_amdgcn_exp2f(N0[15]); PIN(N0); } SBAR(); \
    if constexpr (!(VAR & 8)) { vAl3 = vtr(vq_ + 13312); vAh3 = vtr(vq_ + 15360); } o[1] = __builtin_amdgcn_mfma_f32_32x32x16_bf16(__builtin_bit_cast(bf16x8, pw3), (bf16x8){vBl3[0], vBl3[1], vBl3[2], vBl3[3], vBh3[0], vBh3[1], vBh3[2], vBh3[3]}, o[1], 0, 0, 0); if constexpr (!(VAR & 2)) { N1[0] = __builtin_amdgcn_exp2f(N1[0]); N1[1] = __builtin_amdgcn_exp2f(N1[1]); N1[2] = __builtin_amdgcn_exp2f(N1[2]); N1[3] = __builtin_amdgcn_exp2f(N1[3]); PIN(N1); } SBAR(); \
    if constexpr (!(VAR & 8)) { vBl0 = vtr(vq_ + 1536); vBh0 = vtr(vq_ + 3584); } o[2] = __builtin_amdgcn_mfma_f32_32x32x16_bf16(__builtin_bit_cast(bf16x8, pw0), (bf16x8){vAl0[0], vAl0[1], vAl0[2], vAl0[3], vAh0[0], vAh0[1], vAh0[2], vAh0[3]}, o[2], 0, 0, 0); if constexpr (!(VAR & 2)) { N1[4] = __builtin_amdgcn_exp2f(N1[4]); N1[5] = __builtin_amdgcn_exp2f(N1[5]); N1[6] = __builtin_amdgcn_exp2f(N1[6]); N1[7] = __builtin_amdgcn_exp2f(N1[7]); PIN(N1); } SBAR(); \
    if constexpr (!(VAR & 8)) { vBl1 = vtr(vq_ + 5632); vBh1 = vtr(vq_ + 7680); } o[2] = __builtin_amdgcn_mfma_f32_32x32x16_bf16(__builtin_bit_cast(bf16x8, pw1), (bf16x8){vAl1[0], vAl1[1], vAl1[2], vAl1[3], vAh1[0], vAh1[1], vAh1[2], vAh1[3]}, o[2], 0, 0, 0); if constexpr (!(VAR & 2)) { N1[8] = __builtin_amdgcn_exp2f(N1[8]); N1[9] = __builtin_amdgcn_exp2f(N1[9]); N1[10] = __builtin_amdgcn_exp2f(N1[10]); N1[11] = __builtin_amdgcn_exp2f(N1[11]); PIN(N1); } SBAR(); \
    if constexpr (!(VAR & 8)) { vBl2 = vtr(vq_ + 9728); vBh2 = vtr(vq_ + 11776); } o[2] = __builtin_amdgcn_mfma_f32_32x32x16_bf16(__builtin_bit_cast(bf16x8, pw2), (bf16x8){vAl2[0], vAl2[1], vAl2[2], vAl2[3], vAh2[0], vAh2[1], vAh2[2], vAh2[3]}, o[2], 0, 0, 0); if constexpr (!(VAR & 2)) { N1[12] = __builtin_amdgcn_exp2f(N1[12]); N1[13] = __builtin_amdgcn_exp2f(N1[13]); N1[14] = __builtin_amdgcn_exp2f(N1[14]); N1[15] = __builtin_amdgcn_exp2f(N1[15]); PIN(N1); } SBAR(); \
    if constexpr (!(VAR & 8)) { vBl3 = vtr(vq_ + 13824); vBh3 = vtr(vq_ + 15872); } o[2] = __builtin_amdgcn_mfma_f32_32x32x16_bf16(__builtin_bit_cast(bf16x8, pw3), (bf16x8){vAl3[0], vAl3[1], vAl3[2], vAl3[3], vAh3[0], vAh3[1], vAh3[2], vAh3[3]}, o[2], 0, 0, 0);  SBAR(); \
     o[3] = __builtin_amdgcn_mfma_f32_32x32x16_bf16(__builtin_bit_cast(bf16x8, pw0), (bf16x8){vBl0[0], vBl0[1], vBl0[2], vBl0[3], vBh0[0], vBh0[1], vBh0[2], vBh0[3]}, o[3], 0, 0, 0); osum = __builtin_amdgcn_mfma_f32_16x16x32_bf16(__builtin_bit_cast(bf16x8, pw0), bsel, osum, 0, 0, 0);  SBAR(); \
     o[3] = __builtin_amdgcn_mfma_f32_32x32x16_bf16(__builtin_bit_cast(bf16x8, pw1), (bf16x8){vBl1[0], vBl1[1], vBl1[2], vBl1[3], vBh1[0], vBh1[1], vBh1[2], vBh1[3]}, o[3], 0, 0, 0); osum = __builtin_amdgcn_mfma_f32_16x16x32_bf16(__builtin_bit_cast(bf16x8, pw1), bsel, osum, 0, 0, 0);  SBAR(); \
     o[3] = __builtin_amdgcn_mfma_f32_32x32x16_bf16(__builtin_bit_cast(bf16x8, pw2), (bf16x8){vBl2[0], vBl2[1], vBl2[2], vBl2[3], vBh2[0], vBh2[1], vBh2[2], vBh2[3]}, o[3], 0, 0, 0); osum = __builtin_amdgcn_mfma_f32_16x16x32_bf16(__builtin_bit_cast(bf16x8, pw2), bsel, osum, 0, 0, 0);  SBAR(); \
     o[3] = __builtin_amdgcn_mfma_f32_32x32x16_bf16(__builtin_bit_cast(bf16x8, pw3), (bf16x8){vBl3[0], vBl3[1], vBl3[2], vBl3[3], vBh3[0], vBh3[1], vBh3[2], vBh3[3]}, o[3], 0, 0, 0); osum = __builtin_amdgcn_mfma_f32_16x16x32_bf16(__builtin_bit_cast(bf16x8, pw3), bsel, osum, 0, 0, 0);  SBAR(); \
    if constexpr (VAR & 2) { alN = 1.f; asm volatile("" :: "v"(N0), "v"(N1)); } \
    RESC(alN); \
    if constexpr (VAR & 4) WAIT_BAR(0); else { if ((j) + 2 < NT) WAIT_BAR(3); else if ((j) + 1 < NT) WAIT_BAR(2); else WAIT_BAR(0); } \
    { const int t_ = kf; kf = kc; kc = (kc == 2 * SHM_K) ? 0 : kc + SHM_K; (void)t_; } \
    { vf = vp; vp = (vp == 2 * SHM_V) ? 0 : vp + SHM_V; } } while (0)
  for (int r = 0; r < 16; ++r) pA1[r] = __builtin_amdgcn_exp2f(pA1[r]);
  for (int j = 1; j + 1 < NT; j += 2) {
    STEP2(pB0, pB1, mnB, alB, pA0, pA1, alA, j);
    STEP2(pA0, pA1, mnA, alA, pB0, pB1, alB, j + 1);
  }
  STEP2(pB0, pB1, mnB, alB, pA0, pA1, alA, NT - 1);
  {
#define PK4(P, BASE, OUT) do { u32x4 w = {cvtpk(P[BASE + 0], P[BASE + 1]), cvtpk(P[BASE + 2], P[BASE + 3]), cvtpk(P[BASE + 4], P[BASE + 5]), cvtpk(P[BASE + 6], P[BASE + 7])}; OUT = *reinterpret_cast<bf16x8*>(&w); } while (0)
    PK4(pB0, 0, pa0); PK4(pB0, 8, pa1); PK4(pB1, 0, pa2); PK4(pB1, 8, pa3);
#undef PK4
    SBAR(); pv_d0(o, vb0 + vp, pa0, pa1, pa2, pa3);
    osum = __builtin_amdgcn_mfma_f32_16x16x32_bf16(pa0, bsel, osum, 0, 0, 0); osum = __builtin_amdgcn_mfma_f32_16x16x32_bf16(pa1, bsel, osum, 0, 0, 0);
    osum = __builtin_amdgcn_mfma_f32_16x16x32_bf16(pa2, bsel, osum, 0, 0, 0); osum = __builtin_amdgcn_mfma_f32_16x16x32_bf16(pa3, bsel, osum, 0, 0, 0); }
#undef MX3
#undef PIN
  if ((lane & 7) == 0) *(f32x4*)(li_l + osrow) = osum;
  WAIT_BAR(0);
  float rli[16];
#pragma unroll
  for (int r = 0; r < 16; ++r) rli[r] = __builtin_amdgcn_rcpf(li_l[crow(r, hi)]);
  unsigned short* stg = (unsigned short*)lds + wid * 32 * OST_PITCH;
#pragma unroll
  for (int r = 0; r < 16; ++r) { const int orow = crow(r, hi);
#pragma unroll
    for (int d0 = 0; d0 < 4; ++d0) stg[orow * OST_PITCH + d0 * 32 + r32] = (unsigned short)f2bf(o[d0][r] * rli[r]); }
  asm volatile("s_waitcnt lgkmcnt(0)" ::: "memory");
  bf16* Ow = Ob + (long)(wid * QBLK) * LD;
#pragma unroll
  for (int i = 0; i < 8; ++i) { const int row = i * 4 + (lane >> 4), ch = lane & 15; const u32x4 v = *(const u32x4*)(stg + row * OST_PITCH + ch * 8); *(u32x4*)(Ow + (long)row * LD + ch * 8) = v; }
  WAIT_BAR(0);
#undef DMA_K
#undef DMA_V
#undef RESC
#undef STEP
#undef STEP2
#undef QNEG
}
#undef WAIT_BAR
#undef KSWZ
#undef SBAR
}

#define RLX_AGENT __ATOMIC_RELAXED, __HIP_MEMORY_SCOPE_AGENT
#define XB_TMO      128
#define XB_XCNT(j)  (256  + 64 * (j))
#define XB_XSUB(j)  (1280 + 64 * (j))
#define XB_XGEN(j)  (2304 + 64 * (j))
#define XB_TOP      3328
#define XB_TOPGEN   3392
#define XCD_BAR_WORDS 3456
#define XB_SPIN_CAP (1u << 18)

__device__ __forceinline__ unsigned xb_ld(unsigned* p)              { return __hip_atomic_load(p, __ATOMIC_RELAXED, __HIP_MEMORY_SCOPE_AGENT); }
__device__ __forceinline__ unsigned xb_add(unsigned* p, unsigned v) { return __hip_atomic_fetch_add(p, v, __ATOMIC_RELAXED, __HIP_MEMORY_SCOPE_AGENT); }
__device__ __forceinline__ unsigned xb_xcc_id() { return (unsigned)__builtin_amdgcn_s_getreg((3 << 11) | 20) & 0xFu; }
#define XB_SPIN(cond, bar) do { unsigned _sp = 0; while (cond) { __builtin_amdgcn_s_sleep(1); \
    if ((++_sp & 255u) == 0u) { if (xb_ld(&(bar)[XB_TMO])) break; if (_sp > XB_SPIN_CAP) { atomicAdd(&(bar)[XB_TMO], 1u); break; } } } } while (0)

struct XcdBarrier {
    unsigned* bar; unsigned x;
    volatile LAS unsigned* st;
};

__device__ __forceinline__ XcdBarrier xcd_barrier_post(unsigned* bar, volatile LAS unsigned* st) {
    XcdBarrier b; b.bar = bar; b.x = xb_xcc_id(); b.st = st;
    if (threadIdx.x == 0) (void)xb_add(&bar[XB_XCNT(b.x)], 1u);
    return b;
}
__device__ __forceinline__ void xcd_barrier_complete(unsigned* bar, unsigned x, unsigned& nloc, unsigned& nx) {
    const unsigned G = gridDim.x * gridDim.y * gridDim.z;
    unsigned sum, cnt, mine, sp = 0u;
    for (;;) {
        sum = 0u; cnt = 0u; mine = 0u;
#pragma unroll
        for (unsigned j = 0; j < 16; ++j) { const unsigned c = xb_ld(&bar[XB_XCNT(j)]); sum += c; cnt += (c > 0u) ? 1u : 0u; mine = (j == x) ? c : mine; }
        if (sum == G) break;
        __builtin_amdgcn_s_sleep(1);
        if ((++sp & 255u) == 0u) { if (xb_ld(&bar[XB_TMO])) break; if (sp > XB_SPIN_CAP) { atomicAdd(&bar[XB_TMO], 1u); break; } }
    }
    nloc = mine > 0u ? mine : 1u; nx = cnt > 0u ? cnt : 1u;
}

__device__ __forceinline__ void xcd_barrier(const XcdBarrier& b) {
    asm volatile("s_waitcnt vmcnt(0)" ::: "memory");
    __syncthreads();
    if (threadIdx.x == 0) {
        unsigned* bar = b.bar;
        __builtin_amdgcn_s_waitcnt(0);
        unsigned nloc = b.st[0], nx = b.st[1];
        if (nloc == 0u) { xcd_barrier_complete(bar, b.x, nloc, nx); b.st[0] = nloc; b.st[1] = nx; }
        const unsigned old = xb_add(&bar[XB_XSUB(b.x)], 1u);
        const unsigned gen = old / nloc;
        if (old + 1u == (gen + 1u) * nloc) {
            __builtin_amdgcn_fence(__ATOMIC_RELEASE, "agent");
            asm volatile("s_waitcnt vmcnt(0)" ::: "memory");
            const unsigned og = xb_add(&bar[XB_TOP], 1u);
            const unsigned tg = og / nx;
            if (og + 1u == (tg + 1u) * nx) xb_add(&bar[XB_TOPGEN], 1u);
            else XB_SPIN(xb_ld(&bar[XB_TOPGEN]) == tg, bar);
            __builtin_amdgcn_fence(__ATOMIC_ACQUIRE, "agent");
            xb_add(&bar[XB_XGEN(b.x)], 1u);
            asm volatile("s_waitcnt vmcnt(0)" ::: "memory");
        } else {
            XB_SPIN(xb_ld(&bar[XB_XGEN(b.x)]) == gen, bar);
            __builtin_amdgcn_fence(__ATOMIC_ACQUIRE, "agent");
            asm volatile("s_waitcnt vmcnt(0)" ::: "memory");
        }
    }
    __syncthreads();
}

__global__ void __launch_bounds__(512) k_pool_only(Params P) { ph_pool(P, blockIdx.x * 8 + (threadIdx.x >> 6), gridDim.x * 8, threadIdx.x & 63); }
template <class Epi> __global__ void __launch_bounds__(256) k_gemm_naive(const bf16* A, const bf16* Bt, int K, Epi epi) {
    __shared__ float As[64][33], Bs[64][33];
    const int tid = threadIdx.x, tx = tid & 15, ty = tid >> 4, gz = blockIdx.z;
    const size_t arow0 = (size_t)epi.a_row0(gz) + blockIdx.y * 64, brow0 = (size_t)epi.b_row0(gz) + blockIdx.x * 64;
    float acc[4][4];
#pragma unroll
    for (int i = 0; i < 4; ++i)
#pragma unroll
        for (int j = 0; j < 4; ++j) acc[i][j] = 0.f;
    const int lr = tid >> 2, lc = (tid & 3) * 8;
    for (int k0 = 0; k0 < K; k0 += 32) {
        const v4u a = *(const v4u*)(A + (arow0 + lr) * K + k0 + lc), b = *(const v4u*)(Bt + (brow0 + lr) * K + k0 + lc);
        As[lr][lc + 0] = bf_lo(a.x); As[lr][lc + 1] = bf_hi(a.x); As[lr][lc + 2] = bf_lo(a.y); As[lr][lc + 3] = bf_hi(a.y); As[lr][lc + 4] = bf_lo(a.z); As[lr][lc + 5] = bf_hi(a.z); As[lr][lc + 6] = bf_lo(a.w); As[lr][lc + 7] = bf_hi(a.w);
        Bs[lr][lc + 0] = bf_lo(b.x); Bs[lr][lc + 1] = bf_hi(b.x); Bs[lr][lc + 2] = bf_lo(b.y); Bs[lr][lc + 3] = bf_hi(b.y); Bs[lr][lc + 4] = bf_lo(b.z); Bs[lr][lc + 5] = bf_hi(b.z); Bs[lr][lc + 6] = bf_lo(b.w); Bs[lr][lc + 7] = bf_hi(b.w);
        __syncthreads();
#pragma unroll 8
        for (int k = 0; k < 32; ++k) { float av[4], bv[4];
#pragma unroll
            for (int i = 0; i < 4; ++i) { av[i] = As[ty * 4 + i][k]; bv[i] = Bs[tx * 4 + i][k]; }
#pragma unroll
            for (int i = 0; i < 4; ++i)
#pragma unroll
                for (int j = 0; j < 4; ++j) acc[i][j] += av[i] * bv[j]; }
        __syncthreads();
    }
#pragma unroll
    for (int i = 0; i < 4; ++i)
#pragma unroll
        for (int j = 0; j < 4; ++j) epi(gz, blockIdx.y * 64 + ty * 4 + i, blockIdx.x * 64 + tx * 4 + j, acc[i][j]);
}
struct NEpiIn { unsigned char* ws;
    __device__ int a_row0(int) const { return 0; } __device__ int b_row0(int) const { return 0; }
    __device__ void operator()(int, int r, int c, float z) const {
        if (c < 1024) ((bf16*)(ws + WS_U))[(size_t)r * D + c] = (bf16)f2bf(z);
        else if (c < 3072) ((float*)(ws + WS_QKF))[(size_t)r * 2048 + (c - 1024)] = z;
        else if (c < 4096) ((bf16*)(ws + WS_V))[(size_t)r * D + c - 3072] = (bf16)f2bf(z);
        else if (c < 5120) ((bf16*)(ws + WS_GP))[(size_t)r * D + c - 4096] = (bf16)f2bf(sigmoidf_(z));
        else ((bf16*)(ws + WS_GA))[(size_t)r * D + c - 5120] = (bf16)f2bf(sigmoidf_(z));
    } };
__global__ void __launch_bounds__(256) k_rope_naive(Params P) {
    const float* QKF = (const float*)(P.ws + WS_QKF); const float* cs = (const float*)(P.ws + WS_ROPE); bf16* Q = (bf16*)(P.ws + WS_Q); bf16* K = (bf16*)(P.ws + WS_K);
    for (size_t i = (size_t)blockIdx.x * 256 + threadIdx.x; i < (size_t)T * 2048; i += (size_t)gridDim.x * 256) { const int t = (int)(i >> 11), c = (int)(i & 2047), d = c & 63;
        float z = QKF[i];
        if (d < 8) z = z * cs[t * 16 + d] - QKF[i + 8] * cs[t * 16 + 8 + d];
        else if (d < 16) z = z * cs[t * 16 + d - 8] + QKF[i - 8] * cs[t * 16 + 8 + d - 8];
        if (c < 1024) Q[(size_t)t * D + c] = (bf16)f2bf(z * C2); else K[(size_t)t * D + c - 1024] = (bf16)f2bf(z); }
}
struct NEpiGate1 { unsigned char* ws;
    __device__ int a_row0(int) const { return 0; } __device__ int b_row0(int) const { return 0; }
    __device__ void operator()(int, int r, int c, float z) const { const size_t i = (size_t)r * D + c; ((bf16*)(ws + WS_MG))[i] = (bf16)f2bf(bf2f(((const bf16*)(ws + WS_GP))[i]) * z); } };
struct NEpiGate2 { unsigned char* ws;
    __device__ int a_row0(int) const { return 0; } __device__ int b_row0(int) const { return 0; }
    __device__ void operator()(int, int r, int c, float z) const { const size_t i = (size_t)r * D + c; bf16* mg = (bf16*)(ws + WS_MG); mg[i] = (bf16)f2bf(bf2f(mg[i]) + bf2f(((const bf16*)(ws + WS_GA))[i]) * z); } };
struct NEpiRes { const float* x; unsigned char* ws;
    __device__ int a_row0(int) const { return 0; } __device__ int b_row0(int) const { return 0; }
    __device__ void operator()(int, int r, int c, float z) const { const size_t i = (size_t)r * D + c; ((bf16*)(ws + WS_X2))[i] = (bf16)f2bf(x[i] + z); } };
__global__ void __launch_bounds__(256) k_up_naive(Params P) {
    __shared__ float As[64][33], Bg[64][33], Bu[64][33];
    const bf16* XS = (const bf16*)(P.ws + WS_XS); const bf16* W13 = (const bf16*)(P.ws + WS_W13); bf16* ACT = (bf16*)(P.ws + WS_ACT);
    const int tid = threadIdx.x, tx = tid & 15, ty = tid >> 4, gz = blockIdx.z, e = gz & 15;
    const size_t arow0 = (size_t)gz * CAP + blockIdx.y * 64; const int f0 = blockIdx.x * 64;
    const size_t grow0 = (size_t)e * 5632 + (f0 >> 7) * 256 + (f0 & 127), urow0 = grow0 + 128;
    float ag[4][4], au[4][4];
#pragma unroll
    for (int i = 0; i < 4; ++i)
#pragma unroll
        for (int j = 0; j < 4; ++j) { ag[i][j] = 0.f; au[i][j] = 0.f; }
    const int lr = tid >> 2, lc = (tid & 3) * 8;
    for (int k0 = 0; k0 < D; k0 += 32) {
        const v4u a = *(const v4u*)(XS + (arow0 + lr) * D + k0 + lc), g = *(const v4u*)(W13 + (grow0 + lr) * D + k0 + lc), u = *(const v4u*)(W13 + (urow0 + lr) * D + k0 + lc);
        As[lr][lc + 0] = bf_lo(a.x); As[lr][lc + 1] = bf_hi(a.x); As[lr][lc + 2] = bf_lo(a.y); As[lr][lc + 3] = bf_hi(a.y); As[lr][lc + 4] = bf_lo(a.z); As[lr][lc + 5] = bf_hi(a.z); As[lr][lc + 6] = bf_lo(a.w); As[lr][lc + 7] = bf_hi(a.w);
        Bg[lr][lc + 0] = bf_lo(g.x); Bg[lr][lc + 1] = bf_hi(g.x); Bg[lr][lc + 2] = bf_lo(g.y); Bg[lr][lc + 3] = bf_hi(g.y); Bg[lr][lc + 4] = bf_lo(g.z); Bg[lr][lc + 5] = bf_hi(g.z); Bg[lr][lc + 6] = bf_lo(g.w); Bg[lr][lc + 7] = bf_hi(g.w);
        Bu[lr][lc + 0] = bf_lo(u.x); Bu[lr][lc + 1] = bf_hi(u.x); Bu[lr][lc + 2] = bf_lo(u.y); Bu[lr][lc + 3] = bf_hi(u.y); Bu[lr][lc + 4] = bf_lo(u.z); Bu[lr][lc + 5] = bf_hi(u.z); Bu[lr][lc + 6] = bf_lo(u.w); Bu[lr][lc + 7] = bf_hi(u.w);
        __syncthreads();
#pragma unroll 4
        for (int k = 0; k < 32; ++k) { float av[4], gv[4], uv[4];
#pragma unroll
            for (int i = 0; i < 4; ++i) { av[i] = As[ty * 4 + i][k]; gv[i] = Bg[tx * 4 + i][k]; uv[i] = Bu[tx * 4 + i][k]; }
#pragma unroll
            for (int i = 0; i < 4; ++i)
#pragma unroll
                for (int j = 0; j < 4; ++j) { ag[i][j] += av[i] * gv[j]; au[i][j] += av[i] * uv[j]; } }
        __syncthreads();
    }
#pragma unroll
    for (int i = 0; i < 4; ++i)
#pragma unroll
        for (int j = 0; j < 4; ++j) { const float g = ag[i][j]; ACT[(arow0 + ty * 4 + i) * FF + f0 + tx * 4 + j] = (bf16)f2bf(g * sigmoidf_(g) * au[i][j]); }
}
struct NEpiDown { unsigned char* ws;
    __device__ int a_row0(int gz) const { return gz * CAP; } __device__ int b_row0(int gz) const { return (gz & 15) * D; }
    __device__ void operator()(int gz, int r, int c, float z) const { const size_t row = (size_t)gz * CAP + r; ((bf16*)(ws + WS_Y))[row * D + c] = (bf16)f2bf(z * ((const float*)(ws + WS_SELV))[row]); } };

__global__ void __launch_bounds__(256) k_attn_naive(Params P) {
    __shared__ __attribute__((aligned(16))) bf16 qs[4][128];
    __shared__ float ps[4][64][2];
    const bf16* Q = (const bf16*)(P.ws + WS_Q); const bf16* K = (const bf16*)(P.ws + WS_K); const bf16* V = (const bf16*)(P.ws + WS_V);
    bf16* O0 = (bf16*)(P.ws + WS_OV); bf16* O1 = O0 + (size_t)T * D;
    const int lane = threadIdx.x & 63, wave = threadIdx.x >> 6;
    const int item = blockIdx.x * 4 + wave, t = item >> 3, h = item & 7, b0 = t & ~(SEQ - 1);
    ((unsigned*)qs[wave])[lane] = ((const unsigned*)(Q + (size_t)t * D + h * 128))[lane];
    __syncthreads();
    auto score = [&](int key, float& s0, float& s1) {
        const v4u* kr = (const v4u*)(K + (size_t)(b0 + key) * D + h * 128); const v4u* qr = (const v4u*)qs[wave];
        float a0 = 0.f, a1 = 0.f;
#pragma unroll
        for (int ch = 0; ch < 16; ++ch) { const v4u kv = kr[ch], qv = qr[ch];
            const float d = bf_lo(kv.x) * bf_lo(qv.x) + bf_hi(kv.x) * bf_hi(qv.x) + bf_lo(kv.y) * bf_lo(qv.y) + bf_hi(kv.y) * bf_hi(qv.y) + bf_lo(kv.z) * bf_lo(qv.z) + bf_hi(kv.z) * bf_hi(qv.z) + bf_lo(kv.w) * bf_lo(qv.w) + bf_hi(kv.w) * bf_hi(qv.w);
            if (ch < 8) a0 += d; else a1 += d; }
        s0 = a0; s1 = a1; };
    float m0 = -1e30f, m1 = -1e30f, l0 = 0.f, l1 = 0.f;
    for (int c = 0; c < SEQ / 64; ++c) { float s0, s1; score(c * 64 + lane, s0, s1);
        const float n0 = fmaxf(m0, s0), n1 = fmaxf(m1, s1);
        l0 = l0 * exp2f(m0 - n0) + exp2f(s0 - n0); l1 = l1 * exp2f(m1 - n1) + exp2f(s1 - n1); m0 = n0; m1 = n1; }
    const float M0 = wave_max(m0), M1 = wave_max(m1);
    const float L0 = wave_sum(l0 * exp2f(m0 - M0)), L1 = wave_sum(l1 * exp2f(m1 - M1));
    float a00 = 0.f, a01 = 0.f, a10 = 0.f, a11 = 0.f;
    for (int c = 0; c < SEQ / 64; ++c) { float s0, s1; score(c * 64 + lane, s0, s1);
        ps[wave][lane][0] = exp2f(s0 - M0); ps[wave][lane][1] = exp2f(s1 - M1);
        __syncthreads();
        for (int j = 0; j < 64; ++j) { const unsigned vv = ((const unsigned*)(V + (size_t)(b0 + c * 64 + j) * D + h * 128))[lane];
            const float p0 = ps[wave][j][0], p1 = ps[wave][j][1];
            a00 += p0 * bf_lo(vv); a01 += p0 * bf_hi(vv); a10 += p1 * bf_lo(vv); a11 += p1 * bf_hi(vv); }
        __syncthreads(); }
    ((unsigned*)(O0 + (size_t)t * D + h * 128))[lane] = pk2(a00 / L0, a01 / L0);
    ((unsigned*)(O1 + (size_t)t * D + h * 128))[lane] = pk2(a10 / L1, a11 / L1);
}


#ifndef MK_FUSED
#define MK_FUSED 1
#endif
#ifndef PROBE_RLO
#define PROBE_RLO -1
#define PROBE_RHI -1
#endif
#ifndef IN_NA
#define IN_NA 3
#endif
#ifndef PROBE_VAR
#define PROBE_VAR 0
#endif
#ifndef PROBE_PARTS
#define PROBE_PARTS 63
#endif
#ifndef NAIVE_MASK
#define NAIVE_MASK 0
#endif
constexpr int NWAVES = 8, NPH = 11;
constexpr int RING_BYTES = 131072, LDSCTL_OFF = RING_BYTES, MISC_OFF = LDSCTL_OFF + 320, LDS_BYTES = 147456;
constexpr int CW_BAR = 4096;
typedef GAS unsigned gu32;

struct Args { Params P; int ph_lo, ph_hi, parts, pad; };
__global__ void __launch_bounds__(NWAVES * 64, 2) mega(Args args) {
    extern __shared__ __attribute__((aligned(16))) unsigned char lds[];
    const Params& P = args.P;
    LAS unsigned char* L = (LAS unsigned char*)lds;
    const int tid = threadIdx.x, lane = tid & 63, wave = __builtin_amdgcn_readfirstlane(tid >> 6);
    const int G = gridDim.x, bx = blockIdx.x, vcu = (G % 8 == 0) ? (bx % 8) * (G / 8) + bx / 8 : bx;
    const int gw = vcu * NWAVES + wave, ngw = G * NWAVES, gtid = vcu * (NWAVES * 64) + tid, ngt = G * NWAVES * 64;
    for (int u = tid; u < (LDS_BYTES - LDSCTL_OFF) / 4; u += NWAVES * 64) ((LAS unsigned*)(L + LDSCTL_OFF))[u] = 0u;
    __syncthreads();
    unsigned* ctl = (unsigned*)(P.ws + WS_CTL);
    XcdBarrier bar; bar.bar = ctl + CW_BAR; bar.x = 0; bar.st = nullptr;
    const int lo = args.ph_lo, hi = args.ph_hi;
    if (hi - lo > 1) bar = xcd_barrier_post(ctl + CW_BAR, (volatile LAS unsigned*)(L + MISC_OFF) + 8);
#define IN(k) (lo <= (k) && (k) < hi)
#define SEAM(k) do { if (IN(k) && IN((k) + 1)) xcd_barrier(bar); } while (0)
    unsigned char* ws = P.ws;

    if (IN(0)) { const int parts = args.parts; if (parts & 1) ph_weights(P, WT_FP8_PAIRS, WT_ALL_PAIRS, gw, ngw, lane, (LAS float*)(L + wave * 16384));     if (parts & 2) ph_rms_x(P, gw, ngw, lane); if (parts & 4) ph_rope(P, gtid, ngt); if (parts & 8) ph_wcomb(P, gtid, ngt); }
    SEAM(0);
    if (IN(1)) { const int xg = vcu >> 5, l = vcu & 31;
        if (l >= 16) { ph_weights(P, 0, WT_FP8_PAIRS, (xg * 16 + (l - 16)) * NWAVES + wave, 128 * NWAVES, lane, (LAS float*)(L + wave * 16384)); asm volatile("s_waitcnt vmcnt(0) lgkmcnt(0)" ::: "memory"); __syncthreads(); }
        pg8::Gemm g{(const bf16*)(ws + WS_XN), (const bf16*)(ws + WS_WIN), T, INC, D}; pg8::InOrder S{__builtin_amdgcn_readfirstlane(8 * xg), __builtin_amdgcn_readfirstlane(l >= 16 ? 16 * (12 - IN_NA) + (l - 16) : l), __builtin_amdgcn_readfirstlane(l >= 16 ? IN_NA : 12 - IN_NA)};
        pg8::EpiIn E{ws, (const float*)(ws + WS_ROPE)};
        pg8::gemm_phase<pg8::EpiIn, pg8::InOrder, true, true>(L, g, S, E); }
    SEAM(1);
    if (IN(2)) { if (args.parts & 16) ph_pool(P, gw, ngw, lane);
        const bf16* Q = (const bf16*)(ws + WS_Q); const bf16* K = (const bf16*)(ws + WS_K); const bf16* V = (const bf16*)(ws + WS_V); bf16* OV = (bf16*)(ws + WS_OV);
        const int g = vcu >> 3, b = g >> 3, h = g & 7;
        const size_t rb = (size_t)b * SEQ * D;
        const float lam = lam_value(P, lane);
        if (args.parts & 32) for (int i = 0; i < 2; ++i) { const int qb = (vcu & 7) * 2 + i; const size_t q0 = (size_t)(qb * 256) * D;
            for (int m = 0; m < 2; ++m) {
                const bf16* q_ = Q + rb + q0 + h * 128 + m * 64; const bf16* k_ = K + rb + h * 128 + m * 64; const bf16* v_ = V + rb + h * 128; bf16* o_ = OV + (size_t)m * T * D + rb + q0 + h * 128;
#if PROBE_VAR
                if (args.parts & 64) attn2::attn_unit<PROBE_VAR>(q_, k_, v_, o_, (char*)lds); else
#endif
                attn2::attn_unit<0>(q_, k_, v_, o_, (char*)lds); }
            asm volatile("s_waitcnt vmcnt(0)" ::: "memory"); __syncthreads();
            combine_block(P, b * SEQ + qb * 256, h, lam, wave, lane); } }
    SEAM(2);
    if (IN(4)) { pg8::MergeOrder S; S.so.init(T, D, G, bx); S.A0 = (const char*)(ws + WS_PD); S.A1 = (const char*)(ws + WS_O); S.B0 = (const char*)(ws + WS_WCOMB); S.B1 = (const char*)(ws + WS_WAO); S.tstep = (size_t)256 * D * 2;
        pg8::Gemm g{(const bf16*)(ws + WS_PD), (const bf16*)(ws + WS_WCOMB), T, D, D}; pg8::EpiMerge E{(const bf16*)(ws + WS_GP), (const bf16*)(ws + WS_GA), (bf16*)(ws + WS_MG)};
        pg8::gemm_phase<pg8::EpiMerge, pg8::MergeOrder, true, true>(L, g, S, E); }
    SEAM(4);
    if (IN(5)) { pg8::Gemm g{(const bf16*)(ws + WS_MG), (const bf16*)(ws + WS_WOUT), T, D, D}; pg8::StaticOrder S; S.init(T, D, G, bx);
        pg8::EpiRes E{P.x, (pg8::bf16_t*)(ws + WS_X2)};
        pg8::gemm_phase<pg8::EpiRes, pg8::StaticOrder, true, true>(L, g, S, E); }
    SEAM(5);
    if (IN(6)) { ph_router(P, vcu, G, tid, NWAVES * 64, (LAS float*)L); __syncthreads(); }
    SEAM(6);
    if (IN(7)) { ph_topk(P, vcu, G, tid, (LAS unsigned*)L); __syncthreads(); }
    SEAM(7);
    if (IN(8)) { pg8::Gemm g{(const bf16*)(ws + WS_XS), (const bf16*)(ws + WS_W13), NSEL, NE * 5632, D / 2}; pg8::UpOrder S{vcu >> 5, vcu & 31};
        pg8::EpiUp E{ws + WS_ACT};
        pg8::gemm_phase<pg8::EpiUp, pg8::UpOrder, true, true, true>(L, g, S, E); }
    SEAM(8);
    if (IN(9)) { pg8::Gemm g{(const bf16*)(ws + WS_ACT), (const bf16*)(ws + WS_WD), NSEL, NE * D, FF / 2}; pg8::DownOrder S{vcu >> 5, vcu & 31};
        pg8::EpiDown E{(bf16*)(ws + WS_Y), (const float*)(ws + WS_SELV)};
        pg8::gemm_phase<pg8::EpiDown, pg8::DownOrder, true, true, true>(L, g, S, E); }
    SEAM(9);
    if (IN(10)) ph_final(P, gw, ngw, lane);
#undef IN
#undef SEAM
}

extern "C" void kernel_launch(void* const* d_in, const int* in_sizes, int n_in, void* d_out, int out_size, void* d_ws, size_t ws_size, hipStream_t stream) {
    static int grid = 0;
    if (grid == 0) {
        if (n_in != 20 || in_sizes[0] != T * D || out_size != T * D || ws_size < WS_END) { fprintf(stderr, "kernel_launch: unexpected shapes (n_in %d, in0 %d, out %d, ws %zu, need %zu)\n", n_in, n_in > 0 ? in_sizes[0] : -1, out_size, ws_size, (size_t)WS_END); grid = -1; return; }
        int dev = 0, cus = 0;
        if (hipGetDevice(&dev) != hipSuccess || hipDeviceGetAttribute(&cus, hipDeviceAttributeMultiprocessorCount, dev) != hipSuccess) { grid = -1; return; }
        if (hipFuncSetAttribute((const void*)mega, hipFuncAttributeMaxDynamicSharedMemorySize, LDS_BYTES) != hipSuccess) { fprintf(stderr, "kernel_launch: hipFuncSetAttribute failed\n"); grid = -1; return; }
        if (cus != 256) { fprintf(stderr, "kernel_launch: built for a 256-CU device, found %d\n", cus); grid = -1; return; }
        grid = cus;
    }
    if (grid < 0) return;
    Args a{}; a.parts = 63;
    Params& P = a.P;
    P.x = (const float*)d_in[0]; P.pos = (const int*)d_in[1]; P.g_mix = (const float*)d_in[2]; P.w_in = (const float*)d_in[3]; P.w_pmix = (const float*)d_in[4]; P.pscale = (const float*)d_in[5];
    P.w_pout = (const float*)d_in[6]; P.lq1 = (const float*)d_in[7]; P.lk1 = (const float*)d_in[8]; P.lq2 = (const float*)d_in[9]; P.lk2 = (const float*)d_in[10]; P.g_sub = (const float*)d_in[11];
    P.w_ao = (const float*)d_in[12]; P.w_out = (const float*)d_in[13]; P.g_ffn = (const float*)d_in[14]; P.w_router = (const float*)d_in[15]; P.w_gate = (const float*)d_in[16]; P.w_up = (const float*)d_in[17];
    P.w_down = (const float*)d_in[18]; P.g_final = (const float*)d_in[19]; P.out = (float*)d_out; P.ws = (unsigned char*)d_ws;
#if MK_FUSED
    (void)hipMemsetAsync((char*)d_ws + WS_CTL, 0, 65536, stream);
#if PROBE_RLO >= 0
    a.ph_lo = 0; a.ph_hi = PROBE_RHI + 1; a.parts = PROBE_PARTS;
    hipLaunchKernelGGL(mega, dim3(grid), dim3(NWAVES * 64), LDS_BYTES, stream, a);
    (void)hipMemsetAsync((char*)d_ws + WS_CTL, 0, 65536, stream);
    a.ph_lo = PROBE_RLO; a.ph_hi = NPH; a.parts = 63;
    hipLaunchKernelGGL(mega, dim3(grid), dim3(NWAVES * 64), LDS_BYTES, stream, a);
#else
    a.ph_lo = 0; a.ph_hi = NPH;
    hipLaunchKernelGGL(mega, dim3(grid), dim3(NWAVES * 64), LDS_BYTES, stream, a);
#endif
#else
    unsigned char* ws = P.ws;
    for (int p = 0; p < NPH; ++p) {
        if ((NAIVE_MASK >> p) & 1) {
            if (p == 1) { k_gemm_naive<NEpiIn><<<dim3(INC / 64, T / 64, 1), 256, 0, stream>>>((const bf16*)(ws + WS_XN), (const bf16*)(ws + WS_WIN), D, NEpiIn{ws}); k_rope_naive<<<2048, 256, 0, stream>>>(P); continue; }
            if (p == 2) { a.ph_lo = 2; a.ph_hi = 2; k_pool_only<<<256, 512, 0, stream>>>(P); k_attn_naive<<<T * NH / 4, 256, 0, stream>>>(P); continue; }
            if (p == 4) { k_gemm_naive<NEpiGate1><<<dim3(D / 64, T / 64, 1), 256, 0, stream>>>((const bf16*)(ws + WS_PD), (const bf16*)(ws + WS_WCOMB), D, NEpiGate1{ws});
                          k_gemm_naive<NEpiGate2><<<dim3(D / 64, T / 64, 1), 256, 0, stream>>>((const bf16*)(ws + WS_O), (const bf16*)(ws + WS_WAO), D, NEpiGate2{ws}); continue; }
            if (p == 5) { k_gemm_naive<NEpiRes><<<dim3(D / 64, T / 64, 1), 256, 0, stream>>>((const bf16*)(ws + WS_MG), (const bf16*)(ws + WS_WOUT), D, NEpiRes{P.x, ws}); continue; }
            if (p == 8) { k_up_naive<<<dim3(FF / 64, CAP / 64, NB * NE), 256, 0, stream>>>(P); continue; }
            if (p == 9) { k_gemm_naive<NEpiDown><<<dim3(D / 64, CAP / 64, NB * NE), 256, 0, stream>>>((const bf16*)(ws + WS_ACT), (const bf16*)(ws + WS_WD), FF, NEpiDown{ws}); continue; }
        }
        a.ph_lo = p; a.ph_hi = p + 1;
        hipLaunchKernelGGL(mega, dim3(grid), dim3(NWAVES * 64), LDS_BYTES, stream, a);
    }
#endif
}
```

```cpp
#include <hip/hip_runtime.h>
#include <cstdio>
#include <cstdint>

#define GAS __attribute__((address_space(1)))
#define LAS __attribute__((address_space(3)))
typedef unsigned short bf16;
typedef unsigned v4u __attribute__((ext_vector_type(4)));
typedef unsigned v2u __attribute__((ext_vector_type(2)));
typedef float f32x4 __attribute__((ext_vector_type(4)));

constexpr int NB = 4, SEQ = 4096, T = NB * SEQ, D = 1024, NH = 8, INC = 6144, NE = 16, CAP = 512, FF = 2816;
constexpr int NSEL = NB * NE * CAP;
constexpr float EPS = 1e-6f;
constexpr float C2 = 0.18033688011112042f;
constexpr float LAM_INIT = 0.2f, ONE_M_LAM_INIT = 0.8f;

constexpr size_t MiB = 1u << 20;
constexpr size_t WS_CTL = 0, CTL_ZERO_BYTES = 1 * MiB;
constexpr size_t WS_ROPE = 1 * MiB;
constexpr size_t WS_AFF = 2 * MiB;
constexpr size_t WS_SELI = 3 * MiB;
constexpr size_t WS_SELV = 3 * MiB + 512 * 1024;
constexpr size_t WS_SLOT = 4 * MiB;
constexpr size_t WS_WIN = 6 * MiB;
constexpr size_t WS_WCOMB = 18 * MiB, WS_WAO = 20 * MiB, WS_WOUT = 22 * MiB;
constexpr size_t WS_W13 = 24 * MiB;
constexpr size_t WS_WD = 200 * MiB;
constexpr size_t WS_ACT0 = 288 * MiB;
constexpr size_t SLOTB = 32 * MiB;
constexpr size_t WS_Q = WS_ACT0 + 0 * SLOTB, WS_K = WS_ACT0 + 1 * SLOTB, WS_X2 = WS_ACT0;
constexpr size_t WS_O = WS_ACT0 + 2 * SLOTB, WS_H2 = WS_O;
constexpr size_t WS_XB = WS_ACT0 + 6 * SLOTB;
constexpr size_t WS_RSTD = 3 * MiB + 768 * 1024;
constexpr size_t WS_U = WS_ACT0 + 3 * SLOTB, WS_MG = WS_U;
constexpr size_t WS_V = WS_ACT0 + 4 * SLOTB, WS_GP = WS_ACT0 + 5 * SLOTB, WS_GA = WS_ACT0 + 5 * SLOTB + 16 * MiB, WS_PD = WS_ACT0 + 7 * SLOTB;
constexpr size_t WS_OV = WS_ACT0 + 8 * SLOTB;
constexpr size_t WS_XS = WS_ACT0 + 3 * SLOTB, WS_Y = WS_XS;
constexpr size_t WS_ACT = WS_ACT0 + 5 * SLOTB;
constexpr size_t WS_QKF = WS_ACT0 + 7 * SLOTB;
constexpr size_t WS_END = WS_ACT0 + 11 * SLOTB;

struct Params {
    const float* x; const int* pos; const float* g_mix; const float* w_in; const float* w_pmix; const float* pscale; const float* w_pout;
    const float *lq1, *lk1, *lq2, *lk2; const float* g_sub; const float* w_ao; const float* w_out; const float* g_ffn; const float* w_router;
    const float *w_gate, *w_up, *w_down; const float* g_final; float* out; unsigned char* ws;
};

__device__ const float ROPE_INV[8] = {1.0f, 0.1939227432012558f, 0.03760603070259094f, 0.007292664609849453f, 0.0014142135623842478f, 0.00027424818836152554f, 5.3182957344688475e-05f, 1.0313385246263351e-05f};

__device__ __forceinline__ unsigned f2bf(float f) { unsigned u = __builtin_bit_cast(unsigned, f); return (u + 0x7fffu + ((u >> 16) & 1u)) >> 16; }
__device__ __forceinline__ unsigned pk2(float lo, float hi) { return f2bf(lo) | (f2bf(hi) << 16); }
__device__ __forceinline__ float bf_lo(unsigned w) { return __builtin_bit_cast(float, w << 16); }
__device__ __forceinline__ float bf_hi(unsigned w) { return __builtin_bit_cast(float, w & 0xffff0000u); }
__device__ __forceinline__ float bf2f(bf16 h) { return __builtin_bit_cast(float, (unsigned)h << 16); }
__device__ __forceinline__ unsigned pk4_fp8(float a, float b, float c, float d) {
    a = __builtin_amdgcn_fmed3f(a, -448.f, 448.f); b = __builtin_amdgcn_fmed3f(b, -448.f, 448.f); c = __builtin_amdgcn_fmed3f(c, -448.f, 448.f); d = __builtin_amdgcn_fmed3f(d, -448.f, 448.f);
    int r = __builtin_amdgcn_cvt_pk_fp8_f32(a, b, 0, false); r = __builtin_amdgcn_cvt_pk_fp8_f32(c, d, r, true); return (unsigned)r; }
constexpr float W8_SCALE = 64.f, XS8_SCALE = 8.f, ACT8_SCALE = 4.f, Y8_SCALE = 64.f;
__device__ __forceinline__ float wave_sum(float v) {
#pragma unroll
    for (int o = 1; o < 64; o <<= 1) v += __shfl_xor(v, o);
    return v;
}
__device__ __forceinline__ float wave_max(float v) {
#pragma unroll
    for (int o = 1; o < 64; o <<= 1) v = fmaxf(v, __shfl_xor(v, o));
    return v;
}
__device__ __forceinline__ unsigned lds_add(LAS unsigned* p, unsigned v) { return __hip_atomic_fetch_add(p, v, __ATOMIC_RELAXED, __HIP_MEMORY_SCOPE_WORKGROUP); }
__device__ __forceinline__ float sigmoidf_(float z) { return 1.0f / (1.0f + __expf(-z)); }
__device__ __forceinline__ float lam_value(const Params& P, int lane) {
    const float a = wave_sum(P.lq1[lane] * P.lk1[lane]), b = wave_sum(P.lq2[lane] * P.lk2[lane]);
    return expf(a) - expf(b) + LAM_INIT;
}

__device__ __forceinline__ void rms_row_bf16(const float* xrow, const float* g, bf16* orow, int lane) {
    const f32x4* xr = (const f32x4*)xrow + lane;
    f32x4 v[4]; float s = 0.f;
#pragma unroll
    for (int j = 0; j < 4; ++j) { v[j] = xr[64 * j]; s += (v[j].x * v[j].x + v[j].y * v[j].y) + (v[j].z * v[j].z + v[j].w * v[j].w); }
    const float r = rsqrtf(wave_sum(s) * (1.f / D) + EPS);
    unsigned long long* o8 = (unsigned long long*)orow + lane;
#pragma unroll
    for (int j = 0; j < 4; ++j) { const f32x4 gg = ((const f32x4*)g)[lane + 64 * j];
        o8[64 * j] = (unsigned long long)pk2(v[j].x * r * gg.x, v[j].y * r * gg.y) | ((unsigned long long)pk2(v[j].z * r * gg.z, v[j].w * r * gg.w) << 32); }
}
__device__ __forceinline__ void ph_rms_x(const Params& P, int gw, int ngw, int lane) {
    bf16* XN = (bf16*)(P.ws + WS_XB); float* RSTD = (float*)(P.ws + WS_RSTD);
    f32x4 gg[4], v[4], nv[4];
#pragma unroll
    for (int j = 0; j < 4; ++j) gg[j] = ((const f32x4*)P.g_mix)[lane + 64 * j];
    if (gw < T) {
#pragma unroll
        for (int j = 0; j < 4; ++j) v[j] = ((const f32x4*)(P.x + (size_t)gw * D) + lane)[64 * j]; }
    for (int m = gw; m < T; m += ngw) {
        if (m + ngw < T) {
#pragma unroll
            for (int j = 0; j < 4; ++j) nv[j] = ((const f32x4*)(P.x + (size_t)(m + ngw) * D) + lane)[64 * j]; }
        float s = 0.f;
#pragma unroll
        for (int j = 0; j < 4; ++j) s += (v[j].x * v[j].x + v[j].y * v[j].y) + (v[j].z * v[j].z + v[j].w * v[j].w);
        const float r = rsqrtf(wave_sum(s) * (1.f / D) + EPS);
        unsigned long long* o8 = (unsigned long long*)(XN + (size_t)m * D) + lane;
#pragma unroll
        for (int j = 0; j < 4; ++j) o8[64 * j] = (unsigned long long)pk2(v[j].x, v[j].y) | ((unsigned long long)pk2(v[j].z, v[j].w) << 32);
        if (lane == 0) RSTD[m] = r;
#pragma unroll
        for (int j = 0; j < 4; ++j) v[j] = nv[j];
    }
}
__device__ __forceinline__ void ph_rope(const Params& P, int gtid, int ngt) {
    float* cs = (float*)(P.ws + WS_ROPE);
    for (int i = gtid; i < T * 8; i += ngt) { const int t = i >> 3, k = i & 7;
        const float ang = (float)P.pos[t] * ROPE_INV[k];
        double fr = (double)ang * 0.15915494309189535; fr -= rint(fr);
        cs[t * 16 + k] = __builtin_amdgcn_cosf((float)fr); cs[t * 16 + 8 + k] = __builtin_amdgcn_sinf((float)fr); }
}
__device__ __forceinline__ void ph_wcomb(const Params& P, int gtid, int ngt) {
    bf16* WT = (bf16*)(P.ws + WS_WCOMB);
    for (int it = gtid; it < 512 * 256; it += ngt) { const int c0 = (it & 255) * 4, k0 = (it >> 8) * 2, g = k0 >> 8;
        f32x4 acc0 = {0.f, 0.f, 0.f, 0.f}, acc1 = acc0;
        const float* wm = P.w_pmix + (size_t)k0 * 256; const float* sc = P.pscale + g * 256; const float* wp = P.w_pout + (size_t)(g * 256) * D + c0;
#pragma unroll 4
        for (int j4 = 0; j4 < 64; ++j4) {
            const f32x4 m0 = *(const f32x4*)(wm + 4 * j4), m1 = *(const f32x4*)(wm + 256 + 4 * j4), s4 = *(const f32x4*)(sc + 4 * j4);
#pragma unroll
            for (int jj = 0; jj < 4; ++jj) { const f32x4 w4 = *(const f32x4*)(wp + (size_t)(4 * j4 + jj) * D) * s4[jj]; acc0 += w4 * m0[jj]; acc1 += w4 * m1[jj]; } }
#pragma unroll
        for (int cc = 0; cc < 4; ++cc) *(unsigned*)(WT + (size_t)(c0 + cc) * D + k0) = pk2(acc0[cc], acc1[cc]); }
}
struct WTile { const float* src; unsigned char* dst; const float* gs; int N, Kb, fp8; };
__device__ __forceinline__ WTile wtile_decode(const Params& P, int pair, int half) {
    constexpr int I_GU = 8 * 88, I_DN = 22 * 32, I_E = 2 * I_GU + I_DN, I_IN = 8 * 192, I_SQ = 8 * 32;
    WTile t; int r = pair; t.gs = nullptr;
    if (r < NE * I_E) { const int e = r / I_E; r -= e * I_E; t.fp8 = 1;
        if (r < 2 * I_GU) { const int up = r >= I_GU ? 1 : 0; r -= up * I_GU; const int kb = r / 88, nb = r % 88, n0 = 32 * nb, k0 = 128 * kb + 64 * half;
            const float* W = (up ? P.w_up : P.w_gate) + (size_t)e * D * FF; const int orow = (n0 >> 7) * 256 + (n0 & 127) + up * 128;
            t.src = W + (size_t)k0 * FF + n0; t.N = FF; t.Kb = D; t.dst = P.ws + WS_W13 + ((size_t)e * 5632 + orow) * D + k0; return t; }
        r -= 2 * I_GU;
        { const int kb = r / 32, nb = r % 32, n0 = 32 * nb, k0 = 128 * kb + 64 * half; const float* W = P.w_down + (size_t)e * FF * D;
          t.src = W + (size_t)k0 * D + n0; t.N = D; t.Kb = FF; t.dst = P.ws + WS_WD + ((size_t)e * D + n0) * FF + k0; return t; } }
    r -= NE * I_E; t.fp8 = 0;
    if (r < I_IN) { const int kb = r / 192, nb = r % 192, n0 = 32 * nb, k0 = 128 * kb + 64 * half; t.src = P.w_in + (size_t)k0 * INC + n0; t.gs = P.g_mix + k0; t.N = INC; t.Kb = 2 * D; t.dst = P.ws + WS_WIN + ((size_t)n0 * D + k0) * 2; return t; }
    r -= I_IN;
    { const int which = r >= I_SQ ? 1 : 0; r -= which * I_SQ; const int kb = r / 32, nb = r % 32, n0 = 32 * nb, k0 = 128 * kb + 64 * half;
      t.src = (which ? P.w_out : P.w_ao) + (size_t)k0 * D + n0; t.N = D; t.Kb = 2 * D; t.dst = P.ws + (which ? WS_WOUT : WS_WAO) + ((size_t)n0 * D + k0) * 2; return t; }
}
#define WT_LOAD(buf, t) do { const float* sp_ = (t).src + (size_t)(lane >> 3) * (t).N + 4 * (lane & 7); _Pragma("unroll") for (int i = 0; i < 8; ++i) buf[i] = __builtin_nontemporal_load((const f32x4*)(sp_ + (size_t)(8 * i) * (t).N)); } while (0)
#define WT_PROC(buf, t) do { _Pragma("unroll") for (int i = 0; i < 8; ++i) { LAS float* w_ = scr + (8 * i + (lane >> 3)) * 33 + 4 * (lane & 7); w_[0] = buf[i].x; w_[1] = buf[i].y; w_[2] = buf[i].z; w_[3] = buf[i].w; } \
        asm volatile("s_waitcnt lgkmcnt(0)" ::: "memory"); const int c = lane & 7; \
        if ((t).fp8) { _Pragma("unroll") for (int jj = 0; jj < 4; ++jj) { const int n = (lane >> 3) + 8 * jj; const LAS float* s = scr + (8 * c) * 33 + n; \
                v2u o; o.x = pk4_fp8(s[0 * 33] * W8_SCALE, s[1 * 33] * W8_SCALE, s[2 * 33] * W8_SCALE, s[3 * 33] * W8_SCALE); o.y = pk4_fp8(s[4 * 33] * W8_SCALE, s[5 * 33] * W8_SCALE, s[6 * 33] * W8_SCALE, s[7 * 33] * W8_SCALE); \
                *(v2u*)((t).dst + (size_t)n * (t).Kb + 8 * c) = o; } } \
        else { float gk_[8]; _Pragma("unroll") for (int j_ = 0; j_ < 8; ++j_) gk_[j_] = 1.f; if ((t).gs) { _Pragma("unroll") for (int j_ = 0; j_ < 8; ++j_) gk_[j_] = (t).gs[8 * c + j_]; } \
            _Pragma("unroll") for (int jj = 0; jj < 4; ++jj) { const int n = (lane >> 3) + 8 * jj; const LAS float* s = scr + (8 * c) * 33 + n; \
                v4u o; o.x = pk2(s[0 * 33] * gk_[0], s[1 * 33] * gk_[1]); o.y = pk2(s[2 * 33] * gk_[2], s[3 * 33] * gk_[3]); o.z = pk2(s[4 * 33] * gk_[4], s[5 * 33] * gk_[5]); o.w = pk2(s[6 * 33] * gk_[6], s[7 * 33] * gk_[7]); \
                *(v4u*)((t).dst + (size_t)n * (t).Kb + 16 * c) = o; } } \
        asm volatile("s_waitcnt lgkmcnt(0)" ::: "memory"); } while (0)
constexpr int WT_FP8_PAIRS = NE * (2 * 8 * 88 + 22 * 32), WT_ALL_PAIRS = WT_FP8_PAIRS + 8 * 192 + 2 * 8 * 32;
__device__ __forceinline__ void ph_weights(const Params& P, int pair0, int pair1, int gw, int ngw, int lane, LAS float* scr) {
    const int npw = (pair1 - pair0 - gw + ngw - 1) / ngw;
    if (npw <= 0) return;
    const int nq = 2 * npw;
    f32x4 va[8], vb[8], vc[8], vd[8];
    WTile ta, tb, tc, td;
#define WT_Q(q) wtile_decode(P, pair0 + gw + ((q) >> 1) * ngw, (q) & 1)
    ta = WT_Q(0); WT_LOAD(va, ta);
    if (1 < nq) { tb = WT_Q(1); WT_LOAD(vb, tb); }
    if (2 < nq) { tc = WT_Q(2); WT_LOAD(vc, tc); }
    for (int q = 0; q < nq; q += 4) {
        if (q + 3 < nq) { td = WT_Q(q + 3); WT_LOAD(vd, td); }
        WT_PROC(va, ta);
        if (q + 4 < nq) { ta = WT_Q(q + 4); WT_LOAD(va, ta); }
        if (q + 1 < nq) WT_PROC(vb, tb);
        if (q + 5 < nq) { tb = WT_Q(q + 5); WT_LOAD(vb, tb); }
        if (q + 2 < nq) WT_PROC(vc, tc);
        if (q + 6 < nq) { tc = WT_Q(q + 6); WT_LOAD(vc, tc); }
        if (q + 3 < nq) WT_PROC(vd, td);
    }
#undef WT_Q
}
#undef WT_LOAD
#undef WT_PROC
__device__ __forceinline__ void pool_add(float (&a)[8], const v4u w, float sg) {
    a[0] += sg * bf_lo(w.x); a[1] += sg * bf_hi(w.x); a[2] += sg * bf_lo(w.y); a[3] += sg * bf_hi(w.y); a[4] += sg * bf_lo(w.z); a[5] += sg * bf_hi(w.z); a[6] += sg * bf_lo(w.w); a[7] += sg * bf_hi(w.w); }
template <int HW, int NRW> __device__ __forceinline__ void pool_rows(const bf16* U, bf16* PD, int t0, int c0) {
    const int s0 = t0 & (SEQ - 1), b0 = t0 - s0;
    constexpr int NR = 2 * HW + NRW - 1;
    v4u w[NR];
#pragma unroll
    for (int i = 0; i < NR; ++i) { const int r = s0 - HW + i, rc = min(max(r, 0), SEQ - 1); w[i] = *(const v4u*)(U + (size_t)(b0 + rc) * D + c0); }
#pragma unroll
    for (int i = 0; i < NR; ++i) { const int r = s0 - HW + i; if (r < 0 || r >= SEQ) w[i] = (v4u){0u, 0u, 0u, 0u}; }
    float acc[8];
#pragma unroll
    for (int j = 0; j < 8; ++j) acc[j] = 0.f;
#pragma unroll
    for (int i = 0; i < 2 * HW; ++i) pool_add(acc, w[i], 1.f);
#pragma unroll
    for (int k = 0; k < NRW; ++k) { const int sr = s0 + k; const float inv = 1.0f / (float)(min(sr + HW, SEQ) - max(sr - HW, 0));
        const v4u c = w[k + HW];
        v4u o; o.x = pk2(acc[0] * inv - bf_lo(c.x), acc[1] * inv - bf_hi(c.x)); o.y = pk2(acc[2] * inv - bf_lo(c.y), acc[3] * inv - bf_hi(c.y));
        o.z = pk2(acc[4] * inv - bf_lo(c.z), acc[5] * inv - bf_hi(c.z)); o.w = pk2(acc[6] * inv - bf_lo(c.w), acc[7] * inv - bf_hi(c.w));
        *(v4u*)(PD + (size_t)(t0 + k) * D + c0) = o;
        if (k < NRW - 1) { pool_add(acc, w[k + 2 * HW], 1.f); pool_add(acc, w[k], -1.f); } }
}
__device__ __forceinline__ void ph_pool(const Params& P, int gw, int ngw, int lane) {
    const bf16* U = (const bf16*)(P.ws + WS_U); bf16* PD = (bf16*)(P.ws + WS_PD);
    for (int wi = gw; wi < (T / 16) * 4; wi += ngw) {
        const int grp = __builtin_amdgcn_readfirstlane(wi & 3), rb2 = wi >> 2;
        const int t0 = (rb2 * 2 + (lane >> 5)) * 8, c0 = grp * 256 + (lane & 31) * 8;
        if (grp == 0) pool_rows<1, 8>(U, PD, t0, c0); else if (grp == 1) pool_rows<2, 8>(U, PD, t0, c0); else if (grp == 2) pool_rows<4, 8>(U, PD, t0, c0); else pool_rows<8, 8>(U, PD, t0, c0);
    }
}
__device__ __forceinline__ void ph_combine(const Params& P, int gw, int ngw, int lane) {
    const bf16* O0 = (const bf16*)(P.ws + WS_OV); const bf16* O1 = O0 + (size_t)T * D; bf16* O = (bf16*)(P.ws + WS_O);
    const float lam = lam_value(P, lane);
    float gs[16];
#pragma unroll
    for (int i = 0; i < 16; ++i) gs[i] = P.g_sub[((16 * lane) & 127) + i] * ONE_M_LAM_INIT;
    for (int t = gw; t < T; t += ngw) {
        const v4u a0 = *(const v4u*)(O0 + (size_t)t * D + 16 * lane), a1 = *(const v4u*)(O0 + (size_t)t * D + 16 * lane + 8);
        const v4u b0 = *(const v4u*)(O1 + (size_t)t * D + 16 * lane), b1 = *(const v4u*)(O1 + (size_t)t * D + 16 * lane + 8);
        float d[16];
        d[0] = bf_lo(a0.x) - lam * bf_lo(b0.x); d[1] = bf_hi(a0.x) - lam * bf_hi(b0.x); d[2] = bf_lo(a0.y) - lam * bf_lo(b0.y); d[3] = bf_hi(a0.y) - lam * bf_hi(b0.y);
        d[4] = bf_lo(a0.z) - lam * bf_lo(b0.z); d[5] = bf_hi(a0.z) - lam * bf_hi(b0.z); d[6] = bf_lo(a0.w) - lam * bf_lo(b0.w); d[7] = bf_hi(a0.w) - lam * bf_hi(b0.w);
        d[8] = bf_lo(a1.x) - lam * bf_lo(b1.x); d[9] = bf_hi(a1.x) - lam * bf_hi(b1.x); d[10] = bf_lo(a1.y) - lam * bf_lo(b1.y); d[11] = bf_hi(a1.y) - lam * bf_hi(b1.y);
        d[12] = bf_lo(a1.z) - lam * bf_lo(b1.z); d[13] = bf_hi(a1.z) - lam * bf_hi(b1.z); d[14] = bf_lo(a1.w) - lam * bf_lo(b1.w); d[15] = bf_hi(a1.w) - lam * bf_hi(b1.w);
        float ss = 0.f;
#pragma unroll
        for (int i = 0; i < 16; ++i) ss += d[i] * d[i];
        ss += __shfl_xor(ss, 1); ss += __shfl_xor(ss, 2); ss += __shfl_xor(ss, 4);
        const float r = rsqrtf(ss * (1.f / 128.f) + EPS);
        v4u o0, o1;
        o0.x = pk2(d[0] * r * gs[0], d[1] * r * gs[1]); o0.y = pk2(d[2] * r * gs[2], d[3] * r * gs[3]); o0.z = pk2(d[4] * r * gs[4], d[5] * r * gs[5]); o0.w = pk2(d[6] * r * gs[6], d[7] * r * gs[7]);
        o1.x = pk2(d[8] * r * gs[8], d[9] * r * gs[9]); o1.y = pk2(d[10] * r * gs[10], d[11] * r * gs[11]); o1.z = pk2(d[12] * r * gs[12], d[13] * r * gs[13]); o1.w = pk2(d[14] * r * gs[14], d[15] * r * gs[15]);
        *(v4u*)(O + (size_t)t * D + 16 * lane) = o0; *(v4u*)(O + (size_t)t * D + 16 * lane + 8) = o1;
    }
}
__device__ __forceinline__ void combine_block(const Params& P, int t0, int h, float lam, int wave, int lane) {
    const bf16* O0 = (const bf16*)(P.ws + WS_OV); const bf16* O1 = O0 + (size_t)T * D; bf16* O = (bf16*)(P.ws + WS_O);
    const int cl = (lane & 7) * 16;
    float gs[16];
#pragma unroll
    for (int i = 0; i < 16; ++i) gs[i] = P.g_sub[cl + i] * ONE_M_LAM_INIT;
#pragma unroll
    for (int it = 0; it < 4; ++it) { const int t = t0 + wave * 32 + it * 8 + (lane >> 3); const size_t off = (size_t)t * D + h * 128 + cl;
        const v4u a0 = *(const v4u*)(O0 + off), a1 = *(const v4u*)(O0 + off + 8), b0 = *(const v4u*)(O1 + off), b1 = *(const v4u*)(O1 + off + 8);
        float d[16];
        d[0] = bf_lo(a0.x) - lam * bf_lo(b0.x); d[1] = bf_hi(a0.x) - lam * bf_hi(b0.x); d[2] = bf_lo(a0.y) - lam * bf_lo(b0.y); d[3] = bf_hi(a0.y) - lam * bf_hi(b0.y);
        d[4] = bf_lo(a0.z) - lam * bf_lo(b0.z); d[5] = bf_hi(a0.z) - lam * bf_hi(b0.z); d[6] = bf_lo(a0.w) - lam * bf_lo(b0.w); d[7] = bf_hi(a0.w) - lam * bf_hi(b0.w);
        d[8] = bf_lo(a1.x) - lam * bf_lo(b1.x); d[9] = bf_hi(a1.x) - lam * bf_hi(b1.x); d[10] = bf_lo(a1.y) - lam * bf_lo(b1.y); d[11] = bf_hi(a1.y) - lam * bf_hi(b1.y);
        d[12] = bf_lo(a1.z) - lam * bf_lo(b1.z); d[13] = bf_hi(a1.z) - lam * bf_hi(b1.z); d[14] = bf_lo(a1.w) - lam * bf_lo(b1.w); d[15] = bf_hi(a1.w) - lam * bf_hi(b1.w);
        float ss = 0.f;
#pragma unroll
        for (int i = 0; i < 16; ++i) ss += d[i] * d[i];
        ss += __shfl_xor(ss, 1); ss += __shfl_xor(ss, 2); ss += __shfl_xor(ss, 4);
        const float r = rsqrtf(ss * (1.f / 128.f) + EPS);
        v4u o0, o1;
        o0.x = pk2(d[0] * r * gs[0], d[1] * r * gs[1]); o0.y = pk2(d[2] * r * gs[2], d[3] * r * gs[3]); o0.z = pk2(d[4] * r * gs[4], d[5] * r * gs[5]); o0.w = pk2(d[6] * r * gs[6], d[7] * r * gs[7]);
        o1.x = pk2(d[8] * r * gs[8], d[9] * r * gs[9]); o1.y = pk2(d[10] * r * gs[10], d[11] * r * gs[11]); o1.z = pk2(d[12] * r * gs[12], d[13] * r * gs[13]); o1.w = pk2(d[14] * r * gs[14], d[15] * r * gs[15]);
        *(v4u*)(O + off) = o0; *(v4u*)(O + off + 8) = o1; }
}
__device__ __forceinline__ void ph_router_fill(const Params& P, int tid, LAS float* wrT) {
    { f32x4 w[8];
#pragma unroll
      for (int j = 0; j < 8; ++j) w[j] = ((const f32x4*)P.w_router)[tid + 512 * j];
#pragma unroll
      for (int j = 0; j < 8; ++j) { const int i4 = tid + 512 * j, d = i4 >> 2, e0 = (i4 & 3) * 4; wrT[(e0 + 0) * D + d] = w[j].x; wrT[(e0 + 1) * D + d] = w[j].y; wrT[(e0 + 2) * D + d] = w[j].z; wrT[(e0 + 3) * D + d] = w[j].w; } }
}
__device__ __forceinline__ void ph_router(const Params& P, int bid, int nblk, int tid, int nthr, LAS float* wrT) {
    const int lane = tid & 63, wave = tid >> 6, nwv = nthr >> 6;
    __syncthreads();
    const bf16* X2 = (const bf16*)(P.ws + WS_X2); unsigned char* H2 = P.ws + WS_H2; float* AFF = (float*)(P.ws + WS_AFF);
    f32x4 gg[4];
#pragma unroll
    for (int j = 0; j < 4; ++j) gg[j] = ((const f32x4*)P.g_ffn)[lane + 64 * j];
    const int t0 = bid * nwv + wave, tstride = nblk * nwv;
    f32x4 v[4]; v2u cv[4], nv[4];
    if (t0 < T) {
#pragma unroll
        for (int j = 0; j < 4; ++j) cv[j] = ((const v2u*)(X2 + (size_t)t0 * D) + lane)[64 * j]; }
    for (int t = t0; t < T; t += tstride) {
        const int tn = t + tstride;
        if (tn < T) {
#pragma unroll
            for (int j = 0; j < 4; ++j) nv[j] = ((const v2u*)(X2 + (size_t)tn * D) + lane)[64 * j]; }
#pragma unroll
        for (int j = 0; j < 4; ++j) { v[j].x = bf_lo(cv[j].x); v[j].y = bf_hi(cv[j].x); v[j].z = bf_lo(cv[j].y); v[j].w = bf_hi(cv[j].y); }
        float s = 0.f;
#pragma unroll
        for (int j = 0; j < 4; ++j) s += (v[j].x * v[j].x + v[j].y * v[j].y) + (v[j].z * v[j].z + v[j].w * v[j].w);
        const float r = rsqrtf(wave_sum(s) * (1.f / D) + EPS);
        unsigned* o4 = (unsigned*)(H2 + (size_t)t * D) + lane;
#pragma unroll
        for (int j = 0; j < 4; ++j) { v[j].x = v[j].x * r * gg[j].x; v[j].y = v[j].y * r * gg[j].y; v[j].z = v[j].z * r * gg[j].z; v[j].w = v[j].w * r * gg[j].w;
            o4[64 * j] = pk4_fp8(v[j].x * XS8_SCALE, v[j].y * XS8_SCALE, v[j].z * XS8_SCALE, v[j].w * XS8_SCALE); }
        float mylg = 0.f;
#pragma unroll 4
        for (int e = 0; e < 16; ++e) { float a = 0.f;
#pragma unroll
            for (int j = 0; j < 4; ++j) { const f32x4 w = *(const LAS f32x4*)(wrT + e * D + 256 * j + 4 * lane); a += (v[j].x * w.x + v[j].y * w.y) + (v[j].z * w.z + v[j].w * w.w); }
            const float tot = wave_sum(a); mylg = (lane == e) ? tot : mylg; }
        float mx = mylg;
        mx = fmaxf(mx, __shfl_xor(mx, 1)); mx = fmaxf(mx, __shfl_xor(mx, 2)); mx = fmaxf(mx, __shfl_xor(mx, 4)); mx = fmaxf(mx, __shfl_xor(mx, 8));
        const float mine = expf(mylg - mx); float den = mine;
        den += __shfl_xor(den, 1); den += __shfl_xor(den, 2); den += __shfl_xor(den, 4); den += __shfl_xor(den, 8);
        if (lane < 16) AFF[((size_t)(t >> 12) * NE + lane) * SEQ + (t & (SEQ - 1))] = mine / den;
#pragma unroll
        for (int j = 0; j < 4; ++j) cv[j] = nv[j];
    }
}
__device__ __forceinline__ void ph_topk(const Params& P, int bid, int nblk, int tid, LAS unsigned* sm) {
    const float* AFF = (const float*)(P.ws + WS_AFF); int* SELI = (int*)(P.ws + WS_SELI); float* SELV = (float*)(P.ws + WS_SELV); int* SLOT = (int*)(P.ws + WS_SLOT);
    const unsigned char* H2 = P.ws + WS_H2; unsigned char* XS = P.ws + WS_XS;
    LAS unsigned* hist = sm;
    LAS unsigned* wtot = sm + 256;
    LAS unsigned* ctl = sm + 272;
    LAS unsigned* cgt = sm + 320;
    LAS unsigned* ceq = sm + 384;
    LAS int* chosen = (LAS int*)(sm + 512);
    const int lane = tid & 63, wave = tid >> 6;
    for (int item = bid; item < NB * NE * 4; item += nblk) {
        const int li = item >> 2, q = item & 3, b = li >> 4, e = li & 15;
        const float* a = AFF + (size_t)li * SEQ;
        unsigned key[8];
#pragma unroll
        for (int i = 0; i < 8; ++i) key[i] = __builtin_bit_cast(unsigned, a[i * 512 + tid]);
        unsigned prefix = 0u, k = CAP;
#pragma unroll 1
        for (int rnd = 0; rnd < 4; ++rnd) { const int shift = 24 - 8 * rnd;
            if (tid < 256) hist[tid] = 0u;
            __syncthreads();
#pragma unroll
            for (int i = 0; i < 8; ++i) { const bool in = (rnd == 0) ? true : ((key[i] >> (shift + 8)) == prefix); if (in) lds_add(&hist[(key[i] >> shift) & 255u], 1u); }
            __syncthreads();
            unsigned h = 0u, sfx = 0u;
            if (tid < 256) { h = hist[tid]; sfx = h;
#pragma unroll
                for (int o = 1; o < 64; o <<= 1) { const unsigned tt = __shfl_down(sfx, o); if (lane + o < 64) sfx += tt; }
                if (lane == 0) wtot[wave] = sfx; }
            __syncthreads();
            if (tid < 256) { unsigned above = 0u;
#pragma unroll
                for (int w = 1; w < 4; ++w) above += (w > wave) ? wtot[w] : 0u;
                const unsigned incl = sfx + above, excl = incl - h;
                if (incl >= k && excl < k) { ctl[2 * rnd] = (prefix << 8) | (unsigned)tid; ctl[2 * rnd + 1] = k - excl; } }
            __syncthreads();
            prefix = ctl[2 * rnd]; k = ctl[2 * rnd + 1];
        }
        const unsigned thr = prefix, need_eq = k;
        unsigned long long gtm[8], eqm[8];
#pragma unroll
        for (int i = 0; i < 8; ++i) { gtm[i] = __ballot(key[i] > thr); eqm[i] = __ballot(key[i] == thr);
            if (lane == 0) { cgt[i * 8 + wave] = (unsigned)__popcll(gtm[i]); ceq[i * 8 + wave] = (unsigned)__popcll(eqm[i]); } }
        __syncthreads();
        if (wave == 0) { const unsigned g0 = cgt[lane], e0 = ceq[lane]; unsigned gs = g0, es = e0;
#pragma unroll
            for (int o = 1; o < 64; o <<= 1) { const unsigned tg = __shfl_up(gs, o), te = __shfl_up(es, o); if (lane >= o) { gs += tg; es += te; } }
            cgt[lane] = gs - g0; ceq[lane] = es - e0; }
        __syncthreads();
        const unsigned long long lt = (1ull << lane) - 1ull;
#pragma unroll
        for (int i = 0; i < 8; ++i) { const int s = i * 512 + tid;
            const unsigned bg = cgt[i * 8 + wave] + (unsigned)__popcll(gtm[i] & lt), be = ceq[i * 8 + wave] + (unsigned)__popcll(eqm[i] & lt);
            const bool isgt = key[i] > thr, iseq = key[i] == thr, sel = isgt || (iseq && be < need_eq);
            const int c = (int)(bg + (be < need_eq ? be : need_eq));
            if (sel && (c >> 7) == q) { SELI[li * CAP + c] = s; SELV[li * CAP + c] = __builtin_bit_cast(float, key[i]); }
            if ((i >> 1) == q) SLOT[((size_t)b * SEQ + s) * NE + e] = sel ? c : -1; }
        __syncthreads();
        __syncthreads();
    }
}
__device__ __forceinline__ void ph_final(const Params& P, int gw, int ngw, int lane) {
    const bf16* X2 = (const bf16*)(P.ws + WS_X2); const unsigned char* Y = P.ws + WS_Y; const int* SLOT = (const int*)(P.ws + WS_SLOT);
    f32x4 gg[4], v[4]; v2u cv[4], nv[4]; int myslot = -1, nslot = -1;
#pragma unroll
    for (int j = 0; j < 4; ++j) gg[j] = ((const f32x4*)P.g_final)[lane + 64 * j];
    if (gw < T) { myslot = SLOT[(size_t)gw * NE + (lane & 15)];
#pragma unroll
        for (int j = 0; j < 4; ++j) cv[j] = ((const v2u*)(X2 + (size_t)gw * D) + lane)[64 * j]; }
    for (int t = gw; t < T; t += ngw) {
        const int tn = t + ngw;
        if (tn < T) { nslot = SLOT[(size_t)tn * NE + (lane & 15)];
#pragma unroll
            for (int j = 0; j < 4; ++j) nv[j] = ((const v2u*)(X2 + (size_t)tn * D) + lane)[64 * j]; }
#pragma unroll
        for (int j = 0; j < 4; ++j) { v[j].x = bf_lo(cv[j].x); v[j].y = bf_hi(cv[j].x); v[j].z = bf_lo(cv[j].y); v[j].w = bf_hi(cv[j].y); }
        const int b = t >> 12;
        unsigned mask = (unsigned)(__ballot(myslot >= 0) & 0xFFFFull);
        while (mask) {
            int e_[4]; float w_[4];
#pragma unroll
            for (int k = 0; k < 4; ++k) { const bool ok = mask != 0u; e_[k] = ok ? (int)__builtin_ctz(mask) : 0; w_[k] = ok ? (1.f / Y8_SCALE) : 0.f; mask = ok ? (mask & (mask - 1u)) : 0u; }
            unsigned yv[4][4];
#pragma unroll
            for (int k = 0; k < 4; ++k) { const int c = __builtin_amdgcn_readlane(myslot, e_[k]); const size_t row = (w_[k] != 0.f) ? ((size_t)(b * NE + e_[k]) * CAP + c) : 0;
                const unsigned* yr = (const unsigned*)(Y + row * D) + lane;
#pragma unroll
                for (int j = 0; j < 4; ++j) yv[k][j] = yr[64 * j]; }
#pragma unroll
            for (int k = 0; k < 4; ++k)
#pragma unroll
                for (int j = 0; j < 4; ++j) { const int yw = (int)yv[k][j]; v[j].x += w_[k] * __builtin_amdgcn_cvt_f32_fp8(yw, 0); v[j].y += w_[k] * __builtin_amdgcn_cvt_f32_fp8(yw, 1); v[j].z += w_[k] * __builtin_amdgcn_cvt_f32_fp8(yw, 2); v[j].w += w_[k] * __builtin_amdgcn_cvt_f32_fp8(yw, 3); }
        }
        float s = 0.f;
#pragma unroll
        for (int j = 0; j < 4; ++j) s += (v[j].x * v[j].x + v[j].y * v[j].y) + (v[j].z * v[j].z + v[j].w * v[j].w);
        const float r = rsqrtf(wave_sum(s) * (1.f / D) + EPS);
        f32x4* orow = (f32x4*)(P.out + (size_t)t * D) + lane;
#pragma unroll
        for (int j = 0; j < 4; ++j) { f32x4 o; o.x = v[j].x * r * gg[j].x; o.y = v[j].y * r * gg[j].y; o.z = v[j].z * r * gg[j].z; o.w = v[j].w * r * gg[j].w; orow[64 * j] = o; }
#pragma unroll
        for (int j = 0; j < 4; ++j) cv[j] = nv[j];
        myslot = nslot;
    }
}

namespace pg8 {
#define PG8_LAS __attribute__((address_space(3)))
typedef unsigned short bf16_t;
typedef short bf16x8 __attribute__((ext_vector_type(8)));
typedef float f32x4 __attribute__((ext_vector_type(4)));
typedef unsigned u32x4 __attribute__((ext_vector_type(4)));
constexpr int BM = 256, BK = 64, HALF = 128, HTB = HALF * BK * 2  , STAGE_BYTES = 8 * HTB, NXCD = 8, WGM = 8;

__host__ __device__ __forceinline__ int lds_byte(int r, int c) { const int st = (r >> 4) * 2 + (c >> 5), rr = r & 15, cc = c & 31, ob = rr * 64 + cc * 2; return st * 1024 + (ob ^ (((ob >> 9) & 1) << 5)); }
__host__ __device__ __forceinline__ void stage_rc(int b, int& R, int& C) { const int st = b / 1024, sb = b % 1024, swz = sb ^ (((sb >> 9) & 1) << 5); R = (st >> 1) * 16 + swz / 64; C = (st & 1) * 32 + (swz % 64) / 2; }
__host__ __device__ __forceinline__ int perm32(int rho) { const int n = rho >> 4, i = rho & 15; return 8 * (i >> 2) + 4 * n + (i & 3); }

struct Unit { int pm, pn, aux; };
struct Gemm { const bf16_t* A; const bf16_t* Bt; int M, N, K; };

struct StaticOrder {
    int nM, nN, nwg, G, c;
    __host__ __device__ void init(int M, int N, int G_, int c_) { nM = M / BM; nN = N / BM; nwg = nM * nN; G = G_; c = c_; }
    __host__ __device__ bool next(int i, Unit& u) const {
        const long L = (long)i * G + c; if (L >= nwg) return false;
        int wgid = (int)L; { const int q = nwg / NXCD, r = nwg % NXCD, xcd = wgid % NXCD, off = wgid / NXCD; wgid = (xcd < r ? xcd * (q + 1) : r * (q + 1) + (xcd - r) * q) + off; }
        const int nig = WGM * nN, gid = wgid / nig, fm = gid * WGM, gsz = (nM - fm) < WGM ? (nM - fm) : WGM;
        u.pm = fm + ((wgid % nig) % gsz); u.pn = (wgid % nig) / gsz; u.aux = 0; return true;
    }
    __device__ __forceinline__ void a_ready(const Unit&) const {}
    __device__ __forceinline__ void done(const Unit&) const {}
};
__device__ __forceinline__ unsigned cvt_pk_bf16(float lo, float hi) { unsigned r; asm volatile("v_cvt_pk_bf16_f32 %0, %1, %2" : "=v"(r) : "v"(lo), "v"(hi)); return r; }

__device__ __forceinline__ float fast_sigmoid(float z) { return __builtin_amdgcn_rcpf(1.0f + __builtin_amdgcn_exp2f(-1.4426950408889634f * z)); }
typedef unsigned v2u_t __attribute__((ext_vector_type(2)));
__device__ __forceinline__ float ub0(unsigned w) { return (float)(w & 0xffu); }
__device__ __forceinline__ float ub1(unsigned w) { return (float)((w >> 8) & 0xffu); }
__device__ __forceinline__ float ub2(unsigned w) { return (float)((w >> 16) & 0xffu); }
__device__ __forceinline__ float ub3(unsigned w) { return (float)(w >> 24); }
struct EpiIn {
    static constexpr bool PERM = true, AFTER_DRAIN = false;
    unsigned char* ws; const float* cs;
    __device__ __forceinline__ void operator()(const f32x4 (&acc)[2][2][4][2], const Unit& u, int wr, int wc, int fr, int fq) const {
        const int seg = u.pn >> 2, colt = (u.pn & 3) * BM;
        const size_t off = seg == 0 ? WS_U : seg == 1 ? WS_Q : seg == 2 ? WS_K : seg == 3 ? WS_V : seg == 4 ? WS_GP : WS_GA;
        bf16_t* base = (bf16_t*)(ws + off);
        const int row0 = u.pm * BM + wr * 64 + fr, col0 = colt + wc * 32 + 8 * fq;
        const bool rot = (seg == 1 || seg == 2) && ((wc & 1) == 0);
        const float sc = seg == 1 ? C2 : 1.f; const float sgn = fq == 0 ? -1.f : 1.f;
        float rsr[2][4];
#pragma unroll
        for (int ai = 0; ai < 2; ++ai)
#pragma unroll
            for (int m = 0; m < 4; ++m) rsr[ai][m] = ((const float*)(ws + WS_RSTD))[row0 + ai * HALF + m * 16];
#pragma unroll
        for (int ai = 0; ai < 2; ++ai)
#pragma unroll
            for (int m = 0; m < 4; ++m) { const int row = row0 + ai * HALF + m * 16; bf16_t* rowp = base + (size_t)row * D + col0;
                f32x4 c0 = {1.f, 1.f, 1.f, 1.f}, c1 = c0, s0 = {0.f, 0.f, 0.f, 0.f}, s1 = s0;
                if (rot && fq < 2) { const f32x4* cp = (const f32x4*)(cs + (size_t)row * 16); c0 = cp[0]; c1 = cp[1]; s0 = cp[2] * sgn; s1 = cp[3] * sgn; }
#pragma unroll
                for (int bj = 0; bj < 2; ++bj) { f32x4 v0 = acc[ai][bj][m][0] * rsr[ai][m], v1 = acc[ai][bj][m][1] * rsr[ai][m];
                    if (rot) { f32x4 p0, p1;
#pragma unroll
                        for (int i = 0; i < 4; ++i) { p0[i] = __shfl_xor(v0[i], 16); p1[i] = __shfl_xor(v1[i], 16); }
                        v0 = v0 * c0 + p0 * s0; v1 = v1 * c1 + p1 * s1; }
                    if (seg >= 4) {
                        unsigned w0 = 0u, w1 = 0u;
                        w0 = __builtin_amdgcn_cvt_pk_u8_f32(fast_sigmoid(v0[0]) * 255.f, 0, w0); w0 = __builtin_amdgcn_cvt_pk_u8_f32(fast_sigmoid(v0[1]) * 255.f, 1, w0);
                        w0 = __builtin_amdgcn_cvt_pk_u8_f32(fast_sigmoid(v0[2]) * 255.f, 2, w0); w0 = __builtin_amdgcn_cvt_pk_u8_f32(fast_sigmoid(v0[3]) * 255.f, 3, w0);
                        w1 = __builtin_amdgcn_cvt_pk_u8_f32(fast_sigmoid(v1[0]) * 255.f, 0, w1); w1 = __builtin_amdgcn_cvt_pk_u8_f32(fast_sigmoid(v1[1]) * 255.f, 1, w1);
                        w1 = __builtin_amdgcn_cvt_pk_u8_f32(fast_sigmoid(v1[2]) * 255.f, 2, w1); w1 = __builtin_amdgcn_cvt_pk_u8_f32(fast_sigmoid(v1[3]) * 255.f, 3, w1);
                        v2u_t w8; w8.x = w0; w8.y = w1; *(v2u_t*)((unsigned char*)base + (size_t)row * D + col0 + bj * HALF) = w8; continue; }
                    v0 = v0 * sc; v1 = v1 * sc; u32x4 w; w.x = cvt_pk_bf16(v0[0], v0[1]); w.y = cvt_pk_bf16(v0[2], v0[3]); w.z = cvt_pk_bf16(v1[0], v1[1]); w.w = cvt_pk_bf16(v1[2], v1[3]);
                    *(u32x4*)(rowp + bj * HALF) = w; } }
    }
};
__device__ __forceinline__ float bfl(unsigned w) { return __builtin_bit_cast(float, w << 16); }
__device__ __forceinline__ float bfh(unsigned w) { return __builtin_bit_cast(float, w & 0xffff0000u); }
struct EpiMerge {
    static constexpr bool PERM = true, AFTER_DRAIN = false, KEEPS_ACC = true;
    mutable v2u_t gak[2][4][2];
    const unsigned char* GP; const unsigned char* GA; bf16_t* MG;
    __device__ __forceinline__ bool keep(const Unit& u) const { return u.aux == 0; }
    __device__ __forceinline__ void operator()(f32x4 (&acc)[2][2][4][2], const Unit& u, int wr, int wc, int fr, int fq) const {
        const int row0 = u.pm * BM + wr * 64 + fr, col0 = u.pn * BM + wc * 32 + 8 * fq;
        if (u.aux == 0) {
#pragma unroll
            for (int ai = 0; ai < 2; ++ai)
#pragma unroll
                for (int m = 0; m < 4; ++m)
#pragma unroll
                    for (int bj = 0; bj < 2; ++bj) { const size_t idx = (size_t)(row0 + ai * HALF + m * 16) * D + col0 + bj * HALF;
                        const v2u_t p = *(const v2u_t*)(GP + idx), a = *(const v2u_t*)(GA + idx); gak[ai][m][bj] = a;
                        const float pv[8] = {ub0(p.x), ub1(p.x), ub2(p.x), ub3(p.x), ub0(p.y), ub1(p.y), ub2(p.y), ub3(p.y)}, av[8] = {ub0(a.x), ub1(a.x), ub2(a.x), ub3(a.x), ub0(a.y), ub1(a.y), ub2(a.y), ub3(a.y)};
#pragma unroll
                        for (int i = 0; i < 4; ++i) { acc[ai][bj][m][0][i] *= pv[i] * __builtin_amdgcn_rcpf(fmaxf(av[i], 0.5f)); acc[ai][bj][m][1][i] *= pv[4 + i] * __builtin_amdgcn_rcpf(fmaxf(av[4 + i], 0.5f)); } }
        } else {
#pragma unroll
            for (int ai = 0; ai < 2; ++ai)
#pragma unroll
                for (int m = 0; m < 4; ++m)
#pragma unroll
                    for (int bj = 0; bj < 2; ++bj) { const size_t idx = (size_t)(row0 + ai * HALF + m * 16) * D + col0 + bj * HALF;
                        const v2u_t a = gak[ai][m][bj]; const f32x4 v0 = acc[ai][bj][m][0], v1 = acc[ai][bj][m][1]; constexpr float Q = 1.0f / 255.0f;
                        const float o[8] = {fmaxf(ub0(a.x), 0.5f) * Q * v0[0], fmaxf(ub1(a.x), 0.5f) * Q * v0[1], fmaxf(ub2(a.x), 0.5f) * Q * v0[2], fmaxf(ub3(a.x), 0.5f) * Q * v0[3],
                                            fmaxf(ub0(a.y), 0.5f) * Q * v1[0], fmaxf(ub1(a.y), 0.5f) * Q * v1[1], fmaxf(ub2(a.y), 0.5f) * Q * v1[2], fmaxf(ub3(a.y), 0.5f) * Q * v1[3]};
                        u32x4 w; w.x = cvt_pk_bf16(o[0], o[1]); w.y = cvt_pk_bf16(o[2], o[3]); w.z = cvt_pk_bf16(o[4], o[5]); w.w = cvt_pk_bf16(o[6], o[7]);
                        *(u32x4*)(MG + idx) = w; }
        }
    }
};
struct MergeOrder { StaticOrder so; const char *A0, *A1, *B0, *B1; size_t tstep;
    __device__ bool next(int i, Unit& u) const { if (!so.next(i >> 1, u)) return false; u.aux = i & 1; return true; }
    __device__ __forceinline__ const char* abase(const Unit& u) const { return (u.aux ? A1 : A0) + (size_t)u.pm * tstep; }
    __device__ __forceinline__ const char* bbase(const Unit& u) const { return (u.aux ? B1 : B0) + (size_t)u.pn * tstep; }
    __device__ __forceinline__ void a_ready(const Unit&) const {}
    __device__ __forceinline__ void done(const Unit&) const {}
};
struct EpiRes {
    static constexpr bool PERM = true, AFTER_DRAIN = false;
    const bf16_t* x; bf16_t* x2;
    __device__ __forceinline__ void operator()(const f32x4 (&acc)[2][2][4][2], const Unit& u, int wr, int wc, int fr, int fq) const {
        const int row0 = u.pm * BM + wr * 64 + fr, col0 = u.pn * BM + wc * 32 + 8 * fq;
        u32x4 xr[2][4][2];
#pragma unroll
        for (int ai = 0; ai < 2; ++ai)
#pragma unroll
            for (int m = 0; m < 4; ++m)
#pragma unroll
                for (int bj = 0; bj < 2; ++bj) xr[ai][m][bj] = *(const u32x4*)(x + (size_t)(row0 + ai * HALF + m * 16) * D + col0 + bj * HALF);
        asm volatile("" ::: "memory");
#pragma unroll
        for (int ai = 0; ai < 2; ++ai)
#pragma unroll
            for (int m = 0; m < 4; ++m)
#pragma unroll
                for (int bj = 0; bj < 2; ++bj) { const size_t off = (size_t)(row0 + ai * HALF + m * 16) * D + col0 + bj * HALF; const u32x4 xb = xr[ai][m][bj];
                    const f32x4 v0 = (f32x4){bfl(xb.x), bfh(xb.x), bfl(xb.y), bfh(xb.y)} + acc[ai][bj][m][0], v1 = (f32x4){bfl(xb.z), bfh(xb.z), bfl(xb.w), bfh(xb.w)} + acc[ai][bj][m][1];
                    u32x4 w; w.x = cvt_pk_bf16(v0[0], v0[1]); w.y = cvt_pk_bf16(v0[2], v0[3]); w.z = cvt_pk_bf16(v1[0], v1[1]); w.w = cvt_pk_bf16(v1[2], v1[3]);
                    *(u32x4*)(x2 + off) = w; }
    }
};
typedef int v8i_t __attribute__((ext_vector_type(8))); typedef int v4i_t __attribute__((ext_vector_type(4)));
__device__ __forceinline__ v8i_t pg8_cat(bf16x8 lo, bf16x8 hi) { const v4i_t a = __builtin_bit_cast(v4i_t, lo), b = __builtin_bit_cast(v4i_t, hi); return __builtin_shufflevector(a, b, 0, 1, 2, 3, 4, 5, 6, 7); }
__device__ __forceinline__ unsigned pk4_e4m3(float a, float b, float c, float d) { return pk4_fp8(a, b, c, d); }
struct EpiUp {
    static constexpr bool PERM = true, AFTER_DRAIN = false;
    unsigned char* act;
    __device__ __forceinline__ void operator()(const f32x4 (&acc)[2][2][4][2], const Unit& u, int wr, int wc, int fr, int fq) const {
        const int e = (u.pm >> 1) & 15, j = u.pn - e * 22;
        const int row0 = u.pm * BM + wr * 64 + fr, col0 = j * HALF + wc * 32 + 8 * fq;
        constexpr float SI = 1.0f / (XS8_SCALE * W8_SCALE), C1 = -1.4426950408889634f * SI, K2 = 1.0f / (SI * SI * ACT8_SCALE);
#pragma unroll
        for (int ai = 0; ai < 2; ++ai)
#pragma unroll
            for (int m = 0; m < 4; ++m) { float o[8];
#pragma unroll
                for (int n = 0; n < 2; ++n)
#pragma unroll
                    for (int i = 0; i < 4; ++i) { const float gr = acc[ai][0][m][n][i], t = __builtin_amdgcn_exp2f(gr * C1); o[4 * n + i] = (gr * acc[ai][1][m][n][i]) * __builtin_amdgcn_rcpf(__builtin_fmaf(t, K2, K2)); }
                v2u w; w.x = pk4_fp8(o[0], o[1], o[2], o[3]); w.y = pk4_fp8(o[4], o[5], o[6], o[7]);
                *(v2u*)(act + (size_t)(row0 + ai * HALF + m * 16) * FF + col0) = w; }
    }
};
struct EpiDown {
    static constexpr bool PERM = true, AFTER_DRAIN = false;
    unsigned char* y; const float* val;
    __device__ __forceinline__ void operator()(const f32x4 (&acc)[2][2][4][2], const Unit& u, int wr, int wc, int fr, int fq) const {
        const int e = (u.pm >> 1) & 15, n4 = u.pn - e * 4;
        const int row0 = u.pm * BM + wr * 64 + fr, col0 = n4 * BM + wc * 32 + 8 * fq;
        float vr[2][4];
#pragma unroll
        for (int ai = 0; ai < 2; ++ai)
#pragma unroll
            for (int m = 0; m < 4; ++m) vr[ai][m] = val[row0 + ai * HALF + m * 16];
        asm volatile("" ::: "memory");
#pragma unroll
        for (int ai = 0; ai < 2; ++ai)
#pragma unroll
            for (int m = 0; m < 4; ++m) { const int row = row0 + ai * HALF + m * 16; const float vv = vr[ai][m] * (Y8_SCALE / (ACT8_SCALE * W8_SCALE));
#pragma unroll
                for (int bj = 0; bj < 2; ++bj) { const f32x4 v0 = acc[ai][bj][m][0] * vv, v1 = acc[ai][bj][m][1] * vv;
                    v2u w; w.x = pk4_fp8(v0[0], v0[1], v0[2], v0[3]); w.y = pk4_fp8(v1[0], v1[1], v1[2], v1[3]);
                    *(v2u*)(y + (size_t)row * D + col0 + bj * HALF) = w; } }
    }
};
struct InOrder { int pm0, off0, nu;
    __device__ bool next(int i, Unit& u) const { if (i >= nu) return false; const int off = off0 + 16 * i, k = off >> 4, w = off & 15, rg = k / 6, cg = k - 6 * rg;
        u.pm = pm0 + 4 * rg + (w & 3); u.pn = 4 * cg + (w >> 2); u.aux = 0; return true; }
    __device__ __forceinline__ void a_ready(const Unit&) const {}
    __device__ __forceinline__ void done(const Unit&) const {}
};
struct UpOrder { int xg, l; const PG8_LAS int* lidx;
    __device__ __forceinline__ void gather(const Unit& u, int tid, unsigned (&g)[2][2]) const {
#pragma unroll
        for (int i = 0; i < 2; ++i) { int R, C; stage_rc(tid * 16 + i * 8192, R, C);
#pragma unroll
            for (int h = 0; h < 2; ++h) g[h][i] = (unsigned)(lidx[u.aux * 256 + h * HALF + R] * D + 2 * C); } }
    __device__ bool next(int i, Unit& u) const { if (i >= 11) return false; const int uu = i * 32 + l, e = xg * 2 + uu / 176, r = uu % 176, j = r >> 3, pmi = r & 7;
        u.pm = ((pmi >> 1) * 16 + e) * 2 + (pmi & 1); u.pn = e * 22 + j; u.aux = i; return true; }
    __device__ __forceinline__ void a_ready(const Unit&) const {}
    __device__ __forceinline__ void done(const Unit&) const {}
};
struct DownOrder { int xg, l;
    __device__ bool next(int i, Unit& u) const { if (i >= 2) return false; const int e = xg * 2 + i, pmi = l & 7, n4 = l >> 3;
        u.pm = ((pmi >> 1) * 16 + e) * 2 + (pmi & 1); u.pn = e * 4 + n4; u.aux = 0; return true; }
    __device__ __forceinline__ void a_ready(const Unit&) const {}
    __device__ __forceinline__ void done(const Unit&) const {}
};
template <class S_, class = void> struct pg8_has_bases { static constexpr bool value = false; };
template <class S_> struct pg8_has_bases<S_, decltype((void)&S_::abase)> { static constexpr bool value = true; };
template <class S_, class = void> struct pg8_gathers { static constexpr bool value = false; };
template <class S_> struct pg8_gathers<S_, decltype((void)&S_::gather)> { static constexpr bool value = true; };
template <class E_, class = void> struct pg8_keeps_acc { static constexpr bool value = false; };
template <class E_> struct pg8_keeps_acc<E_, decltype((void)E_::KEEPS_ACC)> { static constexpr bool value = E_::KEEPS_ACC; };
template <class Epi, class Sched, bool ALIGN_EPI = false, bool SP2 = false, bool FP8 = false>
__device__ __forceinline__ void gemm_phase(PG8_LAS unsigned char* lds, const Gemm g, const Sched& S, const Epi& E) {
    const int tid = threadIdx.x, wid = __builtin_amdgcn_readfirstlane(tid >> 6), lane = tid & 63, wr = wid >> 2, wc = wid & 3, fr = lane & 15, fq = lane >> 4;
    const int K = g.K, nt = K / BK;
    unsigned voffA[2], voffB[2];
#pragma unroll
    for (int i = 0; i < 2; ++i) { int R, C; stage_rc(tid * 16 + i * 8192, R, C); const int Rb = Epi::PERM ? ((R & ~31) + perm32(R & 31)) : R;
        voffA[i] = (unsigned)(R * K + C) * 2u; voffB[i] = (unsigned)(Rb * K + C) * 2u; }
    const size_t kstep = (size_t)(BK * 2);
    const size_t hstep = (size_t)HALF * K * 2;
    const size_t tstep = 2 * hstep;
    const unsigned ldsw = (unsigned)wid * 1024u;
    const int aoff = lds_byte(wr * 64 + fr, fq * 8), boff = lds_byte(wc * 32 + fr, fq * 8);
    constexpr bool GATHER = pg8_gathers<Sched>::value; static_assert(!GATHER || SP2, "gathered A rows: SP2 loop only");
    unsigned gA[2][2] = {{0u, 0u}, {0u, 0u}}, gN[2][2] = {{0u, 0u}, {0u, 0u}};
#define PG8_SA(b, h) (((b) * 2 + (h)) * HTB)
#define PG8_SB(b, h) ((4 + (b) * 2 + (h)) * HTB)
#define PG8_STAGE(bufoff, gbase, voff) do { _Pragma("unroll") for (int _i = 0; _i < 2; ++_i) \
        __builtin_amdgcn_global_load_lds((const unsigned*)((const char*)(gbase) + (voff)[_i]), (PG8_LAS unsigned*)(lds + (bufoff) + ldsw + _i * 8192), 16, 0, 0); } while (0)
#define PG8_STAGE_A(bufoff, gbase, half, nx) do { if constexpr (GATHER) { unsigned vo_[2] = {(nx) ? gN[half][0] : gA[half][0], (nx) ? gN[half][1] : gA[half][1]}; PG8_STAGE(bufoff, gbase, vo_); } \
        else { PG8_STAGE(bufoff, (gbase) + (half) * hstep, voffA); } } while (0)
#define PG8_GPIN(g) asm volatile("" : "+v"(g[0][0]), "+v"(g[0][1]), "+v"(g[1][0]), "+v"(g[1][1]))
#define PG8_LDA(dst, b, h) do { _Pragma("unroll") for (int m = 0; m < 4; ++m) { const bf16x8 x0_ = *(const PG8_LAS bf16x8*)(lds + PG8_SA(b, h) + aoff + m * 2048), x1_ = *(const PG8_LAS bf16x8*)(lds + PG8_SA(b, h) + aoff + m * 2048 + 1024); \
        if constexpr (FP8) dst##8[m] = pg8_cat(x0_, x1_); else { dst[m][0] = x0_; dst[m][1] = x1_; } } } while (0)
#define PG8_LDB(dst, b, h) do { _Pragma("unroll") for (int n = 0; n < 2; ++n) { const bf16x8 x0_ = *(const PG8_LAS bf16x8*)(lds + PG8_SB(b, h) + boff + n * 2048), x1_ = *(const PG8_LAS bf16x8*)(lds + PG8_SB(b, h) + boff + n * 2048 + 1024); \
        if constexpr (FP8) dst##8[n] = pg8_cat(x0_, x1_); else { dst[n][0] = x0_; dst[n][1] = x1_; } } } while (0)
#define PG8_MMA(ai, bj, At, Bt) do { __builtin_amdgcn_s_setprio(1); \
        if constexpr (FP8) { _Pragma("unroll") for (int m = 0; m < 4; ++m) _Pragma("unroll") for (int n = 0; n < 2; ++n) \
            asm volatile("s_nop 1\n\tv_mfma_scale_f32_16x16x128_f8f6f4 %0, %1, %2, %0, %3, %3 op_sel_hi:[0,0,0]" : "+v"(acc[ai][bj][m][n]) : "v"(Bt##8[n]), "v"(At##8[m]), "v"(sc8_)); } \
        else { _Pragma("unroll") for (int m = 0; m < 4; ++m) _Pragma("unroll") for (int n = 0; n < 2; ++n) _Pragma("unroll") for (int k = 0; k < 2; ++k) \
            acc[ai][bj][m][n] = __builtin_amdgcn_mfma_f32_16x16x32_bf16(Bt[n][k], At[m][k], acc[ai][bj][m][n], 0, 0, 0); } \
        __builtin_amdgcn_s_setprio(0); } while (0)
#define PG8_WAIT_V(n) asm volatile("s_waitcnt vmcnt(" #n ")" ::: "memory")
#define PG8_WAIT_L(n) asm volatile("s_waitcnt lgkmcnt(" #n ")" ::: "memory")
#define PG8_BAR __builtin_amdgcn_s_barrier()
#define PG8_SCHED __builtin_amdgcn_sched_barrier(0)
    Unit cur, nxt; int ui = 0;
    if (!S.next(0, cur)) return;
    f32x4 acc[2][2][4][2];
#pragma unroll
    for (int a = 0; a < 2; ++a)
#pragma unroll
        for (int b = 0; b < 2; ++b)
#pragma unroll
            for (int m = 0; m < 4; ++m)
#pragma unroll
                for (int n = 0; n < 2; ++n) acc[a][b][m][n] = (f32x4){0.f, 0.f, 0.f, 0.f};
    const unsigned sc8_ = 0x7F7F7F7Fu;
    bf16x8 At[4][2], B0[2][2], B1[2][2]; v8i_t At8[4], B08[2], B18[2];
    const char* cA; const char* cB;
    if constexpr (pg8_has_bases<Sched>::value) { cA = S.abase(cur); cB = S.bbase(cur); } else { cA = (const char*)g.A + (GATHER ? (size_t)0 : (size_t)cur.pm * tstep); cB = (const char*)g.Bt + (size_t)cur.pn * tstep; }
    if constexpr (GATHER) { S.gather(cur, tid, gA); PG8_GPIN(gA); }
    S.a_ready(cur);
    if constexpr (SP2) {
        PG8_STAGE(PG8_SB(0, 0), cB, voffB); PG8_STAGE(PG8_SB(0, 1), cB + hstep, voffB); PG8_STAGE_A(PG8_SA(0, 0), cA, 0, false); PG8_STAGE_A(PG8_SA(0, 1), cA, 1, false);
        if (wr == 1) PG8_BAR;
        PG8_WAIT_V(2); PG8_BAR;
        PG8_STAGE(PG8_SB(1, 0), cB + kstep, voffB); PG8_STAGE_A(PG8_SA(1, 0), cA + kstep, 0, false); PG8_STAGE(PG8_SB(1, 1), cB + hstep + kstep, voffB);
        PG8_WAIT_V(6); PG8_BAR;
    } else {
        PG8_STAGE(PG8_SB(0, 0), cB, voffB); PG8_STAGE(PG8_SA(0, 0), cA, voffA); PG8_STAGE(PG8_SB(0, 1), cB + hstep, voffB); PG8_STAGE(PG8_SA(0, 1), cA + hstep, voffA);
        if (wr == 1) PG8_BAR;
        PG8_WAIT_V(4); PG8_BAR;
        PG8_STAGE(PG8_SB(1, 0), cB + kstep, voffB); PG8_STAGE(PG8_SA(1, 0), cA + kstep, voffA); PG8_STAGE(PG8_SB(1, 1), cB + hstep + kstep, voffB);
        PG8_WAIT_V(6); PG8_BAR;
    }
    for (;;) {
        const bool has_next = S.next(ui + 1, nxt);
        const char* nA; const char* nB;
        if constexpr (pg8_has_bases<Sched>::value) { nA = has_next ? S.abase(nxt) : cA; nB = has_next ? S.bbase(nxt) : cB; } else { nA = (has_next && !GATHER) ? (const char*)g.A + (size_t)nxt.pm * tstep : cA; nB = has_next ? (const char*)g.Bt + (size_t)nxt.pn * tstep : cB; }
        if constexpr (GATHER) { if (has_next) S.gather(nxt, tid, gN); else { gN[0][0] = gA[0][0]; gN[0][1] = gA[0][1]; gN[1][0] = gA[1][0]; gN[1][1] = gA[1][1]; } PG8_GPIN(gN); }
        for (int t = 0; t < nt; t += 2) {
            const bool last = (t == nt - 2);
            const char* a1 = cA + (size_t)(t + 1) * kstep;
            const char* a2 = last ? nA : cA + (size_t)(t + 2) * kstep; const char* b2 = last ? nB : cB + (size_t)(t + 2) * kstep;
            const char* a3 = a2 + kstep; const char* b3 = b2 + kstep;
            if (last && has_next) S.a_ready(nxt);
            if constexpr (SP2) {
            PG8_LDB(B0, 0, 0); PG8_LDB(B1, 0, 1); PG8_SCHED; PG8_LDA(At, 0, 0); PG8_STAGE_A(PG8_SA(1, 1), a1, 1, false);
            PG8_WAIT_V(8); PG8_WAIT_L(0); PG8_BAR; PG8_MMA(0, 0, At, B0); PG8_MMA(0, 1, At, B1); PG8_BAR; PG8_SCHED;
            PG8_LDA(At, 0, 1); PG8_STAGE(PG8_SB(0, 0), b2, voffB); PG8_STAGE(PG8_SB(0, 1), b2 + hstep, voffB); PG8_STAGE_A(PG8_SA(0, 0), a2, 0, last);
            PG8_WAIT_V(8); PG8_WAIT_L(0); PG8_BAR; PG8_MMA(1, 0, At, B0); PG8_MMA(1, 1, At, B1); PG8_BAR; PG8_SCHED;
            PG8_LDB(B0, 1, 0); PG8_LDB(B1, 1, 1); PG8_SCHED; PG8_LDA(At, 1, 0); PG8_STAGE_A(PG8_SA(0, 1), a2, 1, last);
            PG8_WAIT_V(8); PG8_WAIT_L(0); PG8_BAR; PG8_MMA(0, 0, At, B0); PG8_MMA(0, 1, At, B1); PG8_BAR; PG8_SCHED;
            PG8_LDA(At, 1, 1); PG8_STAGE(PG8_SB(1, 0), b3, voffB); PG8_STAGE(PG8_SB(1, 1), b3 + hstep, voffB); PG8_STAGE_A(PG8_SA(1, 0), a3, 0, last);
            PG8_WAIT_V(8); PG8_WAIT_L(0); PG8_BAR; PG8_MMA(1, 0, At, B0); PG8_MMA(1, 1, At, B1); PG8_BAR; PG8_SCHED;
            } else {
            PG8_LDB(B0, 0, 0); PG8_SCHED; PG8_LDA(At, 0, 0); PG8_STAGE(PG8_SA(1, 1), a1 + hstep, voffA);
            PG8_WAIT_L(8); PG8_BAR; PG8_WAIT_L(0); PG8_MMA(0, 0, At, B0); PG8_BAR; PG8_SCHED;
            PG8_LDB(B1, 0, 1); PG8_STAGE(PG8_SB(0, 0), b2, voffB);
            PG8_BAR; PG8_WAIT_L(0); PG8_MMA(0, 1, At, B1); PG8_BAR;
            PG8_LDA(At, 0, 1); PG8_STAGE(PG8_SA(0, 0), a2, voffA);
            PG8_BAR; PG8_WAIT_L(0); PG8_MMA(1, 0, At, B0); PG8_BAR; PG8_SCHED;
            PG8_STAGE(PG8_SB(0, 1), b2 + hstep, voffB);
            PG8_WAIT_V(6); PG8_BAR; PG8_MMA(1, 1, At, B1); PG8_BAR;
            PG8_LDB(B0, 1, 0); PG8_SCHED; PG8_LDA(At, 1, 0); PG8_STAGE(PG8_SA(0, 1), a2 + hstep, voffA);
            PG8_WAIT_L(8); PG8_BAR; PG8_WAIT_L(0); PG8_MMA(0, 0, At, B0); PG8_BAR; PG8_SCHED;
            PG8_LDB(B1, 1, 1); PG8_STAGE(PG8_SB(1, 0), b3, voffB);
            PG8_BAR; PG8_WAIT_L(0); PG8_MMA(0, 1, At, B1); PG8_BAR;
            PG8_LDA(At, 1, 1); PG8_STAGE(PG8_SA(1, 0), a3, voffA);
            PG8_BAR; PG8_WAIT_L(0); PG8_MMA(1, 0, At, B0); PG8_BAR; PG8_SCHED;
            PG8_STAGE(PG8_SB(1, 1), b3 + hstep, voffB);
            PG8_WAIT_V(6); PG8_BAR; PG8_MMA(1, 1, At, B1); PG8_BAR;
            }
        }
        if constexpr (ALIGN_EPI) { if (wr == 0) PG8_BAR; }
        if constexpr (!Epi::AFTER_DRAIN) { E(acc, cur, wr, wc, fr, fq); S.done(cur); }
        if (!has_next) break;
        bool keep_ = false; if constexpr (pg8_keeps_acc<Epi>::value) keep_ = E.keep(cur);
        if (!keep_) {
#pragma unroll
        for (int a = 0; a < 2; ++a)
#pragma unroll
            for (int b = 0; b < 2; ++b)
#pragma unroll
                for (int m = 0; m < 4; ++m)
#pragma unroll
                    for (int n = 0; n < 2; ++n) acc[a][b][m][n] = (f32x4){0.f, 0.f, 0.f, 0.f};
        }
        cur = nxt; cA = nA; cB = nB; ++ui;
        if constexpr (GATHER) { gA[0][0] = gN[0][0]; gA[0][1] = gN[0][1]; gA[1][0] = gN[1][0]; gA[1][1] = gN[1][1]; }
        if constexpr (ALIGN_EPI) { if (wr == 1) PG8_BAR; }
    }
    PG8_WAIT_V(0);
    if constexpr (!ALIGN_EPI) { if (wr == 0) PG8_BAR; }
    PG8_BAR;
    if constexpr (Epi::AFTER_DRAIN) { E.fused(acc, cur, wr, wc, fr, fq, lds, wid, lane); S.done(cur); }
#undef PG8_SA
#undef PG8_SB
#undef PG8_STAGE
#undef PG8_LDA
#undef PG8_STAGE_A
#undef PG8_GPIN
#undef PG8_LDB
#undef PG8_MMA
#undef PG8_WAIT_V
#undef PG8_WAIT_L
#undef PG8_BAR
#undef PG8_SCHED
}
}

#include <hip/hip_bf16.h>
#include <cmath>
namespace attn_body {
using bf16=__hip_bfloat16;
using bf16x8=__attribute__((ext_vector_type(8)))short;
using s16x4=__attribute__((ext_vector_type(4)))short;
using f32x16=__attribute__((ext_vector_type(16)))float;
using u32x4=__attribute__((ext_vector_type(4)))unsigned;
constexpr int SEQ=4096,D=64,DM=1024;
constexpr int NW=8,QBLK=32,QB=QBLK*NW,KVBLK=64,NQB=SEQ/QB;
constexpr int ATTN_PITCH=DM, ATTN_UNIT_ROWS=QB;
__device__ __forceinline__ int crow(int r,int hi){return (r&3)+8*(r>>2)+4*hi;}
#define SBAR() __builtin_amdgcn_sched_barrier(0)
__device__ __forceinline__ void cmask(f32x16&p0,f32x16&p1,int jb,int qrel,int hi){
  const float NEG=-INFINITY; int kb=64*jb+4*hi;
  #pragma unroll
  for(int r=0;r<16;++r){int kv=kb+(r&3)+8*(r>>2); if(kv>qrel)p0[r]=NEG; if(kv+32>qrel)p1[r]=NEG;}
}

constexpr int NSLOT=3, SLOTB=8192;
constexpr int LDS_K=0, LDS_V=NSLOT*SLOTB, LDS_WS=2*NSLOT*SLOTB, LDS_OST=LDS_WS+NW*64*4, LDS_BYTES=LDS_OST+NW*4096;
constexpr float C2=0.125f*1.4426950408889634f;
__device__ __forceinline__ void glds16(const void*gsrc,unsigned lds_dst){unsigned keep;
  asm volatile("s_mov_b32 %0, m0\n\ts_mov_b32 m0, %2\n\ts_nop 0\n\tglobal_load_lds_dwordx4 %1, off\n\ts_mov_b32 m0, %0":"=&s"(keep):"v"(gsrc),"s"(lds_dst):"memory");}
__device__ __forceinline__ float max3f(float a,float b,float c){float r;asm("v_max3_f32 %0, %1, %2, %3":"=v"(r):"v"(a),"v"(b),"v"(c));return r;}
__device__ __forceinline__ float max2f(float a,float b){float r;asm("v_max_f32_e32 %0, %1, %2":"=v"(r):"v"(a),"v"(b));return r;}
__device__ __forceinline__ float fadd_s(float a,float b){float r;asm("v_add_f32_e32 %0, %1, %2":"=v"(r):"v"(a),"v"(b));return r;}
__device__ __forceinline__ float fsub_s(float a,float b){float r;asm("v_sub_f32_e32 %0, %1, %2":"=v"(r):"v"(a),"v"(b));return r;}
typedef float f32x2_t __attribute__((ext_vector_type(2))); typedef __bf16 bf16x2_t __attribute__((ext_vector_type(2)));
__device__ __forceinline__ unsigned cvtpk_s(float lo,float hi){f32x2_t v={lo,hi};bf16x2_t b=__builtin_convertvector(v,bf16x2_t);return __builtin_bit_cast(unsigned,b);}
#define WAIT_BAR(N) asm volatile("s_waitcnt vmcnt(" #N ") lgkmcnt(0)\n\ts_barrier":::"memory")

__device__ __forceinline__ void qkt(f32x16&p0,f32x16&p1,const char*Kslot,const bf16x8*qr,const f32x16&negm,int r32,int hi){
  const char*kb=Kslot+hi*1024+r32*16;
  #pragma unroll
  for(int d0=0;d0<4;++d0){
    const bf16x8 b0=*reinterpret_cast<const bf16x8*>(kb+d0*2048);
    const bf16x8 b1=*reinterpret_cast<const bf16x8*>(kb+d0*2048+512);
    if(d0==0){p0=__builtin_amdgcn_mfma_f32_32x32x16_bf16(b0,qr[0],negm,0,0,0);p1=__builtin_amdgcn_mfma_f32_32x32x16_bf16(b1,qr[0],negm,0,0,0);}
    else{p0=__builtin_amdgcn_mfma_f32_32x32x16_bf16(b0,qr[d0],p0,0,0,0);p1=__builtin_amdgcn_mfma_f32_32x32x16_bf16(b1,qr[d0],p1,0,0,0);}}
}
typedef __attribute__((address_space(3))) const char* lds_cptr;
typedef short v4i16_t __attribute__((ext_vector_type(4)));
__device__ __forceinline__ void kload8(bf16x8*kf,lds_cptr kp){
  kf[0]=*(const __attribute__((address_space(3))) bf16x8*)(kp);      kf[1]=*(const __attribute__((address_space(3))) bf16x8*)(kp+512);
  kf[2]=*(const __attribute__((address_space(3))) bf16x8*)(kp+2048); kf[3]=*(const __attribute__((address_space(3))) bf16x8*)(kp+2560);
  kf[4]=*(const __attribute__((address_space(3))) bf16x8*)(kp+4096); kf[5]=*(const __attribute__((address_space(3))) bf16x8*)(kp+4608);
  kf[6]=*(const __attribute__((address_space(3))) bf16x8*)(kp+6144); kf[7]=*(const __attribute__((address_space(3))) bf16x8*)(kp+6656);
}
__device__ __forceinline__ void kload2(bf16x8*kf,lds_cptr kp,int j){ kf[2*j]=*(const __attribute__((address_space(3))) bf16x8*)(kp+j*2048); kf[2*j+1]=*(const __attribute__((address_space(3))) bf16x8*)(kp+j*2048+512); }
__device__ __forceinline__ s16x4 vtr(lds_cptr p){ return __builtin_bit_cast(s16x4,__builtin_amdgcn_ds_read_tr16_b64_v4i16((__attribute__((address_space(3))) v4i16_t*)p)); }
__device__ __forceinline__ float rowmax(const f32x16&p0,const f32x16&p1){
  float a=max3f(p0[0],p0[1],p1[0]),b=max3f(p0[2],p0[3],p1[1]);a=max3f(a,p1[2],p1[3]);
  #pragma unroll
  for(int r=4;r<16;r+=4){a=max3f(a,p0[r],p0[r+1]);b=max3f(b,p0[r+2],p0[r+3]);a=max3f(a,p1[r],p1[r+1]);b=max3f(b,p1[r+2],p1[r+3]);}
  const float m=max2f(a,b);
  auto rr=__builtin_amdgcn_permlane32_swap(__float_as_uint(m),__float_as_uint(m),false,false);
  return max2f(__uint_as_float(rr[0]),__uint_as_float(rr[1]));
}
__device__ __forceinline__ void pv(f32x16*o,int vb,bf16x8 pa0,bf16x8 pa1,bf16x8 pa2,bf16x8 pa3){
  #pragma unroll
  for(int d0=0;d0<2;++d0){s16x4 lo[4],hi[4];
    #pragma unroll
    for(int ks=0;ks<4;++ks){
      asm volatile("ds_read_b64_tr_b16 %0,%1 offset:%c2":"=&v"(lo[ks]):"v"(vb),"i"(d0*4096+ks*1024):"memory");
      asm volatile("ds_read_b64_tr_b16 %0,%1 offset:%c2":"=&v"(hi[ks]):"v"(vb),"i"(d0*4096+ks*1024+512):"memory");}
    asm volatile("s_waitcnt lgkmcnt(0)":::"memory");SBAR();
    #define PK(k) (bf16x8){lo[k][0],lo[k][1],lo[k][2],lo[k][3],hi[k][0],hi[k][1],hi[k][2],hi[k][3]}
    o[d0]=__builtin_amdgcn_mfma_f32_32x32x16_bf16(pa0,PK(0),o[d0],0,0,0);
    o[d0]=__builtin_amdgcn_mfma_f32_32x32x16_bf16(pa1,PK(1),o[d0],0,0,0);
    o[d0]=__builtin_amdgcn_mfma_f32_32x32x16_bf16(pa2,PK(2),o[d0],0,0,0);
    o[d0]=__builtin_amdgcn_mfma_f32_32x32x16_bf16(pa3,PK(3),o[d0],0,0,0);
    #undef PK
  }
}

#ifndef ATTN_STORE16
#define ATTN_STORE16(p,v) (*(u32x4*)(p)=(v))
#endif
template<int THRL> __device__ __forceinline__ void attn_unit(const bf16*Qh,const bf16*__restrict__ Kh,const bf16*__restrict__ Vh,bf16*Oh,int q0,char*shm){
  const int tid=threadIdx.x,lane=tid&63,r32=lane&31,hi=lane>>5; const int wid=__builtin_amdgcn_readfirstlane(tid>>6);
  const bf16*Qw=Qh+(long)(q0+wid*QBLK)*DM;
  const unsigned lds0=(unsigned)(uintptr_t)shm;
  float*wsf=(float*)(shm+LDS_WS)+wid*64;
  const bf16*ksrc=Kh+(long)lane*DM+wid*8;
  const bf16*vsrc=Vh+(long)(16*(wid&3)+(lane>>2))*DM+(wid>>2)*32+(lane&3)*8;
  const unsigned kdst=lds0+LDS_K+wid*1024, vdst=lds0+LDS_V+wid*1024;
  #define DMA_K(t,slot) glds16(ksrc+(long)(t)*KVBLK*DM,(unsigned)__builtin_amdgcn_readfirstlane(kdst+(slot)))
  #define DMA_V(t,slot) glds16(vsrc+(long)(t)*KVBLK*DM,(unsigned)__builtin_amdgcn_readfirstlane(vdst+(slot)))
  const int vb0=(int)(lds0+LDS_V)+((lane>>4)&1)*32+(lane&3)*8+(4*hi+((lane&15)>>2))*64;
  const char*Kbase=shm+LDS_K; bf16x8 kf[8];
  const lds_cptr shm3=(lds_cptr)shm; const lds_cptr kp0=shm3+LDS_K+hi*1024+r32*16; const lds_cptr vp0=shm3+LDS_V+((lane>>4)&1)*32+(lane&3)*8+(4*hi+((lane&15)>>2))*64;
  const int NT=SEQ/KVBLK;
  DMA_K(0,0);DMA_V(0,0);DMA_K(1,SLOTB);
  bf16x8 qr[4];
  #pragma unroll
  for(int d0=0;d0<4;++d0)qr[d0]=*reinterpret_cast<const bf16x8*>(&Qw[(long)r32*DM+d0*16+hi*8]);
  float mhat=0.f,l_reg=0.f;f32x16 o[2];o[0]=f32x16{};o[1]=f32x16{};f32x16 negm=f32x16{};asm volatile("":"+v"(negm));
  const int qrel=wid*QBLK+r32;
  #define CMASK(P0,P1,t) do{}while(0)
  bool resc=false;
  #define START(P0,P1) do{ const float rm=rowmax(P0,P1); resc=false; \
    { const float dl=rm; mhat=fadd_s(mhat,dl); \
      _Pragma("unroll") for(int r=0;r<16;++r){P0[r]=fsub_s(P0[r],dl);P1[r]=fsub_s(P1[r],dl);} \
      _Pragma("unroll") for(int r=0;r<16;++r)negm[r]=-mhat; asm volatile("":"+v"(negm)); } \
    _Pragma("unroll") for(int r=0;r<16;++r)P0[r]=__builtin_amdgcn_exp2f(P0[r]); }while(0)
  #define RESC() do{ if(resc){ asm volatile("s_waitcnt lgkmcnt(0)":::"memory"); \
      _Pragma("unroll") for(int d_=0;d_<2;++d_) _Pragma("unroll") for(int r=0;r<16;++r)o[d_][r]*=wsf[crow(r,hi)]; } }while(0)
  f32x16 pA0,pA1,pB0,pB1;
  int sl_prev=0,sl_cur=0,sl_next=SLOTB;
  #define ROT() do{sl_prev=sl_cur;sl_cur=sl_next;sl_next=(sl_next==(NSLOT-1)*SLOTB)?0:sl_next+SLOTB;}while(0)
  DMA_K(2,2*SLOTB);
  WAIT_BAR(3);
  qkt(pA0,pA1,Kbase,qr,negm,r32,hi);asm volatile("s_nop 15\n\ts_nop 7":"+v"(pA0),"+v"(pA1));CMASK(pA0,pA1,0);
  START(pA0,pA1);
  _Pragma("unroll") for(int r=0;r<16;++r)pA1[r]=__builtin_amdgcn_exp2f(pA1[r]);
  WAIT_BAR(0);
  DMA_K(3,0);DMA_V(1,SLOTB);
  ROT();
  kload8(kf,kp0+sl_cur);
  WAIT_BAR(2);
  s16x4 vlo[8],vhi[8]; u32x4 pw0,pw1,pw2,pw3;
  #define PKW(P,B) cvtpk_s(P[B],P[B+1])
  #define PAF(k) __builtin_bit_cast(bf16x8,pw##k)
  #define VFR(i) (bf16x8){vlo[i][0],vlo[i][1],vlo[i][2],vlo[i][3],vhi[i][0],vhi[i][1],vhi[i][2],vhi[i][3]}
  #define PIN(x) asm volatile("":"+v"(x))
  #define MX3(a,b,c) __builtin_fmaxf(__builtin_fmaxf((a),(b)),(c))
  #define GAPA(MF,A0,A1,A2,A3,W0,W1,PW) do{ MF; sacc+=A0; sacc+=A1; sacc+=A2; sacc+=A3; PIN(sacc); W0; W1; PIN(PW); SBAR(); }while(0)
  #define EX(v) __builtin_amdgcn_exp2f(v)
  #define GAPB(MF,X,B) do{ MF; X[B]=EX(X[B]); X[B+1]=EX(X[B+1]); X[B+2]=EX(X[B+2]); X[B+3]=EX(X[B+3]); PIN(X); SBAR(); }while(0)
  #define VRD(i) do{ vlo[i]=vtr(vp_+(((i)>>2)*4096+((i)&3)*1024)); vhi[i]=vtr(vp_+(((i)>>2)*4096+((i)&3)*1024+512)); }while(0)
  #define KRD(G,j) do{ if(G){ kload2(kf,kp0+sl_next,j); SBAR(); } }while(0)
  #define STEP(C0,C1,P0,P1,t,GK,GV,GL) do{ SBAR(); \
    const lds_cptr vp_=vp0+sl_prev; \
    VRD(0); SBAR(); float sacc=(P0[0]+P0[1]); \
    GAPA(C0=__builtin_amdgcn_mfma_f32_32x32x16_bf16(kf[0],qr[0],negm,0,0,0), P0[2],P0[3],P0[4],P0[5],     pw0[0]=PKW(P0,0), pw0[1]=PKW(P0,2), pw0); \
    VRD(4); SBAR(); GAPA(C1=__builtin_amdgcn_mfma_f32_32x32x16_bf16(kf[1],qr[0],negm,0,0,0), P0[6],P0[7],P0[8],P0[9],     pw0[2]=PKW(P0,4), pw0[3]=PKW(P0,6), pw0); \
    VRD(1); SBAR(); GAPA(C0=__builtin_amdgcn_mfma_f32_32x32x16_bf16(kf[2],qr[1],C0,0,0,0),   P0[10],P0[11],P0[12],P0[13], pw1[0]=PKW(P0,8), pw1[1]=PKW(P0,10), pw1); \
    VRD(5); SBAR(); GAPA(C1=__builtin_amdgcn_mfma_f32_32x32x16_bf16(kf[3],qr[1],C1,0,0,0),   P0[14],P0[15],P1[0],P1[1],   pw1[2]=PKW(P0,12),pw1[3]=PKW(P0,14), pw1); \
    VRD(2); SBAR(); GAPA(C0=__builtin_amdgcn_mfma_f32_32x32x16_bf16(kf[4],qr[2],C0,0,0,0),   P1[2],P1[3],P1[4],P1[5],     pw2[0]=PKW(P1,0), pw2[1]=PKW(P1,2), pw2); \
    VRD(6); SBAR(); GAPA(C1=__builtin_amdgcn_mfma_f32_32x32x16_bf16(kf[5],qr[2],C1,0,0,0),   P1[6],P1[7],P1[8],P1[9],     pw2[2]=PKW(P1,4), pw2[3]=PKW(P1,6), pw2); \
    VRD(3); SBAR(); GAPA(C0=__builtin_amdgcn_mfma_f32_32x32x16_bf16(kf[6],qr[3],C0,0,0,0),   P1[10],P1[11],P1[12],P1[13], pw3[0]=PKW(P1,8), pw3[1]=PKW(P1,10), pw3); \
    VRD(7); SBAR(); GAPA(C1=__builtin_amdgcn_mfma_f32_32x32x16_bf16(kf[7],qr[3],C1,0,0,0),   P1[14],P1[15],0.f,0.f,       pw3[2]=PKW(P1,12),pw3[3]=PKW(P1,14), pw3); \
    l_reg+=sacc; \
    if(GK){DMA_K((t)+3,sl_cur);} if(GV){DMA_V((t)+1,sl_next);} \
    CMASK(C0,C1,t); \
    { float a=MX3(C0[0],C0[1],C1[0]),b=MX3(C0[2],C0[3],C1[1]); a=MX3(a,C1[2],C1[3]); \
      _Pragma("unroll") for(int r=4;r<16;r+=4){a=MX3(a,C0[r],C0[r+1]);b=MX3(b,C0[r+2],C0[r+3]);a=MX3(a,C1[r],C1[r+1]);b=MX3(b,C1[r+2],C1[r+3]);} \
      float rm=__builtin_fmaxf(a,b); { auto rr=__builtin_amdgcn_permlane32_swap(__float_as_uint(rm),__float_as_uint(rm),false,false); rm=__builtin_fmaxf(__uint_as_float(rr[0]),__uint_as_float(rr[1])); } \
      resc=false; \
      if(__builtin_expect(__any(rm>(float)THRL),0)){ const float dl=__builtin_fmaxf(rm,0.f); mhat+=dl; \
        _Pragma("unroll") for(int r=0;r<16;++r){C0[r]-=dl;C1[r]-=dl;} \
        _Pragma("unroll") for(int r=0;r<16;++r)negm[r]=-mhat; asm volatile("":"+v"(negm)); \
        const float f=__builtin_amdgcn_exp2f(-dl); l_reg*=f; if(hi==0)wsf[r32]=f; resc=true; } } \
    SBAR(); \
    GAPB(o[0]=__builtin_amdgcn_mfma_f32_32x32x16_bf16(PAF(0),VFR(0),o[0],0,0,0), C0,0); \
    GAPB(o[1]=__builtin_amdgcn_mfma_f32_32x32x16_bf16(PAF(0),VFR(4),o[1],0,0,0), C0,4); \
    KRD(GL,0); GAPB(o[0]=__builtin_amdgcn_mfma_f32_32x32x16_bf16(PAF(1),VFR(1),o[0],0,0,0), C0,8); \
    KRD(GL,1); GAPB(o[1]=__builtin_amdgcn_mfma_f32_32x32x16_bf16(PAF(1),VFR(5),o[1],0,0,0), C0,12); \
    KRD(GL,2); GAPB(o[0]=__builtin_amdgcn_mfma_f32_32x32x16_bf16(PAF(2),VFR(2),o[0],0,0,0), C1,0); \
    KRD(GL,3); GAPB(o[1]=__builtin_amdgcn_mfma_f32_32x32x16_bf16(PAF(2),VFR(6),o[1],0,0,0), C1,4); \
    GAPB(o[0]=__builtin_amdgcn_mfma_f32_32x32x16_bf16(PAF(3),VFR(3),o[0],0,0,0), C1,8); \
    GAPB(o[1]=__builtin_amdgcn_mfma_f32_32x32x16_bf16(PAF(3),VFR(7),o[1],0,0,0), C1,12); \
    }while(0)
  int t=1;
  #undef CMASK
  #define CMASK(P0,P1,t) do{}while(0)
  for(;t+5<NT;t+=2){
    STEP(pB0,pB1,pA0,pA1,t,true,true,true);     WAIT_BAR(2); RESC(); ROT();
    STEP(pA0,pA1,pB0,pB1,t+1,true,true,true);   WAIT_BAR(2); RESC(); ROT();
  }
  #undef CMASK
  #define CMASK(P0,P1,t) do{}while(0)
  #define ENDW(tt) do{ if((tt)+3<NT){WAIT_BAR(2);} else if((tt)+2<NT){WAIT_BAR(1);} else {WAIT_BAR(0);} }while(0)
  for(;t+1<NT;t+=2){
    STEP(pB0,pB1,pA0,pA1,t,(t+3<NT),(t+1<NT),(t+1<NT));       ENDW(t);   RESC(); ROT();
    STEP(pA0,pA1,pB0,pB1,t+1,(t+4<NT),(t+2<NT),(t+2<NT));     ENDW(t+1); RESC(); ROT();
  }
  STEP(pB0,pB1,pA0,pA1,NT-1,false,false,false); RESC();
  { float sacc=pB0[0]+pB0[1]; _Pragma("unroll") for(int r=2;r<16;++r)sacc+=pB0[r]; _Pragma("unroll") for(int r=0;r<16;++r)sacc+=pB1[r]; l_reg+=sacc;
    pw0=(u32x4){PKW(pB0,0),PKW(pB0,2),PKW(pB0,4),PKW(pB0,6)};pw1=(u32x4){PKW(pB0,8),PKW(pB0,10),PKW(pB0,12),PKW(pB0,14)};pw2=(u32x4){PKW(pB1,0),PKW(pB1,2),PKW(pB1,4),PKW(pB1,6)};pw3=(u32x4){PKW(pB1,8),PKW(pB1,10),PKW(pB1,12),PKW(pB1,14)};
    SBAR(); pv(o,vb0+sl_cur,PAF(0),PAF(1),PAF(2),PAF(3)); }
  #undef PKW
  #undef PAF
  #undef VFR
  #undef PIN
  #undef MX3
  #undef GAPA
  #undef GAPB
  #undef EX
  #undef VRD
  #undef KRD
  #undef STEP
  #undef ENDW
  {auto rr=__builtin_amdgcn_permlane32_swap(__float_as_uint(l_reg),__float_as_uint(l_reg),false,false);l_reg=__uint_as_float(rr[0])+__uint_as_float(rr[1]);}
  if(hi==0)wsf[32+r32]=l_reg;asm volatile("s_waitcnt lgkmcnt(0)":::"memory");
  float rli[16];
  #pragma unroll
  for(int r=0;r<16;++r)rli[r]=__builtin_amdgcn_rcpf(wsf[32+crow(r,hi)]);
  bf16*Ow=Oh+(long)(q0+wid*QBLK)*DM;
  { bf16*stg=(bf16*)(shm+LDS_OST)+wid*2048;
    #pragma unroll
    for(int r=0;r<16;++r){const int orow=crow(r,hi);
      #pragma unroll
      for(int d0=0;d0<2;++d0)stg[orow*64+d0*32+r32]=__float2bfloat16(o[d0][r]*rli[r]);}
    asm volatile("s_waitcnt lgkmcnt(0)":::"memory");
    #pragma unroll
    for(int i=0;i<4;++i){const int row=i*8+(lane>>3),ch=lane&7; const u32x4 v=*(const u32x4*)(stg+row*64+ch*8); ATTN_STORE16(Ow+(long)row*DM+ch*8,v);} }
  asm volatile("s_waitcnt lgkmcnt(0)\n\ts_barrier":::"memory");
  #undef DMA_K
  #undef DMA_V
  #undef CMASK
  #undef START
  #undef RESC
  #undef ROT
}
constexpr int ATTN_LDS_BYTES=LDS_BYTES;
#undef SBAR
#undef WAIT_BAR
}

namespace attn2 {
using bf16x8 = __attribute__((ext_vector_type(8))) short;
using s16x4  = __attribute__((ext_vector_type(4))) short;
using f32x16 = __attribute__((ext_vector_type(16))) float;
using u32x4  = __attribute__((ext_vector_type(4))) unsigned;
constexpr int NW = 8, QBLK = 32, KVBLK = 64, LD = 1024, NT = 4096 / KVBLK;
constexpr float THR = 16.0f;
constexpr int SHM_V = KVBLK * 128 * 2, SHM_K = KVBLK * 64 * 2;
constexpr int OST_PITCH = 136;
#define KSWZ(row, colB) ((row) * 128 + ((colB) ^ ((((row) >> 1) & 7) << 4)))
#define SBAR() __builtin_amdgcn_sched_barrier(0)
__device__ __forceinline__ int crow(int r, int hi) { return (r & 3) + 8 * (r >> 2) + 4 * hi; }
__device__ __forceinline__ float bf2f_(unsigned short h) { return __builtin_bit_cast(float, (unsigned)h << 16); }
__device__ __forceinline__ float bf_lo_(unsigned w) { return __builtin_bit_cast(float, w << 16); }
__device__ __forceinline__ float bf_hi_(unsigned w) { return __builtin_bit_cast(float, w & 0xffff0000u); }
typedef float f32x2_t __attribute__((ext_vector_type(2))); typedef __bf16 bf16x2_t __attribute__((ext_vector_type(2)));
__device__ __forceinline__ unsigned cvtpk(float lo, float hi) { f32x2_t v = {lo, hi}; bf16x2_t b = __builtin_convertvector(v, bf16x2_t); return __builtin_bit_cast(unsigned, b); }
__device__ __forceinline__ void partialSM(f32x16& p0, f32x16& p1, float& m_reg, float& mn, float& alpha) {
  float pmax = p0[0]; for (int r = 1; r < 16; ++r) pmax = fmaxf(pmax, p0[r]); for (int r = 0; r < 16; ++r) pmax = fmaxf(pmax, p1[r]);
  { auto rr = __builtin_amdgcn_permlane32_swap(__float_as_uint(pmax), __float_as_uint(pmax), false, false);
    pmax = fmaxf(__uint_as_float(rr[0]), __uint_as_float(rr[1])); }
  { const bool keep = __all(pmax - m_reg <= THR);
    mn = keep ? m_reg : fmaxf(m_reg, pmax); alpha = keep ? 1.f : __builtin_amdgcn_exp2f(m_reg - mn); m_reg = mn; }
  for (int r = 0; r < 16; ++r) p0[r] = p0[r] - mn; for (int r = 0; r < 16; ++r) p1[r] = p1[r] - mn;
  for (int r = 0; r < 16; ++r) p0[r] = __builtin_amdgcn_exp2f(p0[r]);
}
__device__ __forceinline__ void finishSM(f32x16& p0, f32x16& p1, float alpha, float& l_reg, bf16x8& pa0, bf16x8& pa1, bf16x8& pa2, bf16x8& pa3) {
  for (int r = 0; r < 16; ++r) p1[r] = __builtin_amdgcn_exp2f(p1[r]);
  float ps = 0; for (int r = 0; r < 16; ++r) ps += p0[r]; for (int r = 0; r < 16; ++r) ps += p1[r];
  { auto rr = __builtin_amdgcn_permlane32_swap(__float_as_uint(ps), __float_as_uint(ps), false, false);
    ps = __uint_as_float(rr[0]) + __uint_as_float(rr[1]); }
  l_reg = l_reg * alpha + ps;
#define PK4(P, BASE, OUT) do { u32x4 w = {cvtpk(P[BASE + 0], P[BASE + 1]), cvtpk(P[BASE + 2], P[BASE + 3]), cvtpk(P[BASE + 4], P[BASE + 5]), cvtpk(P[BASE + 6], P[BASE + 7])}; OUT = *reinterpret_cast<bf16x8*>(&w); } while (0)
  PK4(p0, 0, pa0); PK4(p0, 8, pa1); PK4(p1, 0, pa2); PK4(p1, 8, pa3);
#undef PK4
}
__device__ __forceinline__ void qkt(f32x16& p0, f32x16& p1, const char* Ks, const bf16x8* qr, int r32, int hi) {
  p0 = f32x16{}; p1 = f32x16{};
  for (int d0 = 0; d0 < 4; ++d0) { int cb = (d0 * 16 + hi * 8) * 2;
    bf16x8 b0 = *reinterpret_cast<const bf16x8*>(Ks + KSWZ(r32, cb));
    bf16x8 b1 = *reinterpret_cast<const bf16x8*>(Ks + KSWZ(32 + r32, cb));
    p0 = __builtin_amdgcn_mfma_f32_32x32x16_bf16(b0, qr[d0], p0, 0, 0, 0);
    p1 = __builtin_amdgcn_mfma_f32_32x32x16_bf16(b1, qr[d0], p1, 0, 0, 0); }
}
__device__ __forceinline__ int v_st(int k, int c) { const int kk = (k & ~0xC) | ((k & 4) << 1) | ((k & 8) >> 1); return ((kk >> 3) * 4 + (c >> 5)) * 512 + ((kk & 7) * 32 + (c & 31)) * 2; }
__device__ __forceinline__ int v_rd_base(int lane) { return ((lane & 3) << 3) | (((lane >> 2) & 3) << 6) | (((lane >> 4) & 1) << 5) | (((lane >> 5) & 1) << 8); }
constexpr int v_rd_off(int d0, int ks, int half) { return d0 * 512 + ks * 4096 + half * 2048; }
typedef short v4i16_t __attribute__((ext_vector_type(4)));
typedef __attribute__((address_space(3))) const char* lds_cptr;
__device__ __forceinline__ s16x4 vtr(lds_cptr p) { return __builtin_bit_cast(s16x4, __builtin_amdgcn_ds_read_tr16_b64_v4i16((__attribute__((address_space(3))) v4i16_t*)p)); }
template <int D0> __device__ __forceinline__ void pv_one(f32x16& od, lds_cptr vp, bf16x8 pa0, bf16x8 pa1, bf16x8 pa2, bf16x8 pa3) {
  const s16x4 l0 = vtr(vp + v_rd_off(D0, 0, 0)), h0 = vtr(vp + v_rd_off(D0, 0, 1)), l1 = vtr(vp + v_rd_off(D0, 1, 0)), h1 = vtr(vp + v_rd_off(D0, 1, 1));
  const s16x4 l2 = vtr(vp + v_rd_off(D0, 2, 0)), h2 = vtr(vp + v_rd_off(D0, 2, 1)), l3 = vtr(vp + v_rd_off(D0, 3, 0)), h3 = vtr(vp + v_rd_off(D0, 3, 1));
#define PK(L, H) (bf16x8){L[0], L[1], L[2], L[3], H[0], H[1], H[2], H[3]}
  od = __builtin_amdgcn_mfma_f32_32x32x16_bf16(pa0, PK(l0, h0), od, 0, 0, 0);
  od = __builtin_amdgcn_mfma_f32_32x32x16_bf16(pa1, PK(l1, h1), od, 0, 0, 0);
  od = __builtin_amdgcn_mfma_f32_32x32x16_bf16(pa2, PK(l2, h2), od, 0, 0, 0);
  od = __builtin_amdgcn_mfma_f32_32x32x16_bf16(pa3, PK(l3, h3), od, 0, 0, 0);
#undef PK
}
__device__ __forceinline__ void pv_d0(f32x16* o, lds_cptr vp, bf16x8 pa0, bf16x8 pa1, bf16x8 pa2, bf16x8 pa3) {
  pv_one<0>(o[0], vp, pa0, pa1, pa2, pa3); pv_one<1>(o[1], vp, pa0, pa1, pa2, pa3); pv_one<2>(o[2], vp, pa0, pa1, pa2, pa3); pv_one<3>(o[3], vp, pa0, pa1, pa2, pa3);
}
__device__ __forceinline__ void glds16(const void* gsrc, unsigned lds_dst) { unsigned keep;
  asm volatile("s_mov_b32 %0, m0\n\ts_mov_b32 m0, %2\n\ts_nop 0\n\tglobal_load_lds_dwordx4 %1, off\n\ts_mov_b32 m0, %0" : "=&s"(keep) : "v"(gsrc), "s"(lds_dst) : "memory"); }
#define GLDS_K(sbase, voff, lds_dst) do { unsigned keep_; asm volatile("s_mov_b32 %0, m0\n\ts_mov_b32 m0, %3\n\ts_nop 0\n\tglobal_load_lds_dwordx4 %1, %2\n\ts_mov_b32 m0, %0" : "=&s"(keep_) : "v"(voff), "s"(sbase), "s"(lds_dst) : "memory"); } while (0)
#define GLDS_V2(sbase, sbase_m896, voff, lds_dst) do { unsigned keep_; asm volatile("s_mov_b32 %0, m0\n\ts_mov_b32 m0, %4\n\ts_nop 0\n\tglobal_load_lds_dwordx4 %1, %2\n\tglobal_load_lds_dwordx4 %1, %3 offset:1024\n\ts_mov_b32 m0, %0" \
    : "=&s"(keep_) : "v"(voff), "s"(sbase), "s"(sbase_m896), "s"(lds_dst) : "memory"); } while (0)
#define GLDS_KV2(kbase, kvoff, kdst_, vbase, vbase_m896, vvoff, vdst_) do { unsigned keep_; asm volatile("s_mov_b32 %0, m0\n\ts_mov_b32 m0, %3\n\ts_nop 0\n\tglobal_load_lds_dwordx4 %1, %2\n\t" \
    "s_mov_b32 m0, %7\n\ts_nop 0\n\tglobal_load_lds_dwordx4 %4, %5\n\tglobal_load_lds_dwordx4 %4, %6 offset:1024\n\ts_mov_b32 m0, %0" \
    : "=&s"(keep_) : "v"(kvoff), "s"(kbase), "s"(kdst_), "v"(vvoff), "s"(vbase), "s"(vbase_m896), "s"(vdst_) : "memory"); } while (0)
#define WAIT_BAR(N) asm volatile("s_waitcnt vmcnt(" #N ") lgkmcnt(0)\n\ts_barrier" ::: "memory")
constexpr int R_V = 0, R_K = 2 * SHM_V, R_KEEP = R_K + 3 * SHM_K, R_WS = R_KEEP + NW * 32 * OST_PITCH * 2, R_BYTES = R_WS + NW * 64 * 4;
static_assert(NW * 32 * OST_PITCH * 2 <= R_WS && R_BYTES <= 131072, "O stage below the scratch; everything inside the 128 KiB phase area");
template <int VAR, int CMB = 0> __device__ __forceinline__ void attn_unit(const bf16* __restrict__ Qb, const bf16* __restrict__ Kh, const bf16* __restrict__ Vh, bf16* __restrict__ Ob, char* lds,
                                                                        const bf16* O0g = nullptr, float lam = 0.f, const float* gsub = nullptr) {
  const int tid = threadIdx.x, lane = tid & 63, r32 = lane & 31, hi = lane >> 5; const int wid = __builtin_amdgcn_readfirstlane(tid >> 6);
  char* V_lds = lds + R_V; char* K_lds = lds + R_K;
  float* ws = (float*)(lds + R_WS) + wid * 64; float* li_l = ws; float* al_l = ws + 32;
  const unsigned lds0 = (unsigned)(uintptr_t)lds;
  const int krow = 8 * wid + (lane >> 3), kch = (lane & 7) ^ ((krow >> 1) & 7);
  const unsigned kvo = (unsigned)(krow * LD + 8 * kch) * 2u;
  const int vkk = wid * 8 + ((lane & 31) >> 2), vk = vkk;
  const unsigned vvo = (unsigned)(vk * LD + (lane >> 5) * 32 + 8 * (lane & 3)) * 2u;
  const unsigned kdst = lds0 + R_K + wid * 1024, vdst = lds0 + R_V + wid * 2048;
#define DMA_K(t, slotB) do { if constexpr (!(VAR & 4)) { const bf16* kb_ = Kh + (long)(t) * KVBLK * LD; GLDS_K(kb_, kvo, (unsigned)__builtin_amdgcn_readfirstlane(kdst + (slotB))); } } while (0)
#define DMA_V(t, slotB) do { if constexpr (!(VAR & 4)) { const char* vb_ = (const char*)(Vh + (long)(t) * KVBLK * LD); const char* vbm_ = vb_ - 896; GLDS_V2(vb_, vbm_, vvo, (unsigned)__builtin_amdgcn_readfirstlane(vdst + (slotB))); } } while (0)
#define DMA_KV(tk, slotK, tv, slotV) do { if constexpr (!(VAR & 4)) { const bf16* kb_ = Kh + (long)(tk) * KVBLK * LD; const char* vb_ = (const char*)(Vh + (long)(tv) * KVBLK * LD); const char* vbm_ = vb_ - 896; \
    GLDS_KV2(kb_, kvo, (unsigned)__builtin_amdgcn_readfirstlane(kdst + (slotK)), vb_, vbm_, vvo, (unsigned)__builtin_amdgcn_readfirstlane(vdst + (slotV))); } } while (0)
  if constexpr (!CMB) { DMA_K(0, 0); DMA_V(0, 0); DMA_K(1, SHM_K); }
  const unsigned bsel_w = ((((lane >> 4) & 1) != 0) == ((lane & 15) >= 8)) ? 0x3F803F80u : 0u;
  const bf16x8 bsel = __builtin_bit_cast(bf16x8, (u32x4){bsel_w, bsel_w, bsel_w, bsel_w});
  f32x4 osum = {};
  const int osrow = ((lane & 15) >= 8 ? 16 : 0) + 4 * (lane >> 4);
  float mhat = 0.f; f32x16 o[4] = {}; bf16x8 qr[4];
  f32x16 negm16;
  const bf16* Qw = Qb + (long)(wid * QBLK + r32) * LD + hi * 8;
#pragma unroll
  for (int d0 = 0; d0 < 4; ++d0) qr[d0] = *reinterpret_cast<const bf16x8*>(Qw + d0 * 16);
  const lds_cptr vb0 = (lds_cptr)(__attribute__((address_space(3))) const char*)(__attribute__((address_space(3))) char*)((__attribute__((address_space(3))) char*)0 + ((unsigned)(uintptr_t)V_lds + v_rd_base(lane)));
#define RESC(a) do { if (__any((a) < 1.f)) { if (hi == 0) al_l[r32] = (a); asm volatile("s_waitcnt lgkmcnt(0)" ::: "memory"); \
    for (int d = 0; d < 4; ++d) for (int r = 0; r < 16; ++r) o[d][r] *= al_l[crow(r, hi)]; osum *= *(const f32x4*)(al_l + osrow); } } while (0)
  f32x16 pA0, pA1; float mnA, alA; bf16x8 pa0, pa1, pa2, pa3;
  u32x4 pwA0 = {}, pwA1 = {}, pwA2 = {}, pwA3 = {}, pwB0 = {}, pwB1 = {}, pwB2 = {}, pwB3 = {}; s16x4 vAl0 = {}, vAl1 = {}, vAl2 = {}, vAl3 = {}, vAh0 = {}, vAh1 = {}, vAh2 = {}, vAh3 = {}, vBl0 = {}, vBl1 = {}, vBl2 = {}, vBl3 = {}, vBh0 = {}, vBh1 = {}, vBh2 = {}, vBh3 = {};
  WAIT_BAR(0);
  qkt(pA0, pA1, K_lds, qr, r32, hi);
  { float pmax = pA0[0]; for (int r = 1; r < 16; ++r) pmax = fmaxf(pmax, pA0[r]); for (int r = 0; r < 16; ++r) pmax = fmaxf(pmax, pA1[r]);
    { auto rr = __builtin_amdgcn_permlane32_swap(__float_as_uint(pmax), __float_as_uint(pmax), false, false); pmax = fmaxf(__uint_as_float(rr[0]), __uint_as_float(rr[1])); }
    mhat = pmax; for (int r = 0; r < 16; ++r) negm16[r] = -mhat; alA = 1.f; mnA = mhat;
    for (int r = 0; r < 16; ++r) { pA0[r] = __builtin_amdgcn_exp2f(pA0[r] - mhat); } for (int r = 0; r < 16; ++r) pA1[r] = pA1[r] - mhat; }
  DMA_K(2, 2 * SHM_K);
  WAIT_BAR(1);
  int kc = SHM_K, kf = 0, vp = 0, vf = SHM_V;
#ifndef ATT_SGB
#define ATT_SGB 0
#endif
#if ATT_SGB == 1
#define ATT_PIPE() do { __builtin_amdgcn_sched_group_barrier(0x100, 8, 0); \
    _Pragma("unroll") for (int g_ = 0; g_ < 8; ++g_) { __builtin_amdgcn_sched_group_barrier(0x8, 1, 0); __builtin_amdgcn_sched_group_barrier(0x100, 2, 0); __builtin_amdgcn_sched_group_barrier(0x2, 12, 0); } \
    _Pragma("unroll") for (int g_ = 0; g_ < 8; ++g_) { __builtin_amdgcn_sched_group_barrier(0x8, 1, 0); __builtin_amdgcn_sched_group_barrier(0x100, 2, 0); __builtin_amdgcn_sched_group_barrier(0x2, 6, 0); } \
    _Pragma("unroll") for (int g_ = 0; g_ < 8; ++g_) { __builtin_amdgcn_sched_group_barrier(0x8, 1, 0); __builtin_amdgcn_sched_group_barrier(0x2, 6, 0); } } while (0)
#elif ATT_SGB == 2
#define ATT_PIPE() __builtin_amdgcn_iglp_opt(2)
#elif ATT_SGB == 3
#define ATT_PIPE() __builtin_amdgcn_iglp_opt(3)
#else
#define ATT_PIPE() do {} while (0)
#endif
#define STEP(N0, N1, mnN, alN, O0, O1, alO, j) do { \
    if ((j) + 2 < NT) DMA_K((j) + 2, kf); if ((j) + 1 < NT) DMA_V((j) + 1, vf); \
    SBAR(); qkt(N0, N1, K_lds + kc, qr, r32, hi); \
    finishSM(O0, O1, alO, l_reg, pa0, pa1, pa2, pa3); \
    pv_d0(o, vb0 + vp, pa0, pa1, pa2, pa3); partialSM(N0, N1, m_reg, mnN, alN); \
    ATT_PIPE(); SBAR(); \
    RESC(alN); \
    if ((j) + 2 < NT) WAIT_BAR(3); else if ((j) + 1 < NT) WAIT_BAR(2); else WAIT_BAR(0); \
    { const int t_ = kf; kf = kc; kc = (kc == 2 * SHM_K) ? 0 : kc + SHM_K; (void)t_; } \
    { vf = vp; vp = (vp == 2 * SHM_V) ? 0 : vp + SHM_V; } } while (0)
#define MX3(a, b, c) __builtin_fmaxf(__builtin_fmaxf((a), (b)), (c))
#define PIN(x) asm volatile("" : "+v"(x))
  const int kswz_ = ((r32 >> 1) & 7) << 4;
  const int koffb = r32 * 128 + ((hi * 16) ^ kswz_);
#define STEP3(PO, PN, j) do { \
    DMA_V((j), vf); if ((j) + 2 < NT) DMA_K((j) + 2, kf); \
    SBAR(); \
    const char* Kp_ = K_lds + kc; const lds_cptr vq_ = vb0 + vp; int koff0 = koffb; asm volatile("" : "+v"(koff0)); const int koff1 = koff0 ^ 32, koff2 = koff0 ^ 64, koff3 = koff0 ^ 96; \
    const bf16x8 k00 = *reinterpret_cast<const bf16x8*>(Kp_ + koff0), k01 = *reinterpret_cast<const bf16x8*>(Kp_ + koff0 + 4096); \
    const bf16x8 k10 = *reinterpret_cast<const bf16x8*>(Kp_ + koff1), k11 = *reinterpret_cast<const bf16x8*>(Kp_ + koff1 + 4096); \
    bf16x8 k20, k21, k30, k31; float alN_; \
    SBAR(); \
    k20 = *reinterpret_cast<const bf16x8*>(Kp_ + koff2); k21 = *reinterpret_cast<const bf16x8*>(Kp_ + koff2 + 4096); N0 = __builtin_amdgcn_mfma_f32_32x32x16_bf16(k00, qr[0], negm16, 0, 0, 0); SBAR(); \
    k30 = *reinterpret_cast<const bf16x8*>(Kp_ + koff3); k31 = *reinterpret_cast<const bf16x8*>(Kp_ + koff3 + 4096); N1 = __builtin_amdgcn_mfma_f32_32x32x16_bf16(k01, qr[0], negm16, 0, 0, 0); SBAR(); \
     N0 = __builtin_amdgcn_mfma_f32_32x32x16_bf16(k10, qr[1], N0, 0, 0, 0); SBAR(); \
     N1 = __builtin_amdgcn_mfma_f32_32x32x16_bf16(k11, qr[1], N1, 0, 0, 0); SBAR(); \
    if constexpr (!(VAR & 8)) { vAl0 = vtr(vq_ + 0); vAh0 = vtr(vq_ + 2048); } N0 = __builtin_amdgcn_mfma_f32_32x32x16_bf16(k20, qr[2], N0, 0, 0, 0); SBAR(); \
    if constexpr (!(VAR & 8)) { vAl1 = vtr(vq_ + 4096); vAh1 = vtr(vq_ + 6144); } N1 = __builtin_amdgcn_mfma_f32_32x32x16_bf16(k21, qr[2], N1, 0, 0, 0); SBAR(); \
    if constexpr (!(VAR & 8)) { vAl2 = vtr(vq_ + 8192); vAh2 = vtr(vq_ + 10240); } N0 = __builtin_amdgcn_mfma_f32_32x32x16_bf16(k30, qr[3], N0, 0, 0, 0); SBAR(); \
    if constexpr (!(VAR & 8)) { vAl3 = vtr(vq_ + 12288); vAh3 = vtr(vq_ + 14336); } N1 = __builtin_amdgcn_mfma_f32_32x32x16_bf16(k31, qr[3], N1, 0, 0, 0); SBAR(); \
    float mxa_, mxb_, rm_; unsigned ca0, ca1, cb0, cb1; \
    if constexpr (!(VAR & 8)) { vBl0 = vtr(vq_ + 512); vBh0 = vtr(vq_ + 2560); } o[0] = __builtin_amdgcn_mfma_f32_32x32x16_bf16(__builtin_bit_cast(bf16x8, PO##0), (bf16x8){vAl0[0], vAl0[1], vAl0[2], vAl0[3], vAh0[0], vAh0[1], vAh0[2], vAh0[3]}, o[0], 0, 0, 0); if constexpr (!(VAR & 2)) { mxa_ = MX3(N0[0], N0[1], N1[0]); mxb_ = MX3(N0[2], N0[3], N1[1]); mxa_ = MX3(mxa_, N1[2], N1[3]); mxa_ = MX3(mxa_, N0[4], N0[5]); mxb_ = MX3(mxb_, N0[6], N0[7]); mxa_ = MX3(mxa_, N1[4], N1[5]); mxb_ = MX3(mxb_, N1[6], N1[7]); PIN(mxa_); PIN(mxb_); } SBAR(); \
    if constexpr (!(VAR & 8)) { vBl1 = vtr(vq_ + 4608); vBh1 = vtr(vq_ + 6656); } o[0] = __builtin_amdgcn_mfma_f32_32x32x16_bf16(__builtin_bit_cast(bf16x8, PO##1), (bf16x8){vAl1[0], vAl1[1], vAl1[2], vAl1[3], vAh1[0], vAh1[1], vAh1[2], vAh1[3]}, o[0], 0, 0, 0); if constexpr (!(VAR & 2)) { mxa_ = MX3(mxa_, N0[8], N0[9]); mxb_ = MX3(mxb_, N0[10], N0[11]); mxa_ = MX3(mxa_, N1[8], N1[9]); mxb_ = MX3(mxb_, N1[10], N1[11]); mxa_ = MX3(mxa_, N0[12], N0[13]); mxb_ = MX3(mxb_, N0[14], N0[15]); mxa_ = MX3(mxa_, N1[12], N1[13]); mxb_ = MX3(mxb_, N1[14], N1[15]); PIN(mxa_); PIN(mxb_); } SBAR(); \
    if constexpr (!(VAR & 8)) { vBl2 = vtr(vq_ + 8704); vBh2 = vtr(vq_ + 10752); } o[0] = __builtin_amdgcn_mfma_f32_32x32x16_bf16(__builtin_bit_cast(bf16x8, PO##2), (bf16x8){vAl2[0], vAl2[1], vAl2[2], vAl2[3], vAh2[0], vAh2[1], vAh2[2], vAh2[3]}, o[0], 0, 0, 0); if constexpr (!(VAR & 2)) { rm_ = __builtin_fmaxf(mxa_, mxb_); { auto rr_ = __builtin_amdgcn_permlane32_swap(__float_as_uint(rm_), __float_as_uint(rm_), false, false); rm_ = __builtin_fmaxf(__uint_as_float(rr_[0]), __uint_as_float(rr_[1])); } alN_ = 1.f; if (__builtin_expect(!__all(rm_ <= THR), 0)) { const float dl_ = __builtin_fmaxf(rm_, 0.f); mhat += dl_; alN_ = __builtin_amdgcn_exp2f(-dl_); _Pragma("unroll") for (int r_ = 0; r_ < 16; ++r_) { N0[r_] -= dl_; N1[r_] -= dl_; negm16[r_] = -mhat; } } PIN(alN_); } SBAR(); \
    if constexpr (!(VAR & 8)) { vBl3 = vtr(vq_ + 12800); vBh3 = vtr(vq_ + 14848); } o[0] = __builtin_amdgcn_mfma_f32_32x32x16_bf16(__builtin_bit_cast(bf16x8, PO##3), (bf16x8){vAl3[0], vAl3[1], vAl3[2], vAl3[3], vAh3[0], vAh3[1], vAh3[2], vAh3[3]}, o[0], 0, 0, 0); if constexpr (!(VAR & 2)) { N0[0] = __builtin_amdgcn_exp2f(N0[0]); N0[1] = __builtin_amdgcn_exp2f(N0[1]); N0[2] = __builtin_amdgcn_exp2f(N0[2]); N0[3] = __builtin_amdgcn_exp2f(N0[3]); PIN(N0); } SBAR(); \
    if constexpr (!(VAR & 8)) { vAl0 = vtr(vq_ + 1024); vAh0 = vtr(vq_ + 3072); } o[1] = __builtin_amdgcn_mfma_f32_32x32x16_bf16(__builtin_bit_cast(bf16x8, PO##0), (bf16x8){vBl0[0], vBl0[1], vBl0[2], vBl0[3], vBh0[0], vBh0[1], vBh0[2], vBh0[3]}, o[1], 0, 0, 0); if constexpr (!(VAR & 2)) { N0[4] = __builtin_amdgcn_exp2f(N0[4]); N0[5] = __builtin_amdgcn_exp2f(N0[5]); N0[6] = __builtin_amdgcn_exp2f(N0[6]); N0[7] = __builtin_amdgcn_exp2f(N0[7]); PIN(N0); } SBAR(); \
    if constexpr (!(VAR & 8)) { vAl1 = vtr(vq_ + 5120); vAh1 = vtr(vq_ + 7168); } o[1] = __builtin_amdgcn_mfma_f32_32x32x16_bf16(__builtin_bit_cast(bf16x8, PO##1), (bf16x8){vBl1[0], vBl1[1], vBl1[2], vBl1[3], vBh1[0], vBh1[1], vBh1[2], vBh1[3]}, o[1], 0, 0, 0); if constexpr (!(VAR & 2)) { N0[8] = __builtin_amdgcn_exp2f(N0[8]); N0[9] = __builtin_amdgcn_exp2f(N0[9]); N0[10] = __builtin_amdgcn_exp2f(N0[10]); N0[11] = __builtin_amdgcn_exp2f(N0[11]); PIN(N0); } SBAR(); \
    if constexpr (!(VAR & 8)) { vAl2 = vtr(vq_ + 9216); vAh2 = vtr(vq_ + 11264); } o[1] = __builtin_amdgcn_mfma_f32_32x32x16_bf16(__builtin_bit_cast(bf16x8, PO##2), (bf16x8){vBl2[0], vBl2[1], vBl2[2], vBl2[3], vBh2[0], vBh2[1], vBh2[2], vBh2[3]}, o[1], 0, 0, 0); if constexpr (!(VAR & 2)) { N0[12] = __builtin_amdgcn_exp2f(N0[12]); N0[13] = __builtin_amdgcn_exp2f(N0[13]); N0[14] = __builtin_amdgcn_exp2f(N0[14]); N0[15] = __builtin_amdgcn_exp2f(N0[15]); PIN(N0); } SBAR(); \
    if constexpr (!(VAR & 8)) { vAl3 = vtr(vq_ + 13312); vAh3 = vtr(vq_ + 15360); } o[1] = __builtin_amdgcn_mfma_f32_32x32x16_bf16(__builtin_bit_cast(bf16x8, PO##3), (bf16x8){vBl3[0], vBl3[1], vBl3[2], vBl3[3], vBh3[0], vBh3[1], vBh3[2], vBh3[3]}, o[1], 0, 0, 0); if constexpr (!(VAR & 2)) { N1[0] = __builtin_amdgcn_exp2f(N1[0]); N1[1] = __builtin_amdgcn_exp2f(N1[1]); N1[2] = __builtin_amdgcn_exp2f(N1[2]); N1[3] = __builtin_amdgcn_exp2f(N1[3]); PIN(N1); } SBAR(); \
    if constexpr (!(VAR & 8)) { vBl0 = vtr(vq_ + 1536); vBh0 = vtr(vq_ + 3584); } o[2] = __builtin_amdgcn_mfma_f32_32x32x16_bf16(__builtin_bit_cast(bf16x8, PO##0), (bf16x8){vAl0[0], vAl0[1], vAl0[2], vAl0[3], vAh0[0], vAh0[1], vAh0[2], vAh0[3]}, o[2], 0, 0, 0); if constexpr (!(VAR & 2)) { N1[4] = __builtin_amdgcn_exp2f(N1[4]); N1[5] = __builtin_amdgcn_exp2f(N1[5]); N1[6] = __builtin_amdgcn_exp2f(N1[6]); N1[7] = __builtin_amdgcn_exp2f(N1[7]); PIN(N1); } SBAR(); \
    if constexpr (!(VAR & 8)) { vBl1 = vtr(vq_ + 5632); vBh1 = vtr(vq_ + 7680); } o[2] = __builtin_amdgcn_mfma_f32_32x32x16_bf16(__builtin_bit_cast(bf16x8, PO##1), (bf16x8){vAl1[0], vAl1[1], vAl1[2], vAl1[3], vAh1[0], vAh1[1], vAh1[2], vAh1[3]}, o[2], 0, 0, 0); if constexpr (!(VAR & 2)) { N1[8] = __builtin_amdgcn_exp2f(N1[8]); N1[9] = __builtin_amdgcn_exp2f(N1[9]); N1[10] = __builtin_amdgcn_exp2f(N1[10]); N1[11] = __builtin_amdgcn_exp2f(N1[11]); PIN(N1); } SBAR(); \
    if constexpr (!(VAR & 8)) { vBl2 = vtr(vq_ + 9728); vBh2 = vtr(vq_ + 11776); } o[2] = __builtin_amdgcn_mfma_f32_32x32x16_bf16(__builtin_bit_cast(bf16x8, PO##2), (bf16x8){vAl2[0], vAl2[1], vAl2[2], vAl2[3], vAh2[0], vAh2[1], vAh2[2], vAh2[3]}, o[2], 0, 0, 0); if constexpr (!(VAR & 2)) { N1[12] = __builtin_amdgcn_exp2f(N1[12]); N1[13] = __builtin_amdgcn_exp2f(N1[13]); N1[14] = __builtin_amdgcn_exp2f(N1[14]); N1[15] = __builtin_amdgcn_exp2f(N1[15]); PIN(N1); } SBAR(); \
    if constexpr (!(VAR & 8)) { vBl3 = vtr(vq_ + 13824); vBh3 = vtr(vq_ + 15872); } o[2] = __builtin_amdgcn_mfma_f32_32x32x16_bf16(__builtin_bit_cast(bf16x8, PO##3), (bf16x8){vAl3[0], vAl3[1], vAl3[2], vAl3[3], vAh3[0], vAh3[1], vAh3[2], vAh3[3]}, o[2], 0, 0, 0); if constexpr (!(VAR & 1)) { ca0 = cvtpk(N0[0], N0[1]); ca1 = cvtpk(N0[2], N0[3]); cb0 = cvtpk(N0[4], N0[5]); cb1 = cvtpk(N0[6], N0[7]); PN##0 = (u32x4){ca0, ca1, cb0, cb1}; PIN(PN##0); } SBAR(); \
     o[3] = __builtin_amdgcn_mfma_f32_32x32x16_bf16(__builtin_bit_cast(bf16x8, PO##0), (bf16x8){vBl0[0], vBl0[1], vBl0[2], vBl0[3], vBh0[0], vBh0[1], vBh0[2], vBh0[3]}, o[3], 0, 0, 0); osum = __builtin_amdgcn_mfma_f32_16x16x32_bf16(__builtin_bit_cast(bf16x8, PO##0), bsel, osum, 0, 0, 0); if constexpr (!(VAR & 1)) { ca0 = cvtpk(N0[8], N0[9]); ca1 = cvtpk(N0[10], N0[11]); cb0 = cvtpk(N0[12], N0[13]); cb1 = cvtpk(N0[14], N0[15]); PN##1 = (u32x4){ca0, ca1, cb0, cb1}; PIN(PN##1); } SBAR(); \
     o[3] = __builtin_amdgcn_mfma_f32_32x32x16_bf16(__builtin_bit_cast(bf16x8, PO##1), (bf16x8){vBl1[0], vBl1[1], vBl1[2], vBl1[3], vBh1[0], vBh1[1], vBh1[2], vBh1[3]}, o[3], 0, 0, 0); osum = __builtin_amdgcn_mfma_f32_16x16x32_bf16(__builtin_bit_cast(bf16x8, PO##1), bsel, osum, 0, 0, 0); if constexpr (!(VAR & 1)) { ca0 = cvtpk(N1[0], N1[1]); ca1 = cvtpk(N1[2], N1[3]); cb0 = cvtpk(N1[4], N1[5]); cb1 = cvtpk(N1[6], N1[7]); PN##2 = (u32x4){ca0, ca1, cb0, cb1}; PIN(PN##2); } SBAR(); \
     o[3] = __builtin_amdgcn_mfma_f32_32x32x16_bf16(__builtin_bit_cast(bf16x8, PO##2), (bf16x8){vBl2[0], vBl2[1], vBl2[2], vBl2[3], vBh2[0], vBh2[1], vBh2[2], vBh2[3]}, o[3], 0, 0, 0); osum = __builtin_amdgcn_mfma_f32_16x16x32_bf16(__builtin_bit_cast(bf16x8, PO##2), bsel, osum, 0, 0, 0); if constexpr (!(VAR & 1)) { ca0 = cvtpk(N1[8], N1[9]); ca1 = cvtpk(N1[10], N1[11]); cb0 = cvtpk(N1[12], N1[13]); cb1 = cvtpk(N1[14], N1[15]); PN##3 = (u32x4){ca0, ca1, cb0, cb1}; PIN(PN##3); } SBAR(); \
     o[3] = __builtin_amdgcn_mfma_f32_32x32x16_bf16(__builtin_bit_cast(bf16x8, PO##3), (bf16x8){vBl3[0], vBl3[1], vBl3[2], vBl3[3], vBh3[0], vBh3[1], vBh3[2], vBh3[3]}, o[3], 0, 0, 0); osum = __builtin_amdgcn_mfma_f32_16x16x32_bf16(__builtin_bit_cast(bf16x8, PO##3), bsel, osum, 0, 0, 0);  SBAR(); \
    if constexpr (VAR & 2) { alN_ = 1.f; asm volatile("" :: "v"(N0), "v"(N1)); } \
    RESC(alN_); \
    if constexpr (VAR & 4) WAIT_BAR(0); else { if ((j) + 2 < NT) WAIT_BAR(1); else WAIT_BAR(0); } \
    { const int t_ = kf; kf = kc; kc = (kc == 2 * SHM_K) ? 0 : kc + SHM_K; (void)t_; } \
    { const int t_ = vf; vf = vp; vp = t_; } } while (0)
  for (int r = 0; r < 16; ++r) pA1[r] = __builtin_amdgcn_exp2f(pA1[r]);
#define PK4W(P, BASE, OUT) OUT = (u32x4){cvtpk(P[BASE + 0], P[BASE + 1]), cvtpk(P[BASE + 2], P[BASE + 3]), cvtpk(P[BASE + 4], P[BASE + 5]), cvtpk(P[BASE + 6], P[BASE + 7])}
  PK4W(pA0, 0, pwA0); PK4W(pA0, 8, pwA1); PK4W(pA1, 0, pwA2); PK4W(pA1, 8, pwA3);
#undef PK4W
#define N0 pA0
#define N1 pA1
  for (int j = 1; j + 1 < NT; j += 2) {
    STEP3(pwA, pwB, j);
    STEP3(pwB, pwA, j + 1);
  }
  STEP3(pwA, pwB, NT - 1);
#undef N0
#undef N1
  if constexpr (!CMB && !(VAR & 4)) {
    const bf16* kn_ = Kh + 64;
    GLDS_K(kn_, kvo, (unsigned)__builtin_amdgcn_readfirstlane(kdst));
    { const char* vb_ = (const char*)Vh; const char* vbm_ = vb_ - 896; GLDS_V2(vb_, vbm_, vvo, (unsigned)__builtin_amdgcn_readfirstlane(vdst)); }
    { const bf16* k1_ = kn_ + (long)KVBLK * LD; GLDS_K(k1_, kvo, (unsigned)__builtin_amdgcn_readfirstlane(kdst + SHM_K)); } }
  {
    pa0 = __builtin_bit_cast(bf16x8, pwB0); pa1 = __builtin_bit_cast(bf16x8, pwB1); pa2 = __builtin_bit_cast(bf16x8, pwB2); pa3 = __builtin_bit_cast(bf16x8, pwB3);
    SBAR(); pv_d0(o, vb0 + vp, pa0, pa1, pa2, pa3);
    osum = __builtin_amdgcn_mfma_f32_16x16x32_bf16(pa0, bsel, osum, 0, 0, 0); osum = __builtin_amdgcn_mfma_f32_16x16x32_bf16(pa1, bsel, osum, 0, 0, 0);
    osum = __builtin_amdgcn_mfma_f32_16x16x32_bf16(pa2, bsel, osum, 0, 0, 0); osum = __builtin_amdgcn_mfma_f32_16x16x32_bf16(pa3, bsel, osum, 0, 0, 0); }
#undef MX3
#undef PIN
  if ((lane & 7) == 0) *(f32x4*)(li_l + osrow) = osum;
  unsigned short* keep = (unsigned short*)(lds + R_KEEP) + wid * 32 * OST_PITCH;
  u32x4 a0[8]; float gs8[8];
  if constexpr (CMB) {
#pragma unroll
    for (int i = 0; i < 8; ++i) a0[i] = *(const u32x4*)(keep + (i * 4 + (lane >> 4)) * OST_PITCH + (lane & 15) * 8);
#pragma unroll
    for (int i = 0; i < 8; ++i) gs8[i] = gsub[(lane & 15) * 8 + i] * ONE_M_LAM_INIT;
    WAIT_BAR(0);
  } else asm volatile("s_waitcnt lgkmcnt(0)" ::: "memory");
  float rli[16];
#pragma unroll
  for (int r = 0; r < 16; ++r) rli[r] = __builtin_amdgcn_rcpf(li_l[crow(r, hi)]);
  unsigned short* stg = CMB ? (unsigned short*)lds + wid * 32 * OST_PITCH : keep;
#pragma unroll
  for (int r = 0; r < 16; ++r) { const int orow = crow(r, hi);
#pragma unroll
    for (int d0 = 0; d0 < 4; ++d0) stg[orow * OST_PITCH + d0 * 32 + r32] = (unsigned short)f2bf(o[d0][r] * rli[r]); }
  asm volatile("s_waitcnt lgkmcnt(0)" ::: "memory");
  if constexpr (CMB) {
  bf16* Ow = Ob + (long)(wid * QBLK) * LD;
#pragma unroll
  for (int i = 0; i < 8; ++i) { const int row = i * 4 + (lane >> 4), ch = lane & 15; u32x4 v = *(const u32x4*)(stg + row * OST_PITCH + ch * 8);
    if constexpr (CMB) { const u32x4 a = a0[i];
      float d[8] = {bf_lo_(a.x) - lam * bf_lo_(v.x), bf_hi_(a.x) - lam * bf_hi_(v.x), bf_lo_(a.y) - lam * bf_lo_(v.y), bf_hi_(a.y) - lam * bf_hi_(v.y),
                    bf_lo_(a.z) - lam * bf_lo_(v.z), bf_hi_(a.z) - lam * bf_hi_(v.z), bf_lo_(a.w) - lam * bf_lo_(v.w), bf_hi_(a.w) - lam * bf_hi_(v.w)};
      float ss = (d[0] * d[0] + d[1] * d[1]) + (d[2] * d[2] + d[3] * d[3]) + (d[4] * d[4] + d[5] * d[5]) + (d[6] * d[6] + d[7] * d[7]);
      ss += __shfl_xor(ss, 1); ss += __shfl_xor(ss, 2); ss += __shfl_xor(ss, 4); ss += __shfl_xor(ss, 8);
      const float rr = rsqrtf(ss * (1.f / 128.f) + EPS);
      v.x = f2bf(d[0] * rr * gs8[0]) | (f2bf(d[1] * rr * gs8[1]) << 16); v.y = f2bf(d[2] * rr * gs8[2]) | (f2bf(d[3] * rr * gs8[3]) << 16);
      v.z = f2bf(d[4] * rr * gs8[4]) | (f2bf(d[5] * rr * gs8[5]) << 16); v.w = f2bf(d[6] * rr * gs8[6]) | (f2bf(d[7] * rr * gs8[7]) << 16); }
    *(u32x4*)(Ow + (long)row * LD + ch * 8) = v; }
  }
  WAIT_BAR(0);
#undef DMA_K
#undef DMA_V
#undef DMA_KV
#undef RESC
#undef STEP
#undef STEP3
}
#undef WAIT_BAR
#undef KSWZ
#undef SBAR
}

#define RLX_AGENT __ATOMIC_RELAXED, __HIP_MEMORY_SCOPE_AGENT
#define XB_TMO      128
#define XB_XCNT(j)  (256  + 64 * (j))
#define XB_XSUB(j)  (1280 + 64 * (j))
#define XB_XGEN(j)  (2304 + 64 * (j))
#define XB_TOP      3328
#define XB_TOPGEN   3392
#define XCD_BAR_WORDS 3456
#define XB_SPIN_CAP (1u << 18)

__device__ __forceinline__ unsigned xb_ld(unsigned* p)              { return __hip_atomic_load(p, __ATOMIC_RELAXED, __HIP_MEMORY_SCOPE_AGENT); }
__device__ __forceinline__ unsigned xb_add(unsigned* p, unsigned v) { return __hip_atomic_fetch_add(p, v, __ATOMIC_RELAXED, __HIP_MEMORY_SCOPE_AGENT); }
__device__ __forceinline__ unsigned xb_xcc_id() { return (unsigned)__builtin_amdgcn_s_getreg((3 << 11) | 20) & 0xFu; }
#define XB_SPIN(cond, bar) do { unsigned _sp = 0; while (cond) { __builtin_amdgcn_s_sleep(1); \
    if ((++_sp & 255u) == 0u) { if (xb_ld(&(bar)[XB_TMO])) break; if (_sp > XB_SPIN_CAP) { atomicAdd(&(bar)[XB_TMO], 1u); break; } } } } while (0)

struct XcdBarrier {
    unsigned* bar; unsigned x;
    volatile LAS unsigned* st;
};

__device__ __forceinline__ XcdBarrier xcd_barrier_post(unsigned* bar, volatile LAS unsigned* st) {
    XcdBarrier b; b.bar = bar; b.x = xb_xcc_id(); b.st = st;
    if (threadIdx.x == 0) (void)xb_add(&bar[XB_XCNT(b.x)], 1u);
    return b;
}
__device__ __forceinline__ void xcd_barrier_complete(unsigned* bar, unsigned x, unsigned& nloc, unsigned& nx) {
    const unsigned G = gridDim.x * gridDim.y * gridDim.z;
    unsigned sum, cnt, mine, sp = 0u;
    for (;;) {
        sum = 0u; cnt = 0u; mine = 0u;
#pragma unroll
        for (unsigned j = 0; j < 16; ++j) { const unsigned c = xb_ld(&bar[XB_XCNT(j)]); sum += c; cnt += (c > 0u) ? 1u : 0u; mine = (j == x) ? c : mine; }
        if (sum == G) break;
        __builtin_amdgcn_s_sleep(1);
        if ((++sp & 255u) == 0u) { if (xb_ld(&bar[XB_TMO])) break; if (sp > XB_SPIN_CAP) { atomicAdd(&bar[XB_TMO], 1u); break; } }
    }
    nloc = mine > 0u ? mine : 1u; nx = cnt > 0u ? cnt : 1u;
}

__device__ __forceinline__ void xcd_barrier(const XcdBarrier& b) {
    asm volatile("s_waitcnt vmcnt(0)" ::: "memory");
    __syncthreads();
    if (threadIdx.x == 0) {
        unsigned* bar = b.bar;
        __builtin_amdgcn_s_waitcnt(0);
        unsigned nloc = b.st[0], nx = b.st[1];
        if (nloc == 0u) { xcd_barrier_complete(bar, b.x, nloc, nx); b.st[0] = nloc; b.st[1] = nx; }
        const unsigned old = xb_add(&bar[XB_XSUB(b.x)], 1u);
        const unsigned gen = old / nloc;
        if (old + 1u == (gen + 1u) * nloc) {
            __builtin_amdgcn_fence(__ATOMIC_RELEASE, "agent");
            asm volatile("s_waitcnt vmcnt(0)" ::: "memory");
            const unsigned og = xb_add(&bar[XB_TOP], 1u);
            const unsigned tg = og / nx;
            if (og + 1u == (tg + 1u) * nx) xb_add(&bar[XB_TOPGEN], 1u);
            else XB_SPIN(xb_ld(&bar[XB_TOPGEN]) == tg, bar);
            __builtin_amdgcn_fence(__ATOMIC_ACQUIRE, "agent");
            xb_add(&bar[XB_XGEN(b.x)], 1u);
            asm volatile("s_waitcnt vmcnt(0)" ::: "memory");
        } else {
            XB_SPIN(xb_ld(&bar[XB_XGEN(b.x)]) == gen, bar);
            __builtin_amdgcn_fence(__ATOMIC_ACQUIRE, "agent");
            asm volatile("s_waitcnt vmcnt(0)" ::: "memory");
        }
    }
    __syncthreads();
}

__global__ void __launch_bounds__(512) k_pool_only(Params P) { ph_pool(P, blockIdx.x * 8 + (threadIdx.x >> 6), gridDim.x * 8, threadIdx.x & 63); }
template <class Epi> __global__ void __launch_bounds__(256) k_gemm_naive(const bf16* A, const bf16* Bt, int K, Epi epi) {
    __shared__ float As[64][33], Bs[64][33];
    const int tid = threadIdx.x, tx = tid & 15, ty = tid >> 4, gz = blockIdx.z;
    const size_t arow0 = (size_t)epi.a_row0(gz) + blockIdx.y * 64, brow0 = (size_t)epi.b_row0(gz) + blockIdx.x * 64;
    float acc[4][4];
#pragma unroll
    for (int i = 0; i < 4; ++i)
#pragma unroll
        for (int j = 0; j < 4; ++j) acc[i][j] = 0.f;
    const int lr = tid >> 2, lc = (tid & 3) * 8;
    for (int k0 = 0; k0 < K; k0 += 32) {
        const v4u a = *(const v4u*)(A + (arow0 + lr) * K + k0 + lc), b = *(const v4u*)(Bt + (brow0 + lr) * K + k0 + lc);
        As[lr][lc + 0] = bf_lo(a.x); As[lr][lc + 1] = bf_hi(a.x); As[lr][lc + 2] = bf_lo(a.y); As[lr][lc + 3] = bf_hi(a.y); As[lr][lc + 4] = bf_lo(a.z); As[lr][lc + 5] = bf_hi(a.z); As[lr][lc + 6] = bf_lo(a.w); As[lr][lc + 7] = bf_hi(a.w);
        Bs[lr][lc + 0] = bf_lo(b.x); Bs[lr][lc + 1] = bf_hi(b.x); Bs[lr][lc + 2] = bf_lo(b.y); Bs[lr][lc + 3] = bf_hi(b.y); Bs[lr][lc + 4] = bf_lo(b.z); Bs[lr][lc + 5] = bf_hi(b.z); Bs[lr][lc + 6] = bf_lo(b.w); Bs[lr][lc + 7] = bf_hi(b.w);
        __syncthreads();
#pragma unroll 8
        for (int k = 0; k < 32; ++k) { float av[4], bv[4];
#pragma unroll
            for (int i = 0; i < 4; ++i) { av[i] = As[ty * 4 + i][k]; bv[i] = Bs[tx * 4 + i][k]; }
#pragma unroll
            for (int i = 0; i < 4; ++i)
#pragma unroll
                for (int j = 0; j < 4; ++j) acc[i][j] += av[i] * bv[j]; }
        __syncthreads();
    }
#pragma unroll
    for (int i = 0; i < 4; ++i)
#pragma unroll
        for (int j = 0; j < 4; ++j) epi(gz, blockIdx.y * 64 + ty * 4 + i, blockIdx.x * 64 + tx * 4 + j, acc[i][j]);
}
struct NEpiIn { unsigned char* ws;
    __device__ int a_row0(int) const { return 0; } __device__ int b_row0(int) const { return 0; }
    __device__ void operator()(int, int r, int c, float z) const { z *= ((const float*)(ws + WS_RSTD))[r];
        if (c < 1024) ((bf16*)(ws + WS_U))[(size_t)r * D + c] = (bf16)f2bf(z);
        else if (c < 3072) ((float*)(ws + WS_QKF))[(size_t)r * 2048 + (c - 1024)] = z;
        else if (c < 4096) ((bf16*)(ws + WS_V))[(size_t)r * D + c - 3072] = (bf16)f2bf(z);
        else if (c < 5120) (ws + WS_GP)[(size_t)r * D + c - 4096] = (unsigned char)(sigmoidf_(z) * 255.f + 0.5f);
        else (ws + WS_GA)[(size_t)r * D + c - 5120] = (unsigned char)(sigmoidf_(z) * 255.f + 0.5f);
    } };
__global__ void __launch_bounds__(256) k_rope_naive(Params P) {
    const float* QKF = (const float*)(P.ws + WS_QKF); const float* cs = (const float*)(P.ws + WS_ROPE); bf16* Q = (bf16*)(P.ws + WS_Q); bf16* K = (bf16*)(P.ws + WS_K);
    for (size_t i = (size_t)blockIdx.x * 256 + threadIdx.x; i < (size_t)T * 2048; i += (size_t)gridDim.x * 256) { const int t = (int)(i >> 11), c = (int)(i & 2047), d = c & 63;
        float z = QKF[i];
        if (d < 8) z = z * cs[t * 16 + d] - QKF[i + 8] * cs[t * 16 + 8 + d];
        else if (d < 16) z = z * cs[t * 16 + d - 8] + QKF[i - 8] * cs[t * 16 + 8 + d - 8];
        if (c < 1024) Q[(size_t)t * D + c] = (bf16)f2bf(z * C2); else K[(size_t)t * D + c - 1024] = (bf16)f2bf(z); }
}
struct NEpiGate1 { unsigned char* ws;
    __device__ int a_row0(int) const { return 0; } __device__ int b_row0(int) const { return 0; }
    __device__ void operator()(int, int r, int c, float z) const { const size_t i = (size_t)r * D + c; ((bf16*)(ws + WS_MG))[i] = (bf16)f2bf((float)(ws + WS_GP)[i] * (1.f / 255.f) * z); } };
struct NEpiGate2 { unsigned char* ws;
    __device__ int a_row0(int) const { return 0; } __device__ int b_row0(int) const { return 0; }
    __device__ void operator()(int, int r, int c, float z) const { const size_t i = (size_t)r * D + c; bf16* mg = (bf16*)(ws + WS_MG); mg[i] = (bf16)f2bf(bf2f(mg[i]) + (float)(ws + WS_GA)[i] * (1.f / 255.f) * z); } };
struct NEpiRes { const float* x; unsigned char* ws;
    __device__ int a_row0(int) const { return 0; } __device__ int b_row0(int) const { return 0; }
    __device__ void operator()(int, int r, int c, float z) const { const size_t i = (size_t)r * D + c; ((bf16*)(ws + WS_X2))[i] = (bf16)f2bf(x[i] + z); } };
__global__ void __launch_bounds__(256) k_up_naive(Params P) {
    __shared__ float As[64][33], Bg[64][33], Bu[64][33];
    const bf16* XS = (const bf16*)(P.ws + WS_XS); const bf16* W13 = (const bf16*)(P.ws + WS_W13); bf16* ACT = (bf16*)(P.ws + WS_ACT);
    const int tid = threadIdx.x, tx = tid & 15, ty = tid >> 4, gz = blockIdx.z, e = gz & 15;
    const size_t arow0 = (size_t)gz * CAP + blockIdx.y * 64; const int f0 = blockIdx.x * 64;
    const size_t grow0 = (size_t)e * 5632 + (f0 >> 7) * 256 + (f0 & 127), urow0 = grow0 + 128;
    float ag[4][4], au[4][4];
#pragma unroll
    for (int i = 0; i < 4; ++i)
#pragma unroll
        for (int j = 0; j < 4; ++j) { ag[i][j] = 0.f; au[i][j] = 0.f; }
    const int lr = tid >> 2, lc = (tid & 3) * 8;
    for (int k0 = 0; k0 < D; k0 += 32) {
        const v4u a = *(const v4u*)(XS + (arow0 + lr) * D + k0 + lc), g = *(const v4u*)(W13 + (grow0 + lr) * D + k0 + lc), u = *(const v4u*)(W13 + (urow0 + lr) * D + k0 + lc);
        As[lr][lc + 0] = bf_lo(a.x); As[lr][lc + 1] = bf_hi(a.x); As[lr][lc + 2] = bf_lo(a.y); As[lr][lc + 3] = bf_hi(a.y); As[lr][lc + 4] = bf_lo(a.z); As[lr][lc + 5] = bf_hi(a.z); As[lr][lc + 6] = bf_lo(a.w); As[lr][lc + 7] = bf_hi(a.w);
        Bg[lr][lc + 0] = bf_lo(g.x); Bg[lr][lc + 1] = bf_hi(g.x); Bg[lr][lc + 2] = bf_lo(g.y); Bg[lr][lc + 3] = bf_hi(g.y); Bg[lr][lc + 4] = bf_lo(g.z); Bg[lr][lc + 5] = bf_hi(g.z); Bg[lr][lc + 6] = bf_lo(g.w); Bg[lr][lc + 7] = bf_hi(g.w);
        Bu[lr][lc + 0] = bf_lo(u.x); Bu[lr][lc + 1] = bf_hi(u.x); Bu[lr][lc + 2] = bf_lo(u.y); Bu[lr][lc + 3] = bf_hi(u.y); Bu[lr][lc + 4] = bf_lo(u.z); Bu[lr][lc + 5] = bf_hi(u.z); Bu[lr][lc + 6] = bf_lo(u.w); Bu[lr][lc + 7] = bf_hi(u.w);
        __syncthreads();
#pragma unroll 4
        for (int k = 0; k < 32; ++k) { float av[4], gv[4], uv[4];
#pragma unroll
            for (int i = 0; i < 4; ++i) { av[i] = As[ty * 4 + i][k]; gv[i] = Bg[tx * 4 + i][k]; uv[i] = Bu[tx * 4 + i][k]; }
#pragma unroll
            for (int i = 0; i < 4; ++i)
#pragma unroll
                for (int j = 0; j < 4; ++j) { ag[i][j] += av[i] * gv[j]; au[i][j] += av[i] * uv[j]; } }
        __syncthreads();
    }
#pragma unroll
    for (int i = 0; i < 4; ++i)
#pragma unroll
        for (int j = 0; j < 4; ++j) { const float g = ag[i][j]; ACT[(arow0 + ty * 4 + i) * FF + f0 + tx * 4 + j] = (bf16)f2bf(g * sigmoidf_(g) * au[i][j]); }
}
struct NEpiDown { unsigned char* ws;
    __device__ int a_row0(int gz) const { return gz * CAP; } __device__ int b_row0(int gz) const { return (gz & 15) * D; }
    __device__ void operator()(int gz, int r, int c, float z) const { const size_t row = (size_t)gz * CAP + r; (ws + WS_Y)[row * D + c] = (unsigned char)(pk4_fp8(z * ((const float*)(ws + WS_SELV))[row] * Y8_SCALE, 0.f, 0.f, 0.f) & 0xffu); } };

__global__ void __launch_bounds__(256) k_attn_naive(Params P) {
    __shared__ __attribute__((aligned(16))) bf16 qs[4][128];
    __shared__ float ps[4][64][2];
    const bf16* Q = (const bf16*)(P.ws + WS_Q); const bf16* K = (const bf16*)(P.ws + WS_K); const bf16* V = (const bf16*)(P.ws + WS_V);
    bf16* O0 = (bf16*)(P.ws + WS_OV); bf16* O1 = O0 + (size_t)T * D;
    const int lane = threadIdx.x & 63, wave = threadIdx.x >> 6;
    const int item = blockIdx.x * 4 + wave, t = item >> 3, h = item & 7, b0 = t & ~(SEQ - 1);
    ((unsigned*)qs[wave])[lane] = ((const unsigned*)(Q + (size_t)t * D + h * 128))[lane];
    __syncthreads();
    auto score = [&](int key, float& s0, float& s1) {
        const v4u* kr = (const v4u*)(K + (size_t)(b0 + key) * D + h * 128); const v4u* qr = (const v4u*)qs[wave];
        float a0 = 0.f, a1 = 0.f;
#pragma unroll
        for (int ch = 0; ch < 16; ++ch) { const v4u kv = kr[ch], qv = qr[ch];
            const float d = bf_lo(kv.x) * bf_lo(qv.x) + bf_hi(kv.x) * bf_hi(qv.x) + bf_lo(kv.y) * bf_lo(qv.y) + bf_hi(kv.y) * bf_hi(qv.y) + bf_lo(kv.z) * bf_lo(qv.z) + bf_hi(kv.z) * bf_hi(qv.z) + bf_lo(kv.w) * bf_lo(qv.w) + bf_hi(kv.w) * bf_hi(qv.w);
            if (ch < 8) a0 += d; else a1 += d; }
        s0 = a0; s1 = a1; };
    float m0 = -1e30f, m1 = -1e30f, l0 = 0.f, l1 = 0.f;
    for (int c = 0; c < SEQ / 64; ++c) { float s0, s1; score(c * 64 + lane, s0, s1);
        const float n0 = fmaxf(m0, s0), n1 = fmaxf(m1, s1);
        l0 = l0 * exp2f(m0 - n0) + exp2f(s0 - n0); l1 = l1 * exp2f(m1 - n1) + exp2f(s1 - n1); m0 = n0; m1 = n1; }
    const float M0 = wave_max(m0), M1 = wave_max(m1);
    const float L0 = wave_sum(l0 * exp2f(m0 - M0)), L1 = wave_sum(l1 * exp2f(m1 - M1));
    float a00 = 0.f, a01 = 0.f, a10 = 0.f, a11 = 0.f;
    for (int c = 0; c < SEQ / 64; ++c) { float s0, s1; score(c * 64 + lane, s0, s1);
        ps[wave][lane][0] = exp2f(s0 - M0); ps[wave][lane][1] = exp2f(s1 - M1);
        __syncthreads();
        for (int j = 0; j < 64; ++j) { const unsigned vv = ((const unsigned*)(V + (size_t)(b0 + c * 64 + j) * D + h * 128))[lane];
            const float p0 = ps[wave][j][0], p1 = ps[wave][j][1];
            a00 += p0 * bf_lo(vv); a01 += p0 * bf_hi(vv); a10 += p1 * bf_lo(vv); a11 += p1 * bf_hi(vv); }
        __syncthreads(); }
    ((unsigned*)(O0 + (size_t)t * D + h * 128))[lane] = pk2(a00 / L0, a01 / L0);
    ((unsigned*)(O1 + (size_t)t * D + h * 128))[lane] = pk2(a10 / L1, a11 / L1);
}


#ifndef MK_FUSED
#define MK_FUSED 1
#endif
#ifndef PROBE_RLO
#define PROBE_RLO -1
#define PROBE_RHI -1
#endif
#ifndef IN_NA
#define IN_NA 3
#endif
#ifndef PROBE_VAR
#define PROBE_VAR 0
#endif
#ifndef PROBE_PARTS
#define PROBE_PARTS 63
#endif
#ifndef NAIVE_MASK
#define NAIVE_MASK 0
#endif
constexpr int NWAVES = 8, NPH = 11;
constexpr int RING_BYTES = 131072, LDSCTL_OFF = RING_BYTES, MISC_OFF = LDSCTL_OFF + 320, LDS_BYTES = 147456;
constexpr int CW_BAR = 4096;
typedef GAS unsigned gu32;

struct Args { Params P; int ph_lo, ph_hi, parts, pad; };
__global__ void __launch_bounds__(NWAVES * 64, 2) mega(Args args) {
    extern __shared__ __attribute__((aligned(16))) unsigned char lds[];
    const Params& P = args.P;
    LAS unsigned char* L = (LAS unsigned char*)lds;
    const int tid = threadIdx.x, lane = tid & 63, wave = __builtin_amdgcn_readfirstlane(tid >> 6);
    const int G = gridDim.x, bx = blockIdx.x, vcu = (G % 8 == 0) ? (bx % 8) * (G / 8) + bx / 8 : bx;
    const int gw = vcu * NWAVES + wave, ngw = G * NWAVES, gtid = vcu * (NWAVES * 64) + tid, ngt = G * NWAVES * 64;
    for (int u = tid; u < (LDS_BYTES - LDSCTL_OFF) / 4; u += NWAVES * 64) ((LAS unsigned*)(L + LDSCTL_OFF))[u] = 0u;
    __syncthreads();
    unsigned* ctl = (unsigned*)(P.ws + WS_CTL);
    XcdBarrier bar; bar.bar = ctl + CW_BAR; bar.x = 0; bar.st = nullptr;
    const int lo = args.ph_lo, hi = args.ph_hi;
    if (hi - lo > 1) bar = xcd_barrier_post(ctl + CW_BAR, (volatile LAS unsigned*)(L + MISC_OFF) + 8);
#define IN(k) (lo <= (k) && (k) < hi)
#define SEAM(k) do { if (IN(k) && IN((k) + 1)) xcd_barrier(bar); } while (0)
    unsigned char* ws = P.ws;

    if (IN(0)) { const int parts = args.parts; if (parts & 1) ph_weights(P, WT_FP8_PAIRS, WT_ALL_PAIRS, gw, ngw, lane, (LAS float*)(L + wave * 16384));     if (parts & 2) ph_rms_x(P, gw, ngw, lane); if (parts & 4) ph_rope(P, gtid, ngt); if (parts & 8) ph_wcomb(P, gtid, ngt); }
    SEAM(0);
    if (IN(1)) { const int xg = vcu >> 5, l = vcu & 31, roleA = l & 1, li = l >> 1;
        if (roleA) { ph_weights(P, 0, WT_FP8_PAIRS, (xg * 16 + li) * NWAVES + wave, 128 * NWAVES, lane, (LAS float*)(L + wave * 16384)); asm volatile("s_waitcnt vmcnt(0) lgkmcnt(0)" ::: "memory"); __syncthreads(); }
        pg8::Gemm g{(const bf16*)(ws + WS_XB), (const bf16*)(ws + WS_WIN), T, INC, D}; pg8::InOrder S{__builtin_amdgcn_readfirstlane(8 * xg), __builtin_amdgcn_readfirstlane(roleA ? 16 * (12 - IN_NA) + li : li), __builtin_amdgcn_readfirstlane(roleA ? IN_NA : 12 - IN_NA)};
        pg8::EpiIn E{ws, (const float*)(ws + WS_ROPE)};
        pg8::gemm_phase<pg8::EpiIn, pg8::InOrder, true, true>(L, g, S, E); }
    SEAM(1);
    if (IN(2)) { if (args.parts & 16) ph_pool(P, gw, ngw, lane);
        const bf16* Q = (const bf16*)(ws + WS_Q); const bf16* K = (const bf16*)(ws + WS_K); const bf16* V = (const bf16*)(ws + WS_V); bf16* OV = (bf16*)(ws + WS_OV);
        const int g = vcu >> 3, b = g >> 3, h = g & 7;
        const size_t rb = (size_t)b * SEQ * D;
        const float lam = lam_value(P, lane);
        if (args.parts & 32) for (int i = 0; i < 2; ++i) { const int qb = (vcu & 7) * 2 + i; const size_t q0 = (size_t)(qb * 256) * D;
            { const bf16* k_ = K + rb + h * 128; const bf16* v_ = V + rb + h * 128; const bf16* q_ = Q + rb + q0 + h * 128; bf16* o0_ = OV + rb + q0 + h * 128; bf16* oc_ = (bf16*)(ws + WS_O) + rb + q0 + h * 128;
#if PROBE_VAR
              if (args.parts & 64) { attn2::attn_unit<PROBE_VAR, 0>(q_, k_, v_, o0_, (char*)lds); attn2::attn_unit<PROBE_VAR, 1>(q_ + 64, k_ + 64, v_, oc_, (char*)lds, o0_, lam, P.g_sub); } else
#endif
              { attn2::attn_unit<0, 0>(q_, k_, v_, o0_, (char*)lds);
                attn2::attn_unit<0, 1>(q_ + 64, k_ + 64, v_, oc_, (char*)lds, o0_, lam, P.g_sub); } } } }
    SEAM(2);
    if (IN(4)) { pg8::MergeOrder S; S.so.init(T, D, G, bx); S.A0 = (const char*)(ws + WS_PD); S.A1 = (const char*)(ws + WS_O); S.B0 = (const char*)(ws + WS_WCOMB); S.B1 = (const char*)(ws + WS_WAO); S.tstep = (size_t)256 * D * 2;
        pg8::Gemm g{(const bf16*)(ws + WS_PD), (const bf16*)(ws + WS_WCOMB), T, D, D}; pg8::EpiMerge E{{}, ws + WS_GP, ws + WS_GA, (bf16*)(ws + WS_MG)};
        pg8::gemm_phase<pg8::EpiMerge, pg8::MergeOrder, true, true>(L, g, S, E); }
    SEAM(4);
    if (IN(5)) { pg8::Gemm g{(const bf16*)(ws + WS_MG), (const bf16*)(ws + WS_WOUT), T, D, D}; pg8::StaticOrder S; S.init(T, D, G, bx);
        pg8::EpiRes E{(const pg8::bf16_t*)(ws + WS_XB), (pg8::bf16_t*)(ws + WS_X2)};
        pg8::gemm_phase<pg8::EpiRes, pg8::StaticOrder, true, true>(L, g, S, E);
        if (IN(6)) ph_router_fill(P, tid, (LAS float*)L); }
    SEAM(5);
    if (IN(6)) { if (!IN(5)) ph_router_fill(P, tid, (LAS float*)L); ph_router(P, vcu, G, tid, NWAVES * 64, (LAS float*)L); __syncthreads(); }
    SEAM(6);
    if (IN(7)) { ph_topk(P, vcu, G, tid, (LAS unsigned*)L); __syncthreads(); }
    SEAM(7);
    if (IN(8)) { LAS int* lidx = (LAS int*)(L + LDSCTL_OFF + 1024);
        pg8::UpOrder S{vcu >> 5, vcu & 31, (const PG8_LAS int*)lidx};
        { const int* SELI = (const int*)(ws + WS_SELI);
          int tv[6];
#pragma unroll
          for (int k = 0; k < 6; ++k) { const int en = tid + 512 * k; tv[k] = 0; if (en < 11 * 256) { pg8::Unit u; S.next(en >> 8, u); const int li = u.pm >> 1; tv[k] = (li >> 4) * SEQ + SELI[li * CAP + (u.pm & 1) * 256 + (en & 255)]; } }
#pragma unroll
          for (int k = 0; k < 6; ++k) { const int en = tid + 512 * k; if (en < 11 * 256) lidx[en] = tv[k]; }
          __syncthreads(); }
        pg8::Gemm g{(const bf16*)(ws + WS_H2), (const bf16*)(ws + WS_W13), NSEL, NE * 5632, D / 2};
        pg8::EpiUp E{ws + WS_ACT};
        pg8::gemm_phase<pg8::EpiUp, pg8::UpOrder, true, true, true>(L, g, S, E); }
    SEAM(8);
    if (IN(9)) { pg8::Gemm g{(const bf16*)(ws + WS_ACT), (const bf16*)(ws + WS_WD), NSEL, NE * D, FF / 2}; pg8::DownOrder S{vcu >> 5, vcu & 31};
        pg8::EpiDown E{ws + WS_Y, (const float*)(ws + WS_SELV)};
        pg8::gemm_phase<pg8::EpiDown, pg8::DownOrder, true, true, true>(L, g, S, E); }
    SEAM(9);
    if (IN(10)) ph_final(P, gw, ngw, lane);
#undef IN
#undef SEAM
}

extern "C" void kernel_launch(void* const* d_in, const int* in_sizes, int n_in, void* d_out, int out_size, void* d_ws, size_t ws_size, hipStream_t stream) {
    static int grid = 0;
    if (grid == 0) {
        if (n_in != 20 || in_sizes[0] != T * D || out_size != T * D || ws_size < WS_END) { fprintf(stderr, "kernel_launch: unexpected shapes (n_in %d, in0 %d, out %d, ws %zu, need %zu)\n", n_in, n_in > 0 ? in_sizes[0] : -1, out_size, ws_size, (size_t)WS_END); grid = -1; return; }
        int dev = 0, cus = 0;
        if (hipGetDevice(&dev) != hipSuccess || hipDeviceGetAttribute(&cus, hipDeviceAttributeMultiprocessorCount, dev) != hipSuccess) { grid = -1; return; }
        if (hipFuncSetAttribute((const void*)mega, hipFuncAttributeMaxDynamicSharedMemorySize, LDS_BYTES) != hipSuccess) { fprintf(stderr, "kernel_launch: hipFuncSetAttribute failed\n"); grid = -1; return; }
        if (cus != 256) { fprintf(stderr, "kernel_launch: built for a 256-CU device, found %d\n", cus); grid = -1; return; }
        grid = cus;
    }
    if (grid < 0) return;
    Args a{}; a.parts = 63;
    Params& P = a.P;
    P.x = (const float*)d_in[0]; P.pos = (const int*)d_in[1]; P.g_mix = (const float*)d_in[2]; P.w_in = (const float*)d_in[3]; P.w_pmix = (const float*)d_in[4]; P.pscale = (const float*)d_in[5];
    P.w_pout = (const float*)d_in[6]; P.lq1 = (const float*)d_in[7]; P.lk1 = (const float*)d_in[8]; P.lq2 = (const float*)d_in[9]; P.lk2 = (const float*)d_in[10]; P.g_sub = (const float*)d_in[11];
    P.w_ao = (const float*)d_in[12]; P.w_out = (const float*)d_in[13]; P.g_ffn = (const float*)d_in[14]; P.w_router = (const float*)d_in[15]; P.w_gate = (const float*)d_in[16]; P.w_up = (const float*)d_in[17];
    P.w_down = (const float*)d_in[18]; P.g_final = (const float*)d_in[19]; P.out = (float*)d_out; P.ws = (unsigned char*)d_ws;
#if MK_FUSED
    (void)hipMemsetAsync((char*)d_ws + WS_CTL, 0, 65536, stream);
#if PROBE_RLO >= 0
    a.ph_lo = 0; a.ph_hi = PROBE_RHI + 1; a.parts = PROBE_PARTS;
    hipLaunchKernelGGL(mega, dim3(grid), dim3(NWAVES * 64), LDS_BYTES, stream, a);
    (void)hipMemsetAsync((char*)d_ws + WS_CTL, 0, 65536, stream);
    a.ph_lo = PROBE_RLO; a.ph_hi = NPH; a.parts = 63;
    hipLaunchKernelGGL(mega, dim3(grid), dim3(NWAVES * 64), LDS_BYTES, stream, a);
#else
    a.ph_lo = 0; a.ph_hi = NPH;
    hipLaunchKernelGGL(mega, dim3(grid), dim3(NWAVES * 64), LDS_BYTES, stream, a);
#endif
#else
    unsigned char* ws = P.ws;
    for (int p = 0; p < NPH; ++p) {
        if ((NAIVE_MASK >> p) & 1) {
            if (p == 1) { k_gemm_naive<NEpiIn><<<dim3(INC / 64, T / 64, 1), 256, 0, stream>>>((const bf16*)(ws + WS_XB), (const bf16*)(ws + WS_WIN), D, NEpiIn{ws}); k_rope_naive<<<2048, 256, 0, stream>>>(P); continue; }
            if (p == 2) { a.ph_lo = 2; a.ph_hi = 2; k_pool_only<<<256, 512, 0, stream>>>(P); k_attn_naive<<<T * NH / 4, 256, 0, stream>>>(P); continue; }
            if (p == 4) { k_gemm_naive<NEpiGate1><<<dim3(D / 64, T / 64, 1), 256, 0, stream>>>((const bf16*)(ws + WS_PD), (const bf16*)(ws + WS_WCOMB), D, NEpiGate1{ws});
                          k_gemm_naive<NEpiGate2><<<dim3(D / 64, T / 64, 1), 256, 0, stream>>>((const bf16*)(ws + WS_O), (const bf16*)(ws + WS_WAO), D, NEpiGate2{ws}); continue; }
            if (p == 5) { k_gemm_naive<NEpiRes><<<dim3(D / 64, T / 64, 1), 256, 0, stream>>>((const bf16*)(ws + WS_MG), (const bf16*)(ws + WS_WOUT), D, NEpiRes{P.x, ws}); continue; }
            if (p == 8) { k_up_naive<<<dim3(FF / 64, CAP / 64, NB * NE), 256, 0, stream>>>(P); continue; }
            if (p == 9) { k_gemm_naive<NEpiDown><<<dim3(D / 64, CAP / 64, NB * NE), 256, 0, stream>>>((const bf16*)(ws + WS_ACT), (const bf16*)(ws + WS_WD), FF, NEpiDown{ws}); continue; }
        }
        a.ph_lo = p; a.ph_hi = p + 1;
        hipLaunchKernelGGL(mega, dim3(grid), dim3(NWAVES * 64), LDS_BYTES, stream, a);
    }
#endif
}
```
